# Optimizing an MI355X kernel written in HIP

```python
import math
import jax, jax.numpy as jnp
from jax import lax
import numpy as np

D_MODEL = 1024
BATCH = 8
SEQ = 2048
DEPTH = 4
DEC_BATCH = 128
DEC_SEQ = 4
PAST_LEN = 16384
PAGE_SIZE = 128

N_EVEN = (DEPTH + 1) // 2
N_ODD = DEPTH // 2
GLA_HEADS = 4
GLA_V_WIDTH = D_MODEL // 2
GLA_DV = GLA_V_WIDTH // GLA_HEADS
GLA_DK = GLA_DV // 2
GLA_K_WIDTH = GLA_HEADS * GLA_DK
GLA_RANK = 16
GLA_TAU = 16.0
GLA_CHUNK = 16
S5_WIDTH = D_MODEL - GLA_V_WIDTH
S5_GROUP = 16
S5_GROUPS = S5_WIDTH // S5_GROUP
S5_STATE = 64
LRU_WIDTH = D_MODEL
LRU_BLOCKS = 8
LRU_BLOCK = LRU_WIDTH // LRU_BLOCKS
LRU_C = 8.0
CONV_WIDTH = 4
D_FF = 4 * D_MODEL
NORM_EPS = 1e-6
EVEN_IN_WIDTH = 2 * GLA_K_WIDTH + 2 * GLA_V_WIDTH + GLA_RANK + S5_WIDTH

kernel_name = 'hybrid_gla_s5_rglru_step'


def rmsnorm(x, g):
    xf = x.astype(jnp.float32)
    y = xf * lax.rsqrt(jnp.mean(xf * xf, axis=-1, keepdims=True) + NORM_EPS) * g.astype(jnp.float32)
    return y.astype(x.dtype)


def gla_chunked(q, k, v, log_a, s0):
    bsz, slen, nh, dk = q.shape
    dv = v.shape[-1]
    c = math.gcd(slen, GLA_CHUNK)
    n = slen // c

    def blocks(t):
        return t.astype(jnp.float32).reshape(bsz, n, c, nh, -1).transpose(1, 0, 3, 2, 4)

    qb, kb, vb, gb = blocks(q), blocks(k), blocks(v), blocks(log_a)
    cum = jnp.cumsum(gb, axis=3)
    last = cum[:, :, :, -1:, :]
    q_t = qb * jnp.exp(cum) * (dk ** -0.5)
    k_t = kb * jnp.exp(-cum)
    k_end = kb * jnp.exp(last - cum)
    mask = jnp.tril(jnp.ones((c, c), dtype=bool))
    scores = jnp.where(mask, jnp.einsum('nbhid,nbhjd->nbhij', q_t, k_t), 0.0)
    o_intra = jnp.einsum('nbhij,nbhje->nbhie', scores, vb)

    def step(state, inp):
        q_c, k_c, v_c, dec = inp
        o = jnp.einsum('bhid,bhde->bhie', q_c, state)
        state = jnp.exp(dec)[..., 0, :, None] * state + jnp.einsum('bhjd,bhje->bhde', k_c, v_c)
        return state, o

    s_fin, o_inter = lax.scan(step, s0.astype(jnp.float32), (q_t, k_end, vb, last))
    o = (o_intra + o_inter).transpose(1, 0, 3, 2, 4).reshape(bsz, slen, nh, dv)
    return o, s_fin


def s5_scan(u, h0_re, h0_im, a_re, a_im, log_dt, b_re, b_im, c_re, c_im, d_skip):
    f32 = jnp.float32
    a_re = a_re.astype(f32)
    a_im = a_im.astype(f32)
    dt = jnp.exp(log_dt.astype(f32))[:, None]
    mag = jnp.exp(dt * a_re)
    ab_re = mag * jnp.cos(dt * a_im)
    ab_im = mag * jnp.sin(dt * a_im)
    den = a_re * a_re + a_im * a_im
    coef_re = ((ab_re - 1.0) * a_re + ab_im * a_im) / den
    coef_im = (ab_im * a_re - (ab_re - 1.0) * a_im) / den
    b_re = b_re.astype(f32)
    b_im = b_im.astype(f32)
    bb_re = coef_re[..., None] * b_re - coef_im[..., None] * b_im
    bb_im = coef_re[..., None] * b_im + coef_im[..., None] * b_re
    bu_re = jnp.einsum('bsgc,gpc->bsgp', u, bb_re)
    bu_im = jnp.einsum('bsgc,gpc->bsgp', u, bb_im)
    h0_re = h0_re.astype(f32)
    h0_im = h0_im.astype(f32)
    bu_re = bu_re.at[:, 0].add(ab_re * h0_re - ab_im * h0_im)
    bu_im = bu_im.at[:, 0].add(ab_re * h0_im + ab_im * h0_re)
    ar = jnp.broadcast_to(ab_re, bu_re.shape)
    ai = jnp.broadcast_to(ab_im, bu_im.shape)

    def combine(e1, e2):
        ar1, ai1, br1, bi1 = e1
        ar2, ai2, br2, bi2 = e2
        return (ar2 * ar1 - ai2 * ai1,
                ar2 * ai1 + ai2 * ar1,
                ar2 * br1 - ai2 * bi1 + br2,
                ar2 * bi1 + ai2 * br1 + bi2)

    _, _, h_re, h_im = lax.associative_scan(combine, (ar, ai, bu_re, bu_im), axis=1)
    y = (jnp.einsum('bsgp,gcp->bsgc', h_re, c_re.astype(f32))
         - jnp.einsum('bsgp,gcp->bsgc', h_im, c_im.astype(f32))
         + d_skip.astype(f32) * u)
    return y, h_re[:, -1], h_im[:, -1]


def causal_conv(x, buf, w, bias):
    slen = x.shape[1]
    xp = jnp.concatenate([buf.astype(x.dtype), x], axis=1)
    out = bias.astype(jnp.float32)
    for j in range(CONV_WIDTH):
        out = out + xp[:, j:j + slen].astype(jnp.float32) * w[j].astype(jnp.float32)
    return out, xp[:, slen:].astype(jnp.float32)


def rg_lru(x, h0, w_r, b_r, w_i, b_i, lam):
    bsz, slen, _ = x.shape
    xb = x.reshape(bsz, slen, LRU_BLOCKS, LRU_BLOCK)
    r = jax.nn.sigmoid(jnp.einsum('bsnc,ncd->bsnd', xb, w_r).reshape(bsz, slen, LRU_WIDTH) + b_r)
    i = jax.nn.sigmoid(jnp.einsum('bsnc,ncd->bsnd', xb, w_i).reshape(bsz, slen, LRU_WIDTH) + b_i)
    log_a = -LRU_C * r.astype(jnp.float32) * jax.nn.softplus(-lam.astype(jnp.float32))
    a = jnp.exp(log_a)
    b = jnp.sqrt(-jnp.expm1(2.0 * log_a)) * (i * x)
    b = b.at[:, 0].add(a[:, 0] * h0.astype(jnp.float32))

    def combine(e1, e2):
        return (e1[0] * e2[0], e2[0] * e1[1] + e2[1])

    _, h = lax.associative_scan(combine, (a, b), axis=1)
    return h, h[:, -1]


def even_mixer(x, s_gla, s_re, s_im, g_norm, w_in, w_a2, b_a2, g_head, a_re, a_im, log_dt,
               b_re, b_im, c_re, c_im, d_skip, w_glu, b_glu, w_out):
    f32 = jnp.float32
    bsz, slen, _ = x.shape
    p = rmsnorm(x, g_norm) @ w_in
    o1 = GLA_K_WIDTH
    o2 = 2 * GLA_K_WIDTH
    o3 = o2 + GLA_V_WIDTH
    o4 = o3 + GLA_V_WIDTH
    o5 = o4 + GLA_RANK
    q = p[..., :o1].reshape(bsz, slen, GLA_HEADS, GLA_DK)
    k = p[..., o1:o2].reshape(bsz, slen, GLA_HEADS, GLA_DK)
    v = p[..., o2:o3].reshape(bsz, slen, GLA_HEADS, GLA_DV)
    g = p[..., o3:o4]
    a_lr = p[..., o4:o5]
    u = p[..., o5:]
    log_a = (jax.nn.log_sigmoid((a_lr @ w_a2 + b_a2).astype(f32)) / GLA_TAU).reshape(bsz, slen, GLA_HEADS, GLA_DK)
    o, s_gla_new = gla_chunked(q, k, v, log_a, s_gla)
    o = rmsnorm(o, g_head.reshape(GLA_HEADS, GLA_DV)).reshape(bsz, slen, GLA_V_WIDTH) * jax.nn.silu(g.astype(f32))
    y5, s_re_new, s_im_new = s5_scan(u.astype(f32).reshape(bsz, slen, S5_GROUPS, S5_GROUP), s_re, s_im,
                                     a_re, a_im, log_dt, b_re, b_im, c_re, c_im, d_skip)
    z = jax.nn.gelu(y5.reshape(bsz, slen, S5_WIDTH))
    z = z * jax.nn.sigmoid(z @ w_glu.astype(f32) + b_glu.astype(f32))
    mix = jnp.concatenate([o, z], axis=-1).astype(x.dtype) @ w_out
    return mix, s_gla_new, s_re_new, s_im_new


def odd_mixer(x, s_lru, s_conv, g_norm, w_in, conv_w, conv_b, w_r, b_r, w_i, b_i, lam, w_out):
    p = rmsnorm(x, g_norm) @ w_in
    gate = jax.nn.gelu(p[..., :LRU_WIDTH].astype(jnp.float32))
    xc, conv_new = causal_conv(p[..., LRU_WIDTH:], s_conv, conv_w, conv_b)
    h, lru_new = rg_lru(xc, s_lru, w_r, b_r, w_i, b_i, lam)
    mix = (gate * h).astype(x.dtype) @ w_out
    return mix, lru_new, conv_new


def channel_mixer(x, g_norm, w_up, w_down):
    h = jnp.square(jax.nn.relu(rmsnorm(x, g_norm) @ w_up))
    return h @ w_down


def setup_inputs(seed: int = 0) -> dict:
    key = jax.random.key(seed)
    ks = iter(jax.random.split(key, 64))
    f32 = jnp.float32

    def nrm(shape, scale):
        return scale * jax.random.normal(next(ks), shape, f32)

    def gain(shape):
        return 1.0 + nrm(shape, 0.02)

    out_scale = (2.0 * DEPTH) ** -0.5
    lam_u = jax.random.uniform(next(ks), (N_ODD, LRU_WIDTH), f32, 0.9, 0.999)
    return {
        'x_prompt': nrm((BATCH, SEQ, D_MODEL), 1.0),
        'x_sample': nrm((DEC_BATCH, DEC_SEQ, D_MODEL), 1.0),
        'state_gla': nrm((N_EVEN, DEC_BATCH, GLA_HEADS, GLA_DK, GLA_DV), 1.0),
        'state_s5_re': nrm((N_EVEN, DEC_BATCH, S5_GROUPS, S5_STATE), 0.3),
        'state_s5_im': nrm((N_EVEN, DEC_BATCH, S5_GROUPS, S5_STATE), 0.3),
        'state_lru': nrm((N_ODD, DEC_BATCH, LRU_WIDTH), 0.5),
        'state_conv': nrm((N_ODD, DEC_BATCH, CONV_WIDTH - 1, LRU_WIDTH), 1.0),
        'norm_mix_even': gain((N_EVEN, D_MODEL)),
        'w_in_even': nrm((N_EVEN, D_MODEL, EVEN_IN_WIDTH), D_MODEL ** -0.5),
        'gla_w_a2': nrm((N_EVEN, GLA_RANK, GLA_K_WIDTH), GLA_RANK ** -0.5),
        'gla_b_a2': nrm((N_EVEN, GLA_K_WIDTH), 0.1),
        'gla_norm': gain((N_EVEN, GLA_V_WIDTH)),
        's5_a_re': -0.5 + nrm((N_EVEN, S5_GROUPS, S5_STATE), 0.01),
        's5_a_im': math.pi * jnp.arange(S5_STATE, dtype=f32) + nrm((N_EVEN, S5_GROUPS, S5_STATE), 0.01),
        's5_log_dt': jax.random.uniform(next(ks), (N_EVEN, S5_GROUPS), f32, math.log(1e-3), math.log(1e-1)),
        's5_b_re': nrm((N_EVEN, S5_GROUPS, S5_STATE, S5_GROUP), (2.0 * S5_GROUP) ** -0.5),
        's5_b_im': nrm((N_EVEN, S5_GROUPS, S5_STATE, S5_GROUP), (2.0 * S5_GROUP) ** -0.5),
        's5_c_re': nrm((N_EVEN, S5_GROUPS, S5_GROUP, S5_STATE), S5_STATE ** -0.5),
        's5_c_im': nrm((N_EVEN, S5_GROUPS, S5_GROUP, S5_STATE), S5_STATE ** -0.5),
        's5_d': nrm((N_EVEN, S5_GROUPS, S5_GROUP), 1.0),
        's5_w_glu': nrm((N_EVEN, S5_WIDTH, S5_WIDTH), S5_WIDTH ** -0.5),
        's5_b_glu': nrm((N_EVEN, S5_WIDTH), 0.01),
        'w_out_even': nrm((N_EVEN, GLA_V_WIDTH + S5_WIDTH, D_MODEL), (GLA_V_WIDTH + S5_WIDTH) ** -0.5 * out_scale),
        'norm_mix_odd': gain((N_ODD, D_MODEL)),
        'w_in_odd': nrm((N_ODD, D_MODEL, 2 * LRU_WIDTH), D_MODEL ** -0.5),
        'conv_w': nrm((N_ODD, CONV_WIDTH, LRU_WIDTH), CONV_WIDTH ** -0.5),
        'conv_b': nrm((N_ODD, LRU_WIDTH), 0.01),
        'lru_w_r': nrm((N_ODD, LRU_BLOCKS, LRU_BLOCK, LRU_BLOCK), LRU_BLOCK ** -0.5),
        'lru_b_r': nrm((N_ODD, LRU_WIDTH), 0.01),
        'lru_w_i': nrm((N_ODD, LRU_BLOCKS, LRU_BLOCK, LRU_BLOCK), LRU_BLOCK ** -0.5),
        'lru_b_i': nrm((N_ODD, LRU_WIDTH), 0.01),
        'lru_lam': jnp.log(lam_u) - jnp.log1p(-lam_u),
        'w_out_odd': nrm((N_ODD, LRU_WIDTH, D_MODEL), LRU_WIDTH ** -0.5 * out_scale),
        'norm_mlp': gain((DEPTH, D_MODEL)),
        'w_up': nrm((DEPTH, D_MODEL, D_FF), D_MODEL ** -0.5),
        'w_down': nrm((DEPTH, D_FF, D_MODEL), D_FF ** -0.5 * out_scale),
        'norm_final': gain((D_MODEL,)),
    }


def reference(x_prompt, x_sample, state_gla, state_s5_re, state_s5_im, state_lru, state_conv,
              norm_mix_even, w_in_even, gla_w_a2, gla_b_a2, gla_norm, s5_a_re, s5_a_im, s5_log_dt,
              s5_b_re, s5_b_im, s5_c_re, s5_c_im, s5_d, s5_w_glu, s5_b_glu, w_out_even,
              norm_mix_odd, w_in_odd, conv_w, conv_b, lru_w_r, lru_b_r, lru_w_i, lru_b_i, lru_lam, w_out_odd,
              norm_mlp, w_up, w_down, norm_final):
    f32 = jnp.float32
    bp = x_prompt.shape[0]
    yp, ys = x_prompt, x_sample
    gla_p, re_p, im_p, lru_p, conv_p = [], [], [], [], []
    gla_s, re_s, im_s, lru_s, conv_s = [], [], [], [], []
    for layer in range(DEPTH):
        if layer % 2 == 0:
            e = layer // 2
            prm = (norm_mix_even[e], w_in_even[e], gla_w_a2[e], gla_b_a2[e], gla_norm[e], s5_a_re[e], s5_a_im[e],
                   s5_log_dt[e], s5_b_re[e], s5_b_im[e], s5_c_re[e], s5_c_im[e], s5_d[e], s5_w_glu[e], s5_b_glu[e],
                   w_out_even[e])
            mp, sg, sr, si = even_mixer(yp, jnp.zeros((bp, GLA_HEADS, GLA_DK, GLA_DV), f32),
                                        jnp.zeros((bp, S5_GROUPS, S5_STATE), f32),
                                        jnp.zeros((bp, S5_GROUPS, S5_STATE), f32), *prm)
            gla_p.append(sg); re_p.append(sr); im_p.append(si)
            ms, sg, sr, si = even_mixer(ys, state_gla[e], state_s5_re[e], state_s5_im[e], *prm)
            gla_s.append(sg); re_s.append(sr); im_s.append(si)
        else:
            o = layer // 2
            prm = (norm_mix_odd[o], w_in_odd[o], conv_w[o], conv_b[o], lru_w_r[o], lru_b_r[o], lru_w_i[o],
                   lru_b_i[o], lru_lam[o], w_out_odd[o])
            mp, sl, sc = odd_mixer(yp, jnp.zeros((bp, LRU_WIDTH), f32),
                                   jnp.zeros((bp, CONV_WIDTH - 1, LRU_WIDTH), f32), *prm)
            lru_p.append(sl); conv_p.append(sc)
            ms, sl, sc = odd_mixer(ys, state_lru[o], state_conv[o], *prm)
            lru_s.append(sl); conv_s.append(sc)
        yp = yp + mp
        ys = ys + ms
        yp = yp + channel_mixer(yp, norm_mlp[layer], w_up[layer], w_down[layer])
        ys = ys + channel_mixer(ys, norm_mlp[layer], w_up[layer], w_down[layer])
    y_prompt = rmsnorm(yp, norm_final)
    y_sample = rmsnorm(ys, norm_final)
    return (y_prompt, y_sample,
            jnp.stack(gla_p), jnp.stack(re_p), jnp.stack(im_p), jnp.stack(lru_p), jnp.stack(conv_p),
            jnp.stack(gla_s), jnp.stack(re_s), jnp.stack(im_s), jnp.stack(lru_s), jnp.stack(conv_s))
```

```cpp
#include <hip/hip_runtime.h>
#include <cstdio>
#include <cstdint>
namespace pg8 {
#define PG8_LAS __attribute__((address_space(3)))
typedef unsigned short bf16_t;
typedef short bf16x8 __attribute__((ext_vector_type(8)));
typedef float f32x4 __attribute__((ext_vector_type(4)));
typedef unsigned u32x4 __attribute__((ext_vector_type(4)));
constexpr int BM = 256, BK = 64, HALF = 128, HTB = HALF * BK * 2  , STAGE_BYTES = 8 * HTB, NXCD = 8, WGM = 8;

__host__ __device__ __forceinline__ int lds_byte(int r, int c) { const int st = (r >> 4) * 2 + (c >> 5), rr = r & 15, cc = c & 31, ob = rr * 64 + cc * 2; return st * 1024 + (ob ^ (((ob >> 9) & 1) << 5)); }
__host__ __device__ __forceinline__ void stage_rc(int b, int& R, int& C) { const int st = b / 1024, sb = b % 1024, swz = sb ^ (((sb >> 9) & 1) << 5); R = (st >> 1) * 16 + swz / 64; C = (st & 1) * 32 + (swz % 64) / 2; }
__host__ __device__ __forceinline__ int perm32(int rho) { const int n = rho >> 4, i = rho & 15; return 8 * (i >> 2) + 4 * n + (i & 3); }

struct Unit { int pm, pn; };
struct Gemm { const bf16_t* A; const bf16_t* Bt; int M, N, K, ld; };

struct StaticOrder {
    int nM, nN, nwg, G, c;
    __host__ __device__ void init(int M, int N, int G_, int c_) { nM = M / BM; nN = N / BM; nwg = nM * nN; G = G_; c = c_; }
    __host__ __device__ bool next(int i, Unit& u) const {
        const long L = (long)i * G + c; if (L >= nwg) return false;
        int wgid = (int)L; { const int q = nwg / NXCD, r = nwg % NXCD, xcd = wgid % NXCD, off = wgid / NXCD; wgid = (xcd < r ? xcd * (q + 1) : r * (q + 1) + (xcd - r) * q) + off; }
        const int nig = WGM * nN, gid = wgid / nig, fm = gid * WGM, gsz = (nM - fm) < WGM ? (nM - fm) : WGM;
        u.pm = fm + ((wgid % nig) % gsz); u.pn = (wgid % nig) / gsz; return true;
    }
    __device__ __forceinline__ void a_ready(const Unit&) const {}
    __device__ __forceinline__ void done(const Unit&) const {}
};

__device__ __forceinline__ unsigned cvt_pk_bf16(float lo, float hi) { unsigned r; asm volatile("v_cvt_pk_bf16_f32 %0, %1, %2" : "=v"(r) : "v"(lo), "v"(hi)); return r; }
template <class Epi, class Sched, bool ALIGN_EPI = false, bool SP2 = false>
__device__ __forceinline__ void gemm_phase(PG8_LAS unsigned char* lds, const Gemm g, const Sched& S, const Epi& E, int tid_in) {
    int tid_ = tid_in; asm volatile("" : "+v"(tid_));
    const int tid = tid_, wid = __builtin_amdgcn_readfirstlane(tid >> 6), lane = tid & 63, wr = wid >> 2, wc = wid & 3, fr = lane & 15, fq = lane >> 4;
    const int K = g.K, nt = K / BK, LD = g.ld;
    unsigned voffA[2], voffB[2];
#pragma unroll
    for (int i = 0; i < 2; ++i) { int R, C; stage_rc(tid * 16 + i * 8192, R, C); const int Rb = Epi::PERM ? ((R & ~31) + perm32(R & 31)) : R;
        voffA[i] = (unsigned)(R * LD + C) * 2u; voffB[i] = (unsigned)(Rb * LD + C) * 2u; }
    const size_t kstep = (size_t)(BK * 2);
    const size_t hstep = (size_t)HALF * LD * 2;
    const size_t tstep = 2 * hstep;
    const unsigned ldsw = (unsigned)wid * 1024u;
    const int aoff = lds_byte(wr * 64 + fr, fq * 8), boff = lds_byte(wc * 32 + fr, fq * 8);
#define PG8_SA(b, h) (((b) * 2 + (h)) * HTB)
#define PG8_SB(b, h) ((4 + (b) * 2 + (h)) * HTB)
#define PG8_STAGE(bufoff, gbase, voff) do { _Pragma("unroll") for (int _i = 0; _i < 2; ++_i) \
        __builtin_amdgcn_global_load_lds((const unsigned*)((const char*)(gbase) + (voff)[_i]), (PG8_LAS unsigned*)(lds + (bufoff) + ldsw + _i * 8192), 16, 0, 0); } while (0)
#define PG8_LDA(dst, b, h) do { _Pragma("unroll") for (int m = 0; m < 4; ++m) _Pragma("unroll") for (int k = 0; k < 2; ++k) dst[m][k] = *(const PG8_LAS bf16x8*)(lds + PG8_SA(b, h) + aoff + m * 2048 + k * 1024); } while (0)
#define PG8_LDB(dst, b, h) do { _Pragma("unroll") for (int n = 0; n < 2; ++n) _Pragma("unroll") for (int k = 0; k < 2; ++k) dst[n][k] = *(const PG8_LAS bf16x8*)(lds + PG8_SB(b, h) + boff + n * 2048 + k * 1024); } while (0)
#define PG8_MMA(ai, bj, At, Bt) do { __builtin_amdgcn_s_setprio(1); _Pragma("unroll") for (int m = 0; m < 4; ++m) _Pragma("unroll") for (int n = 0; n < 2; ++n) _Pragma("unroll") for (int k = 0; k < 2; ++k) \
        acc[ai][bj][m][n] = __builtin_amdgcn_mfma_f32_16x16x32_bf16(Bt[n][k], At[m][k], acc[ai][bj][m][n], 0, 0, 0); __builtin_amdgcn_s_setprio(0); } while (0)
#define PG8_WAIT_V(n) asm volatile("s_waitcnt vmcnt(" #n ")" ::: "memory")
#define PG8_WAIT_L(n) asm volatile("s_waitcnt lgkmcnt(" #n ")" ::: "memory")
#define PG8_BAR __builtin_amdgcn_s_barrier()
#define PG8_SCHED __builtin_amdgcn_sched_barrier(0)
    Unit cur, nxt; int ui = 0;
    if (!S.next(0, cur)) return;
    f32x4 acc[2][2][4][2];
#pragma unroll
    for (int a = 0; a < 2; ++a)
#pragma unroll
        for (int b = 0; b < 2; ++b)
#pragma unroll
            for (int m = 0; m < 4; ++m)
#pragma unroll
                for (int n = 0; n < 2; ++n) acc[a][b][m][n] = (f32x4){0.f, 0.f, 0.f, 0.f};
    bf16x8 At[4][2], B0[2][2], B1[2][2];
    const char* cA = (const char*)g.A + (size_t)cur.pm * tstep; const char* cB = (const char*)g.Bt + (size_t)cur.pn * tstep;
    S.a_ready(cur);
    if constexpr (SP2) {
        PG8_STAGE(PG8_SB(0, 0), cB, voffB); PG8_STAGE(PG8_SB(0, 1), cB + hstep, voffB); PG8_STAGE(PG8_SA(0, 0), cA, voffA); PG8_STAGE(PG8_SA(0, 1), cA + hstep, voffA);
        if (wr == 1) PG8_BAR;
        PG8_WAIT_V(2); PG8_BAR;
        PG8_STAGE(PG8_SB(1, 0), cB + kstep, voffB); PG8_STAGE(PG8_SA(1, 0), cA + kstep, voffA); PG8_STAGE(PG8_SB(1, 1), cB + hstep + kstep, voffB);
        PG8_WAIT_V(6); PG8_BAR;
    } else {
        PG8_STAGE(PG8_SB(0, 0), cB, voffB); PG8_STAGE(PG8_SA(0, 0), cA, voffA); PG8_STAGE(PG8_SB(0, 1), cB + hstep, voffB); PG8_STAGE(PG8_SA(0, 1), cA + hstep, voffA);
        if (wr == 1) PG8_BAR;
        PG8_WAIT_V(4); PG8_BAR;
        PG8_STAGE(PG8_SB(1, 0), cB + kstep, voffB); PG8_STAGE(PG8_SA(1, 0), cA + kstep, voffA); PG8_STAGE(PG8_SB(1, 1), cB + hstep + kstep, voffB);
        PG8_WAIT_V(6); PG8_BAR;
    }
    for (;;) {
        const bool has_next = S.next(ui + 1, nxt);
        const char* nA = has_next ? (const char*)g.A + (size_t)nxt.pm * tstep : cA; const char* nB = has_next ? (const char*)g.Bt + (size_t)nxt.pn * tstep : cB;
        for (int t = 0; t < nt; t += 2) {
            const bool last = (t == nt - 2);
            const char* a1 = cA + (size_t)(t + 1) * kstep;
            const char* a2 = last ? nA : cA + (size_t)(t + 2) * kstep; const char* b2 = last ? nB : cB + (size_t)(t + 2) * kstep;
            const char* a3 = a2 + kstep; const char* b3 = b2 + kstep;
            if (last && has_next) S.a_ready(nxt);
            if constexpr (SP2) {
            PG8_LDB(B0, 0, 0); PG8_LDB(B1, 0, 1); PG8_SCHED; PG8_LDA(At, 0, 0); PG8_STAGE(PG8_SA(1, 1), a1 + hstep, voffA);
            PG8_WAIT_V(8); PG8_WAIT_L(0); PG8_BAR; PG8_MMA(0, 0, At, B0); PG8_MMA(0, 1, At, B1); PG8_BAR; PG8_SCHED;
            PG8_LDA(At, 0, 1); PG8_STAGE(PG8_SB(0, 0), b2, voffB); PG8_STAGE(PG8_SB(0, 1), b2 + hstep, voffB); PG8_STAGE(PG8_SA(0, 0), a2, voffA);
            PG8_WAIT_V(8); PG8_WAIT_L(0); PG8_BAR; PG8_MMA(1, 0, At, B0); PG8_MMA(1, 1, At, B1); PG8_BAR; PG8_SCHED;
            PG8_LDB(B0, 1, 0); PG8_LDB(B1, 1, 1); PG8_SCHED; PG8_LDA(At, 1, 0); PG8_STAGE(PG8_SA(0, 1), a2 + hstep, voffA);
            PG8_WAIT_V(8); PG8_WAIT_L(0); PG8_BAR; PG8_MMA(0, 0, At, B0); PG8_MMA(0, 1, At, B1); PG8_BAR; PG8_SCHED;
            PG8_LDA(At, 1, 1); PG8_STAGE(PG8_SB(1, 0), b3, voffB); PG8_STAGE(PG8_SB(1, 1), b3 + hstep, voffB); PG8_STAGE(PG8_SA(1, 0), a3, voffA);
            PG8_WAIT_V(8); PG8_WAIT_L(0); PG8_BAR; PG8_MMA(1, 0, At, B0); PG8_MMA(1, 1, At, B1); PG8_BAR; PG8_SCHED;
            } else {
            PG8_LDB(B0, 0, 0); PG8_SCHED; PG8_LDA(At, 0, 0); PG8_STAGE(PG8_SA(1, 1), a1 + hstep, voffA);
            PG8_WAIT_L(8); PG8_BAR; PG8_WAIT_L(0); PG8_MMA(0, 0, At, B0); PG8_BAR; PG8_SCHED;
            PG8_LDB(B1, 0, 1); PG8_STAGE(PG8_SB(0, 0), b2, voffB);
            PG8_BAR; PG8_WAIT_L(0); PG8_MMA(0, 1, At, B1); PG8_BAR;
            PG8_LDA(At, 0, 1); PG8_STAGE(PG8_SA(0, 0), a2, voffA);
            PG8_BAR; PG8_WAIT_L(0); PG8_MMA(1, 0, At, B0); PG8_BAR; PG8_SCHED;
            PG8_STAGE(PG8_SB(0, 1), b2 + hstep, voffB);
            PG8_WAIT_V(6); PG8_BAR; PG8_MMA(1, 1, At, B1); PG8_BAR;
            PG8_LDB(B0, 1, 0); PG8_SCHED; PG8_LDA(At, 1, 0); PG8_STAGE(PG8_SA(0, 1), a2 + hstep, voffA);
            PG8_WAIT_L(8); PG8_BAR; PG8_WAIT_L(0); PG8_MMA(0, 0, At, B0); PG8_BAR; PG8_SCHED;
            PG8_LDB(B1, 1, 1); PG8_STAGE(PG8_SB(1, 0), b3, voffB);
            PG8_BAR; PG8_WAIT_L(0); PG8_MMA(0, 1, At, B1); PG8_BAR;
            PG8_LDA(At, 1, 1); PG8_STAGE(PG8_SA(1, 0), a3, voffA);
            PG8_BAR; PG8_WAIT_L(0); PG8_MMA(1, 0, At, B0); PG8_BAR; PG8_SCHED;
            PG8_STAGE(PG8_SB(1, 1), b3 + hstep, voffB);
            PG8_WAIT_V(6); PG8_BAR; PG8_MMA(1, 1, At, B1); PG8_BAR;
            }
        }
        if constexpr (ALIGN_EPI) { if (wr == 0) PG8_BAR; }
        if constexpr (!Epi::AFTER_DRAIN) { E(acc, cur, wr, wc, fr, fq); S.done(cur); }
        if (!has_next) break;
#pragma unroll
        for (int a = 0; a < 2; ++a)
#pragma unroll
            for (int b = 0; b < 2; ++b)
#pragma unroll
                for (int m = 0; m < 4; ++m)
#pragma unroll
                    for (int n = 0; n < 2; ++n) acc[a][b][m][n] = (f32x4){0.f, 0.f, 0.f, 0.f};
        cur = nxt; cA = nA; cB = nB; ++ui;
        if constexpr (ALIGN_EPI) { if (wr == 1) PG8_BAR; }
    }
    PG8_WAIT_V(0);
    if constexpr (!ALIGN_EPI) { if (wr == 0) PG8_BAR; }
    PG8_BAR;
    if constexpr (Epi::AFTER_DRAIN) { E.fused(acc, cur, wr, wc, fr, fq, lds, wid, lane); S.done(cur); }
#undef PG8_SA
#undef PG8_SB
#undef PG8_STAGE
#undef PG8_LDA
#undef PG8_LDB
#undef PG8_MMA
#undef PG8_WAIT_V
#undef PG8_WAIT_L
#undef PG8_BAR
#undef PG8_SCHED
}
}
#ifndef PG8_SP2
#define PG8_SP2 true
#endif
namespace pg8 {
constexpr int TP_ROWS = 16384, T_ROWS = 16896;
constexpr float EPS_F = 1e-6f;
__device__ __forceinline__ float sigmoid_f(float x) { return __builtin_amdgcn_rcpf(1.0f + __expf(-x)); }
__device__ __forceinline__ float gelu_tanh_f(float x) { const float u = 0.7978845608028654f * (x + 0.044715f * x * x * x); return x * __builtin_amdgcn_rcpf(1.0f + __expf(-2.0f * u)); }
__device__ __forceinline__ float logsigmoid_f(float x) { return fminf(x, 0.f) - __logf(1.0f + __expf(-fabsf(x))); }
__device__ __forceinline__ u32x4 pack8(const f32x4& a, const f32x4& b) { u32x4 w; w.x = cvt_pk_bf16(a[0], a[1]); w.y = cvt_pk_bf16(a[2], a[3]); w.z = cvt_pk_bf16(b[0], b[1]); w.w = cvt_pk_bf16(b[2], b[3]); return w; }
__device__ __forceinline__ void unpack8(const u32x4& w, f32x4& a, f32x4& b) {
    a = (f32x4){__uint_as_float(w.x << 16), __uint_as_float(w.x & 0xffff0000u), __uint_as_float(w.y << 16), __uint_as_float(w.y & 0xffff0000u)};
    b = (f32x4){__uint_as_float(w.z << 16), __uint_as_float(w.z & 0xffff0000u), __uint_as_float(w.w << 16), __uint_as_float(w.w & 0xffff0000u)}; }
__device__ __forceinline__ float ssq4(const float* ssq, int row) { return rsqrtf(((ssq[row] + ssq[T_ROWS + row]) + (ssq[2 * T_ROWS + row] + ssq[3 * T_ROWS + row])) * (1.0f / 1024.0f) + EPS_F); }

template <class E> __device__ __forceinline__ void drive_epi(const E& e, const f32x4 (&acc)[2][2][4][2], const Unit& u, int wr, int wc, int fr, int fq, float (&sums)[8]) {
    const int row0 = u.pm * BM + wr * 64 + fr, col0 = u.pn * BM + wc * 32 + 8 * fq;
    float rs[8]; f32x4 cb0[2], cb1[2];
#pragma unroll
    for (int g = 0; g < 8; ++g) rs[g] = e.row_scale(row0 + (g >> 2) * HALF + (g & 3) * 16);
#pragma unroll
    for (int bj = 0; bj < 2; ++bj) e.col8(col0 + bj * HALF, cb0[bj], cb1[bj]);
#pragma unroll
    for (int hf = 0; hf < 2; ++hf) {
        u32x4 pre[4][2];
        if (E::HAS_PRE) {
#pragma unroll
            for (int m = 0; m < 4; ++m)
#pragma unroll
                for (int bj = 0; bj < 2; ++bj) pre[m][bj] = e.pre8(row0 + hf * HALF + m * 16, col0 + bj * HALF);
        }
#pragma unroll
        for (int m = 0; m < 4; ++m) { const int g = 4 * hf + m, row = row0 + hf * HALF + m * 16; float s = 0.f;
#pragma unroll
            for (int bj = 0; bj < 2; ++bj) e.row8(row, col0 + bj * HALF, acc[hf][bj][m][0], acc[hf][bj][m][1], rs[g], cb0[bj], cb1[bj], E::HAS_PRE ? pre[m][bj] : (u32x4){0u, 0u, 0u, 0u}, s);
            sums[g] = s; }
        if (E::HAS_PRE) asm volatile("" ::: "memory");
    }
}
struct EpiInE {
    static constexpr bool PERM = true, AFTER_DRAIN = false, HAS_PRE = false;
    bf16_t* P; const float* ssq;
    __device__ __forceinline__ float row_scale(int row) const { return ssq4(ssq, row); }
    __device__ __forceinline__ void col8(int, f32x4& b0, f32x4& b1) const { b0 = (f32x4){0.f, 0.f, 0.f, 0.f}; b1 = b0; }
    __device__ __forceinline__ u32x4 pre8(int, int) const { return (u32x4){0u, 0u, 0u, 0u}; }
    __device__ __forceinline__ void row8(int row, int col, f32x4 v0, f32x4 v1, float rs, const f32x4&, const f32x4&, const u32x4&, float&) const {
        v0 = v0 * rs; v1 = v1 * rs;
        if (col >= 1024 && col < 1536) {
#pragma unroll
            for (int e = 0; e < 4; ++e) { v0[e] = v0[e] * sigmoid_f(v0[e]); v1[e] = v1[e] * sigmoid_f(v1[e]); } }
        *(u32x4*)(P + (size_t)row * 2048 + col) = pack8(v0, v1);
    }
    __device__ __forceinline__ void operator()(const f32x4 (&acc)[2][2][4][2], const Unit& u, int wr, int wc, int fr, int fq) const { float sm[8]; drive_epi(*this, acc, u, wr, wc, fr, fq, sm); }
};
struct EpiInO {
    static constexpr bool PERM = true, AFTER_DRAIN = false, HAS_PRE = false;
    bf16_t* GATE; bf16_t* CIN; const float* ssq; float* conv_p; float* conv_s;
    __device__ __forceinline__ float row_scale(int row) const { return ssq4(ssq, row); }
    __device__ __forceinline__ void col8(int, f32x4& b0, f32x4& b1) const { b0 = (f32x4){0.f, 0.f, 0.f, 0.f}; b1 = b0; }
    __device__ __forceinline__ u32x4 pre8(int, int) const { return (u32x4){0u, 0u, 0u, 0u}; }
    __device__ __forceinline__ void row8(int row, int col, f32x4 v0, f32x4 v1, float rs, const f32x4&, const f32x4&, const u32x4&, float&) const {
        v0 = v0 * rs; v1 = v1 * rs;
        if (col < 1024) {
#pragma unroll
            for (int e = 0; e < 4; ++e) { v0[e] = gelu_tanh_f(v0[e]); v1[e] = gelu_tanh_f(v1[e]); }
            *(u32x4*)(GATE + (size_t)row * 1024 + col) = pack8(v0, v1);
        } else {
            const int cc = col - 1024;
            *(u32x4*)(CIN + (size_t)row * 1024 + cc) = pack8(v0, v1);
            float* cdst = nullptr;
            if (row < TP_ROWS) { const int t = row & 2047; if (t >= 2045) cdst = conv_p + ((size_t)(row >> 11) * 3 + (t - 2045)) * 1024; }
            else { const int r2 = row - TP_ROWS, t = r2 & 3; if (t >= 1) cdst = conv_s + ((size_t)(r2 >> 2) * 3 + (t - 1)) * 1024; }
            if (cdst) { *(f32x4*)(cdst + cc) = v0; *(f32x4*)(cdst + cc + 4) = v1; }
        }
    }
    __device__ __forceinline__ void operator()(const f32x4 (&acc)[2][2][4][2], const Unit& u, int wr, int wc, int fr, int fq) const { float sm[8]; drive_epi(*this, acc, u, wr, wc, fr, fq, sm); }
};
struct EpiRes {
    static constexpr bool PERM = true, AFTER_DRAIN = true, HAS_PRE = true;
    bf16_t* XB; float* ssq_out;
    __device__ __forceinline__ float row_scale(int) const { return 1.f; }
    __device__ __forceinline__ void col8(int, f32x4& b0, f32x4& b1) const { b0 = (f32x4){0.f, 0.f, 0.f, 0.f}; b1 = b0; }
    __device__ __forceinline__ u32x4 pre8(int row, int col) const { return *(const u32x4*)(XB + (size_t)row * 1024 + col); }
    __device__ __forceinline__ void row8(int row, int col, f32x4 v0, f32x4 v1, float, const f32x4&, const f32x4&, const u32x4& pre, float& s) const {
        f32x4 o0, o1; unpack8(pre, o0, o1); o0 = o0 + v0; o1 = o1 + v1;
        *(u32x4*)(XB + (size_t)row * 1024 + col) = pack8(o0, o1);
        s += (o0[0] * o0[0] + o0[1] * o0[1]) + (o0[2] * o0[2] + o0[3] * o0[3]) + (o1[0] * o1[0] + o1[1] * o1[1]) + (o1[2] * o1[2] + o1[3] * o1[3]);
    }
    __device__ __forceinline__ void fused(f32x4 (&acc)[2][2][4][2], const Unit& u, int wr, int wc, int fr, int fq, PG8_LAS unsigned char* lds, int wid, int lane) const {
        PG8_LAS float* part = (PG8_LAS float*)lds;
        float sm[8]; drive_epi(*this, acc, u, wr, wc, fr, fq, sm);
#pragma unroll
        for (int g = 0; g < 8; ++g) { float s = sm[g]; s += __shfl_xor(s, 16); s += __shfl_xor(s, 32);
            if (fq == 0) part[wc * 256 + (g >> 2) * HALF + wr * 64 + (g & 3) * 16 + fr] = s; }
        asm volatile("s_waitcnt lgkmcnt(0)" ::: "memory"); __builtin_amdgcn_s_barrier(); asm volatile("" ::: "memory");
        const int t = wid * 64 + lane;
        if (t < 256) ssq_out[(size_t)u.pn * T_ROWS + u.pm * BM + t] = (part[t] + part[256 + t]) + (part[512 + t] + part[768 + t]);
        asm volatile("s_waitcnt lgkmcnt(0)" ::: "memory"); __builtin_amdgcn_s_barrier(); asm volatile("" ::: "memory");
    }
    __device__ __forceinline__ void operator()(const f32x4 (&acc)[2][2][4][2], const Unit& u, int wr, int wc, int fr, int fq) const {}
};
struct EpiUp {
    static constexpr bool PERM = true, AFTER_DRAIN = false, HAS_PRE = false;
    bf16_t* H; const float* ssq;
    __device__ __forceinline__ float row_scale(int row) const { return ssq4(ssq, row); }
    __device__ __forceinline__ void col8(int, f32x4& b0, f32x4& b1) const { b0 = (f32x4){0.f, 0.f, 0.f, 0.f}; b1 = b0; }
    __device__ __forceinline__ u32x4 pre8(int, int) const { return (u32x4){0u, 0u, 0u, 0u}; }
    __device__ __forceinline__ void row8(int row, int col, f32x4 v0, f32x4 v1, float rs, const f32x4&, const f32x4&, const u32x4&, float&) const {
        v0 = v0 * rs; v1 = v1 * rs;
#pragma unroll
        for (int e = 0; e < 4; ++e) { const float a = fmaxf(v0[e], 0.f), b = fmaxf(v1[e], 0.f); v0[e] = a * a; v1[e] = b * b; }
        { const u32x4 pk_ = pack8(v0, v1); bf16_t* dp_ = H + (size_t)row * 4224 + col;
          asm volatile("global_store_dwordx4 %0, %1, off sc1\n\ts_nop 1" :: "v"(dp_), "v"(pk_) : "memory"); }
    }
    __device__ __forceinline__ void operator()(const f32x4 (&acc)[2][2][4][2], const Unit& u, int wr, int wc, int fr, int fq) const { float sm[8]; drive_epi(*this, acc, u, wr, wc, fr, fq, sm); }
};
struct EpiGlu {
    static constexpr bool PERM = true, AFTER_DRAIN = false, HAS_PRE = true;
    const bf16_t* Z1; bf16_t* MIX; const float* b_glu;
    __device__ __forceinline__ float row_scale(int) const { return 1.f; }
    __device__ __forceinline__ void col8(int col, f32x4& b0, f32x4& b1) const { b0 = *(const f32x4*)(b_glu + col); b1 = *(const f32x4*)(b_glu + col + 4); }
    __device__ __forceinline__ u32x4 pre8(int row, int col) const { return *(const u32x4*)(Z1 + (size_t)row * 512 + col); }
    __device__ __forceinline__ void row8(int row, int col, f32x4 v0, f32x4 v1, float, const f32x4& b0, const f32x4& b1, const u32x4& pre, float&) const {
        f32x4 z0, z1; unpack8(pre, z0, z1);
#pragma unroll
        for (int e = 0; e < 4; ++e) { v0[e] = z0[e] * sigmoid_f(v0[e] + b0[e]); v1[e] = z1[e] * sigmoid_f(v1[e] + b1[e]); }
        *(u32x4*)(MIX + (size_t)row * 1024 + 512 + col) = pack8(v0, v1);
    }
    __device__ __forceinline__ void operator()(const f32x4 (&acc)[2][2][4][2], const Unit& u, int wr, int wc, int fr, int fq) const { float sm[8]; drive_epi(*this, acc, u, wr, wc, fr, fq, sm); }
};
}
constexpr int NWAVES = 8;
constexpr int D = 1024, TP = 16384, TS = 512, T = TP + TS, FF = 4096;
constexpr int NIN_E = 2304, NIN_O = 2048;
constexpr float EPS = 1e-6f;
constexpr size_t MiB = 1u << 20;
constexpr size_t WS_CTL = 0, CTL_ZERO_BYTES = 2 * MiB;
constexpr size_t WS_SSQ = 277 * MiB;
constexpr size_t CTL_S5AB = 1 * MiB;
constexpr size_t CTL_S5BRE = 1 * MiB + 64 * 1024;
constexpr size_t CTL_S5BIM = CTL_S5BRE + 256 * 1024;
constexpr size_t WS_W = 2 * MiB;
constexpr size_t W_INE = 0, W_GLU = 9437184, W_OUTE = 10485760, W_INO = 14680064, W_G = 23068672, W_OUTO = 24117248, W_UP = 28311552, W_DN = 61865984, W_END = 96468992;
constexpr size_t WS_WA = 94 * MiB;
constexpr int LD_FF = 4224;
constexpr size_t WS_XB = 95 * MiB, WS_R = 128 * MiB;
constexpr size_t R_H = 0, R_P = 0, R_LA = 66 * MiB, R_Z1 = 82 * MiB + MiB / 2, R_MIX = 99 * MiB, R_ORAW = 132 * MiB;
constexpr size_t R_CIN = 0, R_LOGA = 0, R_XC = 33 * MiB, R_BB = 66 * MiB;
constexpr size_t WS_END = WS_SSQ + (size_t)9 * 4 * T * 4;
static_assert(WS_R + 148 * MiB + MiB / 2 <= WS_SSQ, "ws map");
static_assert(WS_W + W_END <= WS_XB && WS_XB + (size_t)T * D * 2 <= WS_R, "ws map");
constexpr size_t OUT_YP = 0, OUT_YS = 16777216, OUT_GLAP = 17301504, OUT_REP = 17825792, OUT_IMP = 17858560, OUT_LRUP = 17891328, OUT_CONVP = 17907712,
                 OUT_GLAS = 17956864, OUT_RES = 26345472, OUT_IMS = 26869760, OUT_LRUS = 27394048, OUT_CONVS = 27656192, OUT_END = 28442624;
constexpr int CW_TMO = 0, CW_CODE = 1, CW_BAR = 4096;
constexpr int RING_OFF = 0, RING_BYTES = 131072, LDSCTL_OFF = RING_BYTES, MISC_OFF = LDSCTL_OFF + 320, LDS_BYTES = 147456;

#define GAS __attribute__((address_space(1)))
#define LAS __attribute__((address_space(3)))
typedef unsigned short bf16;
typedef unsigned v4u __attribute__((ext_vector_type(4)));
typedef unsigned v2u __attribute__((ext_vector_type(2)));
typedef float f32x4 __attribute__((ext_vector_type(4)));
typedef short bf16x8 __attribute__((ext_vector_type(8)));
typedef GAS unsigned gu32;
#define RLX_AGENT __ATOMIC_RELAXED, __HIP_MEMORY_SCOPE_AGENT
#define LDS_WAIT() asm volatile("s_waitcnt lgkmcnt(0)" ::: "memory")
#define VM_WAIT() asm volatile("s_waitcnt vmcnt(0)" ::: "memory")
__device__ __forceinline__ unsigned f2bf(float f) { unsigned u = __builtin_bit_cast(unsigned, f); return (u + 0x7fffu + ((u >> 16) & 1u)) >> 16; }
__device__ __forceinline__ unsigned pk2(float lo, float hi) { return f2bf(lo) | (f2bf(hi) << 16); }
__device__ __forceinline__ float bflo(unsigned w) { return __uint_as_float(w << 16); }
__device__ __forceinline__ float bfhi(unsigned w) { return __uint_as_float(w & 0xffff0000u); }
__device__ __forceinline__ float bf2f(bf16 h) { return __uint_as_float((unsigned)h << 16); }
__device__ __forceinline__ float sigmoid_f(float x) { return __builtin_amdgcn_rcpf(1.0f + __expf(-x)); }
__device__ __forceinline__ float gelu_tanh_f(float x) { const float u = 0.7978845608028654f * (x + 0.044715f * x * x * x); return x * __builtin_amdgcn_rcpf(1.0f + __expf(-2.0f * u)); }
__device__ __forceinline__ float wave_sum(float v) {
#pragma unroll
    for (int o = 1; o < 64; o <<= 1) v += __shfl_xor(v, o);
    return v;
}
#define XB_TMO      128
#define XB_XCNT(j)  (256  + 64 * (j))
#define XB_XSUB(j)  (1280 + 64 * (j))
#define XB_XGEN(j)  (2304 + 64 * (j))
#define XB_TOP      3328
#define XB_TOPGEN   3392
#define XCD_BAR_WORDS 3456
#define XB_SPIN_CAP (1u << 18)

__device__ __forceinline__ unsigned xb_ld(unsigned* p)              { return __hip_atomic_load(p, __ATOMIC_RELAXED, __HIP_MEMORY_SCOPE_AGENT); }
__device__ __forceinline__ unsigned xb_add(unsigned* p, unsigned v) { return __hip_atomic_fetch_add(p, v, __ATOMIC_RELAXED, __HIP_MEMORY_SCOPE_AGENT); }
__device__ __forceinline__ unsigned xb_xcc_id() { return (unsigned)__builtin_amdgcn_s_getreg((3 << 11) | 20) & 0xFu; }
#define XB_SPIN(cond, bar) do { unsigned _sp = 0; while (cond) { __builtin_amdgcn_s_sleep(1); \
    if ((++_sp & 255u) == 0u) { if (xb_ld(&(bar)[XB_TMO])) break; if (_sp > XB_SPIN_CAP) { atomicAdd(&(bar)[XB_TMO], 1u); break; } } } } while (0)

struct XcdBarrier {
    unsigned* bar; unsigned x;
    volatile LAS unsigned* st;
};

__device__ __forceinline__ XcdBarrier xcd_barrier_post(unsigned* bar, volatile LAS unsigned* st, int tid) {
    XcdBarrier b; b.bar = bar; b.x = xb_xcc_id(); b.st = st;
    if (tid == 0) (void)xb_add(&bar[XB_XCNT(b.x)], 1u);
    return b;
}
__device__ __forceinline__ void xcd_barrier_complete(unsigned* bar, unsigned x, unsigned& nloc, unsigned& nx) {
    const unsigned G = gridDim.x * gridDim.y * gridDim.z;
    unsigned sum, cnt, mine, sp = 0u;
    for (;;) {
        sum = 0u; cnt = 0u; mine = 0u;
#pragma unroll
        for (unsigned j = 0; j < 16; ++j) { const unsigned c = xb_ld(&bar[XB_XCNT(j)]); sum += c; cnt += (c > 0u) ? 1u : 0u; mine = (j == x) ? c : mine; }
        if (sum == G) break;
        __builtin_amdgcn_s_sleep(1);
        if ((++sp & 255u) == 0u) { if (xb_ld(&bar[XB_TMO])) break; if (sp > XB_SPIN_CAP) { atomicAdd(&bar[XB_TMO], 1u); break; } }
    }
    nloc = mine > 0u ? mine : 1u; nx = cnt > 0u ? cnt : 1u;
}

__device__ __forceinline__ void xcd_barrier(const XcdBarrier& b, int tid) {
    asm volatile("s_waitcnt vmcnt(0)" ::: "memory");
    __syncthreads();
    if (tid == 0) {
        unsigned* bar = b.bar;
        __builtin_amdgcn_s_waitcnt(0);
        unsigned nloc = b.st[0], nx = b.st[1];
        if (nloc == 0u) { xcd_barrier_complete(bar, b.x, nloc, nx); b.st[0] = nloc; b.st[1] = nx; }
        const unsigned old = xb_add(&bar[XB_XSUB(b.x)], 1u);
        const unsigned gen = old / nloc;
        if (old + 1u == (gen + 1u) * nloc) {
            __builtin_amdgcn_fence(__ATOMIC_RELEASE, "agent");
            asm volatile("s_waitcnt vmcnt(0)" ::: "memory");
            const unsigned og = xb_add(&bar[XB_TOP], 1u);
            const unsigned tg = og / nx;
            if (og + 1u == (tg + 1u) * nx) xb_add(&bar[XB_TOPGEN], 1u);
            else XB_SPIN(xb_ld(&bar[XB_TOPGEN]) == tg, bar);
            __builtin_amdgcn_fence(__ATOMIC_ACQUIRE, "agent");
            xb_add(&bar[XB_XGEN(b.x)], 1u);
            asm volatile("s_waitcnt vmcnt(0)" ::: "memory");
        } else {
            XB_SPIN(xb_ld(&bar[XB_XGEN(b.x)]) == gen, bar);
            __builtin_amdgcn_fence(__ATOMIC_ACQUIRE, "agent");
            asm volatile("s_waitcnt vmcnt(0)" ::: "memory");
        }
    }
    __syncthreads();
}
struct Args { const float* in[37]; float* out; unsigned char* ws; int ph_lo, ph_hi, li, pad; };
template <class T> __device__ __forceinline__ T* as_global(T* p) { const unsigned long long u = (unsigned long long)p; return (T*)(GAS T*)u; }
struct InPtrs { const float* const* p; __device__ __forceinline__ const float* operator[](int i) const { return as_global(p[i]); } };
struct Ctx { InPtrs in; float* out; unsigned char* ws; LAS unsigned char* lds; int tid, lane, wave, vcu, G, gw, NGW, var; };

__device__ __forceinline__ void tr_item(const float* W, int ldw, int K, const float* gain, bf16* WT, LAS float* scr, int kb, int nb, int lane, int ldo) {
    const int k0 = 64 * kb, n0 = 32 * nb;
    f32x4 v[8];
#pragma unroll
    for (int i = 0; i < 8; ++i) v[i] = __builtin_nontemporal_load((const f32x4*)(W + (size_t)(k0 + 8 * i + (lane >> 3)) * ldw + n0 + 4 * (lane & 7)));
#pragma unroll
    for (int i = 0; i < 8; ++i) { const int kk = 8 * i + (lane >> 3); f32x4 x = v[i]; if (gain) x = x * gain[k0 + kk];
        LAS float* d = scr + kk * 33 + 4 * (lane & 7); d[0] = x[0]; d[1] = x[1]; d[2] = x[2]; d[3] = x[3]; }
    LDS_WAIT(); asm volatile("" ::: "memory");
    const int c = lane & 7;
#pragma unroll
    for (int j = 0; j < 4; ++j) { const int n = (lane >> 3) + 8 * j; const LAS float* s = scr + (8 * c) * 33 + n;
        v4u o; o.x = pk2(s[0 * 33], s[1 * 33]); o.y = pk2(s[2 * 33], s[3 * 33]); o.z = pk2(s[4 * 33], s[5 * 33]); o.w = pk2(s[6 * 33], s[7 * 33]);
        __builtin_nontemporal_store(o, (GAS v4u*)(WT + (size_t)(n0 + n) * ldo + k0 + 8 * c)); }
    LDS_WAIT(); asm volatile("" ::: "memory");
}
__device__ __forceinline__ void tr_job(const Ctx& c, int& base, const float* W, int ldw, int ncols, int K, const float* gain, bf16* WT, LAS float* scr, int ldo = 0) {
    if (ldo == 0) ldo = K;
    const int nblk = ncols / 32, nitems = (K / 64) * nblk;
    int first = (c.gw - base) % c.NGW; if (first < 0) first += c.NGW;
    for (int it = first; it < nitems; it += c.NGW) tr_item(W, ldw, K, gain, WT, scr, it / nblk, it % nblk, c.lane, ldo);
    base = (base + nitems) % c.NGW;
}
__device__ __forceinline__ void sincos_d(double x, double& s, double& c) {
    const double j = __builtin_rint(x * 0.63661977236758134308);
    double r = __builtin_fma(-j, 1.57079632673412561417e+00, x); r = __builtin_fma(-j, 6.07710050650619224932e-11, r);
    const double z = r * r;
    const double sp = r + r * z * (-1.66666666666666307295e-1 + z * (8.33333333332211858878e-3 + z * (-1.98412698295895385996e-4 + z * (2.75573136213857245213e-6 + z * (-2.50507477628578072866e-8 + z * 1.58962301576546568060e-10)))));
    const double cp = 1.0 - 0.5 * z + z * z * (4.16666666666665929218e-2 + z * (-1.38888888888730564116e-3 + z * (2.48015872888517045348e-5 + z * (-2.75573141792967388112e-7 + z * (2.08757008419747316778e-9 + z * -1.13585365213876817300e-11)))));
    const int q = ((int)j) & 3;
    s = (q == 0) ? sp : (q == 1) ? cp : (q == 2) ? -sp : -cp;
    c = (q == 0) ? cp : (q == 1) ? -sp : (q == 2) ? -cp : sp;
}
__device__ __forceinline__ void p0_weights_rest(const Ctx& c) {
    LAS float* scr = (LAS float*)(c.lds + RING_OFF + c.wave * 16384);
    const InPtrs in = c.in; unsigned char* ws = c.ws;
    bf16* Wb = (bf16*)(ws + WS_W);
    int base = 0;
    for (int e = 0; e < 2; ++e) {
        if (e == 1) { const float* w = in[8] + (size_t)e * 1024 * 2064; const float* g = in[7] + e * 1024; bf16* dst = (bf16*)((unsigned char*)Wb + W_INE) + (size_t)e * NIN_E * 1024;
            tr_job(c, base, w, 2064, 1536, 1024, g, dst, scr);
            tr_job(c, base, w + 1552, 2064, 512, 1024, g, dst + (size_t)1536 * 1024, scr); }
        tr_job(c, base, in[20] + (size_t)e * 512 * 512, 512, 512, 512, nullptr, (bf16*)((unsigned char*)Wb + W_GLU) + (size_t)e * 512 * 512, scr);
        tr_job(c, base, in[22] + (size_t)e * 1024 * 1024, 1024, 1024, 1024, nullptr, (bf16*)((unsigned char*)Wb + W_OUTE) + (size_t)e * 1024 * 1024, scr);
    }
    for (int o = 0; o < 2; ++o) {
        tr_job(c, base, in[24] + (size_t)o * 1024 * 2048, 2048, 2048, 1024, in[23] + o * 1024, (bf16*)((unsigned char*)Wb + W_INO) + (size_t)o * 2048 * 1024, scr);
        tr_job(c, base, in[32] + (size_t)o * 1024 * 1024, 1024, 1024, 1024, nullptr, (bf16*)((unsigned char*)Wb + W_OUTO) + (size_t)o * 1024 * 1024, scr);
        for (int n = 0; n < 8; ++n) {
            bf16* dst = (bf16*)((unsigned char*)Wb + W_G) + ((size_t)o * 8 + n) * 256 * 128;
            tr_job(c, base, in[27] + ((size_t)o * 8 + n) * 128 * 128, 128, 128, 128, nullptr, dst, scr);
            tr_job(c, base, in[29] + ((size_t)o * 8 + n) * 128 * 128, 128, 128, 128, nullptr, dst + 128 * 128, scr);
        }
    }
    for (int l = 0; l < 4; ++l) {
        tr_job(c, base, in[34] + (size_t)l * 1024 * 4096, 4096, 4096, 1024, in[33] + l * 1024, (bf16*)((unsigned char*)Wb + W_UP) + (size_t)l * 4096 * 1024, scr);
        tr_job(c, base, in[35] + (size_t)l * 4096 * 1024, 1024, 1024, 4096, nullptr, (bf16*)((unsigned char*)Wb + W_DN) + (size_t)l * 1024 * LD_FF, scr, LD_FF);
    }
    __syncthreads();
}
__device__ __forceinline__ void p0_prologue(const Ctx& c) {
    LAS float* scr = (LAS float*)(c.lds + RING_OFF + c.wave * 16384);
    const InPtrs in = c.in; unsigned char* ws = c.ws;
    bf16* Wb = (bf16*)(ws + WS_W);
    int base = 0;
    { const float* w = in[8]; const float* g = in[7]; bf16* dst = (bf16*)((unsigned char*)Wb + W_INE);
      tr_job(c, base, w, 2064, 1536, 1024, g, dst, scr);
      tr_job(c, base, w + 1552, 2064, 512, 1024, g, dst + (size_t)1536 * 1024, scr); }
    const int gtid = c.vcu * (NWAVES * 64) + c.tid, NT = c.G * NWAVES * 64;
    for (int i = gtid; i < 2 * 16 * 128; i += NT) {
        const int e = i >> 11, j = (i >> 7) & 15, k0 = (i & 127) * 8; const float* w = in[8] + (size_t)e * 1024 * 2064 + 1536 + j; const float* g = in[7] + e * 1024;
        float o[8];
#pragma unroll
        for (int kk = 0; kk < 8; ++kk) o[kk] = w[(size_t)(k0 + kk) * 2064] * g[k0 + kk];
        v4u pk; pk.x = pk2(o[0], o[1]); pk.y = pk2(o[2], o[3]); pk.z = pk2(o[4], o[5]); pk.w = pk2(o[6], o[7]);
        *(v4u*)((bf16*)(ws + WS_WA) + ((size_t)e * 16 + j) * 1024 + k0) = pk;
    }
    for (int i = gtid; i < 2 * 256 * 2; i += NT) {
        const int e = i >> 9, n = (i >> 1) & 255, j0 = (i & 1) * 8; const float* a2 = in[9] + (size_t)e * 16 * 256 + n;
        float o[8];
#pragma unroll
        for (int jj = 0; jj < 8; ++jj) o[jj] = a2[(size_t)(j0 + jj) * 256];
        v4u pk; pk.x = pk2(o[0], o[1]); pk.y = pk2(o[2], o[3]); pk.z = pk2(o[4], o[5]); pk.w = pk2(o[6], o[7]);
        *(v4u*)((bf16*)(ws + WS_WA) + 2 * 16 * 1024 + ((size_t)e * 256 + n) * 16 + j0) = pk;
    }
    for (int i = gtid; i < 2 * 32 * 64; i += NT) {
        const double dt = exp((double)in[14][i >> 6]);
        const double are = (double)in[12][i], aim = (double)in[13][i];
        const double zr = dt * are, zi = dt * aim; double sn, cs; sincos_d(zi, sn, cs);
        const double mag = exp(zr), abre = mag * cs, abim = mag * sn;
        double sh, ch; sincos_d(0.5 * zi, sh, ch);
        const double m1re = expm1(zr) * cs - 2.0 * sh * sh, m1im = abim;
        const double den = are * are + aim * aim;
        const double cre = (m1re * are + m1im * aim) / den, cim = (m1im * are - m1re * aim) / den;
        float* AB = (float*)(ws + CTL_S5AB); AB[2 * i] = (float)abre; AB[2 * i + 1] = (float)abim;
        float* BRE = (float*)(ws + CTL_S5BRE) + (size_t)i * 16; float* BIM = (float*)(ws + CTL_S5BIM) + (size_t)i * 16;
        const float* bre = in[15] + (size_t)i * 16; const float* bim = in[16] + (size_t)i * 16;
#pragma unroll
        for (int q = 0; q < 16; ++q) { const double br = bre[q], bi = bim[q]; BRE[q] = (float)(cre * br - cim * bi); BIM[q] = (float)(cre * bi + cim * br); }
    }
    bf16* XB = (bf16*)(ws + WS_XB); float* ssq0 = (float*)(ws + WS_SSQ);
    for (int m = c.gw; m < T; m += c.NGW) {
        const float* xr = (m < TP) ? in[0] + (size_t)m * D : in[1] + (size_t)(m - TP) * D;
        const GAS f32x4* x4 = (const GAS f32x4*)xr + c.lane; f32x4 v[4]; float s = 0.f;
#pragma unroll
        for (int j = 0; j < 4; ++j) { v[j] = __builtin_nontemporal_load(x4 + 64 * j); s += (v[j].x * v[j].x + v[j].y * v[j].y) + (v[j].z * v[j].z + v[j].w * v[j].w); }
        s = wave_sum(s);
        GAS v2u* o8 = (GAS v2u*)(XB + (size_t)m * D) + c.lane;
#pragma unroll
        for (int j = 0; j < 4; ++j) { v2u w; w.x = pk2(v[j].x, v[j].y); w.y = pk2(v[j].z, v[j].w); o8[64 * j] = w; }
        if (c.lane < 4) ssq0[(size_t)c.lane * T + m] = (c.lane == 0) ? s : 0.f;
    }
}
__device__ __forceinline__ void gla_naive_block(const Ctx& c, int e, int item0, bool sample) {
    unsigned char* ws = c.ws;
    const bf16* P = (const bf16*)(ws + WS_R + R_P); const float* LA = (const float*)(ws + WS_R + R_LA); bf16* ORAW = (bf16*)(ws + WS_R + R_ORAW);
    const int sub = c.tid >> 7, st = c.tid & 127, item = item0 + sub, b = item >> 2, h = item & 3;
    const int row0 = sample ? TP + b * 4 : b * 2048, n = sample ? 4 : 2048;
    float S[64];
    if (sample) { const float* s0 = c.in[2] + (((size_t)e * 128 + b) * 4 + h) * 8192;
#pragma unroll
        for (int d = 0; d < 64; ++d) S[d] = s0[d * 128 + st]; }
    else {
#pragma unroll
        for (int d = 0; d < 64; ++d) S[d] = 0.f; }
    LAS float* lq = (LAS float*)(c.lds + RING_OFF) + sub * 5120; LAS float* lk = lq + 1024; LAS float* la = lq + 2048; LAS float* lv = lq + 3072;
    for (int t0 = 0; t0 < n; t0 += 16) {
        const int nt = (n - t0) < 16 ? (n - t0) : 16;
        __syncthreads();
#pragma unroll
        for (int i = 0; i < 8; ++i) { const int idx = st + 128 * i, tt = idx >> 6, d = idx & 63;
            if (tt < nt) { const size_t row = (size_t)(row0 + t0 + tt);
                lq[idx] = bf2f(P[row * 2048 + h * 64 + d]); lk[idx] = bf2f(P[row * 2048 + 256 + h * 64 + d]); la[idx] = __expf(LA[row * 256 + h * 64 + d]); } }
#pragma unroll
        for (int tt = 0; tt < 16; ++tt) if (tt < nt) lv[tt * 128 + st] = bf2f(P[(size_t)(row0 + t0 + tt) * 2048 + 512 + h * 128 + st]);
        __syncthreads();
#pragma unroll 1
        for (int tt = 0; tt < nt; ++tt) {
            const float v = lv[tt * 128 + st]; float o = 0.f;
#pragma unroll
            for (int d4 = 0; d4 < 16; ++d4) { const f32x4 a4 = *(const LAS f32x4*)(la + tt * 64 + 4 * d4), k4 = *(const LAS f32x4*)(lk + tt * 64 + 4 * d4), q4 = *(const LAS f32x4*)(lq + tt * 64 + 4 * d4);
#pragma unroll
                for (int i = 0; i < 4; ++i) { S[4 * d4 + i] = a4[i] * S[4 * d4 + i] + k4[i] * v; o += q4[i] * S[4 * d4 + i]; } }
            ORAW[(size_t)(row0 + t0 + tt) * 512 + h * 128 + st] = (bf16)f2bf(o * 0.125f);
        }
    }
    float* dst = c.out + (sample ? OUT_GLAS + (((size_t)e * 128 + b) * 4 + h) * 8192 : OUT_GLAP + (((size_t)e * 8 + b) * 4 + h) * 8192);
#pragma unroll
    for (int d = 0; d < 64; ++d) dst[d * 128 + st] = S[d];
}
__device__ __forceinline__ void s5_naive_wave(const Ctx& c, int e, int item, bool sample, LAS float* wl) {
    unsigned char* ws = c.ws; const int lane = c.lane;
    const bf16* P = (const bf16*)(ws + WS_R + R_P); bf16* Z1 = (bf16*)(ws + WS_R + R_Z1);
    const int b = item >> 5, g = item & 31, row0 = sample ? TP + b * 4 : b * 2048, n = sample ? 4 : 2048;
    const int idx = (e * 32 + g) * 64 + lane;
    const float* AB = (const float*)(ws + CTL_S5AB); const float ar = AB[2 * idx], ai = AB[2 * idx + 1];
    float bre[16], bim[16];
    { const f32x4* r4 = (const f32x4*)((const float*)(ws + CTL_S5BRE) + (size_t)idx * 16); const f32x4* i4 = (const f32x4*)((const float*)(ws + CTL_S5BIM) + (size_t)idx * 16);
#pragma unroll
      for (int q = 0; q < 4; ++q) { const f32x4 a = r4[q], bb = i4[q];
#pragma unroll
          for (int j = 0; j < 4; ++j) { bre[4 * q + j] = a[j]; bim[4 * q + j] = bb[j]; } } }
    float hre = 0.f, him = 0.f;
    if (sample) { hre = c.in[3][(((size_t)e * 128 + b) * 32 + g) * 64 + lane]; him = c.in[4][(((size_t)e * 128 + b) * 32 + g) * 64 + lane]; }
    LAS float* lcre = wl; LAS float* lcim = wl + 1024; LAS float* lu = wl + 2048; LAS float* hs = wl + 2176;
    { const float* cr = c.in[17] + (size_t)(e * 32 + g) * 1024; const float* ci = c.in[18] + (size_t)(e * 32 + g) * 1024;
#pragma unroll
      for (int i = 0; i < 16; ++i) { lcre[i * 64 + lane] = cr[i * 64 + lane]; lcim[i * 64 + lane] = ci[i * 64 + lane]; } }
    const int ott = lane >> 3, oc0 = 2 * (lane & 7);
    const float dsk0 = c.in[19][(e * 32 + g) * 16 + oc0], dsk1 = c.in[19][(e * 32 + g) * 16 + oc0 + 1];
    for (int t0 = 0; t0 < n; t0 += 8) {
        const int nt = (n - t0) < 8 ? (n - t0) : 8;
#pragma unroll
        for (int i = 0; i < 2; ++i) { const int ix = lane + 64 * i, tt = ix >> 4, cc = ix & 15;
            lu[ix] = (tt < nt) ? bf2f(P[(size_t)(row0 + t0 + tt) * 2048 + 1536 + g * 16 + cc]) : 0.f; }
        LDS_WAIT(); asm volatile("" ::: "memory");
#pragma unroll
        for (int tt = 0; tt < 8; ++tt) {
            if (tt < nt) {
                float bur = 0.f, bui = 0.f;
#pragma unroll
                for (int q = 0; q < 4; ++q) { const f32x4 u4 = *(const LAS f32x4*)(lu + tt * 16 + 4 * q);
#pragma unroll
                    for (int j = 0; j < 4; ++j) { bur += u4[j] * bre[4 * q + j]; bui += u4[j] * bim[4 * q + j]; } }
                const float nre = ar * hre - ai * him + bur, nim = ar * him + ai * hre + bui; hre = nre; him = nim;
                hs[tt * 128 + lane] = hre; hs[tt * 128 + 64 + lane] = him;
            }
        }
        LDS_WAIT(); asm volatile("" ::: "memory");
        if (ott < nt) {
            float y0 = 0.f, y1 = 0.f;
#pragma unroll
            for (int p4 = 0; p4 < 16; ++p4) {
                const f32x4 hr = *(const LAS f32x4*)(hs + ott * 128 + 4 * p4), hi = *(const LAS f32x4*)(hs + ott * 128 + 64 + 4 * p4);
                const f32x4 c0r = *(const LAS f32x4*)(lcre + oc0 * 64 + 4 * p4), c0i = *(const LAS f32x4*)(lcim + oc0 * 64 + 4 * p4);
                const f32x4 c1r = *(const LAS f32x4*)(lcre + (oc0 + 1) * 64 + 4 * p4), c1i = *(const LAS f32x4*)(lcim + (oc0 + 1) * 64 + 4 * p4);
#pragma unroll
                for (int j = 0; j < 4; ++j) { y0 += hr[j] * c0r[j] - hi[j] * c0i[j]; y1 += hr[j] * c1r[j] - hi[j] * c1i[j]; }
            }
            y0 += dsk0 * lu[ott * 16 + oc0]; y1 += dsk1 * lu[ott * 16 + oc0 + 1];
            *(unsigned*)(Z1 + (size_t)(row0 + t0 + ott) * 512 + g * 16 + oc0) = pk2(gelu_tanh_f(y0), gelu_tanh_f(y1));
        }
        LDS_WAIT(); asm volatile("" ::: "memory");
    }
    float* dre = c.out + (sample ? OUT_RES + (((size_t)e * 128 + b) * 32 + g) * 64 : OUT_REP + (((size_t)e * 8 + b) * 32 + g) * 64);
    float* dim = c.out + (sample ? OUT_IMS + (((size_t)e * 128 + b) * 32 + g) * 64 : OUT_IMP + (((size_t)e * 8 + b) * 32 + g) * 64);
    dre[lane] = hre; dim[lane] = him;
}
__device__ __forceinline__ void gla_post(const Ctx& c, int e) {
    unsigned char* ws = c.ws; const int lane = c.lane;
    const bf16* P = (const bf16*)(ws + WS_R + R_P); const bf16* ORAW = (const bf16*)(ws + WS_R + R_ORAW); bf16* MIX = (bf16*)(ws + WS_R + R_MIX);
    const float* gn = c.in[11] + e * 512;
    for (int wi = TP * 4 + c.gw; wi < T * 4; wi += c.NGW) {
        const int row = wi >> 2, h = wi & 3;
        const unsigned ow = *(const unsigned*)(ORAW + (size_t)row * 512 + h * 128 + 2 * lane);
        const float o0 = bflo(ow), o1 = bfhi(ow);
        const float ss = wave_sum(o0 * o0 + o1 * o1), rs = rsqrtf(ss * (1.0f / 128.0f) + EPS);
        const unsigned gw = *(const unsigned*)(P + (size_t)row * 2048 + 1024 + h * 128 + 2 * lane);
        *(unsigned*)(MIX + (size_t)row * 1024 + h * 128 + 2 * lane) = pk2(o0 * rs * gn[h * 128 + 2 * lane] * bflo(gw), o1 * rs * gn[h * 128 + 2 * lane + 1] * bfhi(gw));
    }
}
__device__ __forceinline__ void final_norm(const Ctx& c) {
    const float* nf = c.in[36]; const bf16* XB = (const bf16*)(c.ws + WS_XB);
    for (int m = c.gw; m < T; m += c.NGW) {
        const v4u* x8 = (const v4u*)(XB + (size_t)m * D) + c.lane; float v[16]; float s = 0.f;
#pragma unroll
        for (int j = 0; j < 2; ++j) { const v4u w = x8[64 * j];
#pragma unroll
            for (int q = 0; q < 4; ++q) { v[8 * j + 2 * q] = bflo(w[q]); v[8 * j + 2 * q + 1] = bfhi(w[q]); } }
#pragma unroll
        for (int i = 0; i < 16; ++i) s += v[i] * v[i];
        const float rs = rsqrtf(wave_sum(s) * (1.0f / 1024.0f) + EPS);
#pragma unroll
        for (int j = 0; j < 2; ++j) { const int col = 512 * j + 8 * c.lane; const f32x4 g0 = *(const f32x4*)(nf + col), g1 = *(const f32x4*)(nf + col + 4);
            f32x4 o0, o1;
#pragma unroll
            for (int q = 0; q < 4; ++q) { o0[q] = v[8 * j + q] * rs * g0[q]; o1[q] = v[8 * j + 4 + q] * rs * g1[q]; }
            *(f32x4*)(c.out + (size_t)m * D + col) = o0; *(f32x4*)(c.out + (size_t)m * D + col + 4) = o1; }
    }
}
typedef float f32x16 __attribute__((ext_vector_type(16)));
typedef short s16x4 __attribute__((ext_vector_type(4)));
typedef float f32x2_t __attribute__((ext_vector_type(2)));
typedef __bf16 bf16x2_t __attribute__((ext_vector_type(2)));
#define MFMA32(a, b, c) __builtin_amdgcn_mfma_f32_32x32x16_bf16((a), (b), (c), 0, 0, 0)
__device__ __forceinline__ unsigned cvtpk(float lo, float hi) { f32x2_t v = {lo, hi}; bf16x2_t b = __builtin_convertvector(v, bf16x2_t); return __builtin_bit_cast(unsigned, b); }
template <int S_> __device__ __forceinline__ bf16x8 pack_step(const f32x16& x) {
    v4u p; p.x = cvtpk(x[8 * S_], x[8 * S_ + 1]); p.y = cvtpk(x[8 * S_ + 2], x[8 * S_ + 3]); p.z = cvtpk(x[8 * S_ + 4], x[8 * S_ + 5]); p.w = cvtpk(x[8 * S_ + 6], x[8 * S_ + 7]);
    return __builtin_bit_cast(bf16x8, p);
}
__device__ __forceinline__ s16x4 trr(const LAS unsigned char* p) { return __builtin_bit_cast(s16x4, __builtin_amdgcn_ds_read_tr16_b64_v4i16((LAS s16x4*)p)); }
__device__ __forceinline__ bf16x8 cat8(s16x4 lo, s16x4 hi) { return __builtin_shufflevector(lo, hi, 0, 1, 2, 3, 4, 5, 6, 7); }
__device__ __forceinline__ bf16x8 cat8u(v2u lo, v2u hi) { v4u w; w.x = lo.x; w.y = lo.y; w.z = hi.x; w.w = hi.y; return __builtin_bit_cast(bf16x8, w); }
constexpr int GL_PQ = 144, GL_PV = 320, GL_PSG = 272;
constexpr int GL_QS = 0, GL_KS = 32 * GL_PQ, GL_V = 2 * 32 * GL_PQ, GL_SG = GL_V + 32 * GL_PV, GL_EL = GL_SG + 32 * GL_PSG, GL_BUF = GL_EL + 256;
constexpr int GL_TOT = 2 * GL_BUF, GL_PART = GL_TOT + 2048, GL_END = GL_PART + 512;
static_assert(GL_BUF % 16 == 0 && GL_END <= RING_BYTES, "GLA LDS map");

__device__ __forceinline__ void gla_fast_block(const Ctx& c, int e, int item) {
    unsigned char* ws = c.ws;
    const bf16* P = (const bf16*)(ws + WS_R + R_P); const float* LA = (const float*)(ws + WS_R + R_LA); bf16* MIX = (bf16*)(ws + WS_R + R_MIX);
    const int b = item >> 2, hh = item & 3, row0 = b * 2048;
    const int lane = c.lane, r32 = lane & 31, h = lane >> 5, wv = c.wave;
    LAS unsigned char* L = c.lds + RING_OFF;
    const int i16 = lane & 15, tq = i16 >> 2, tp = i16 & 3, blk = (lane >> 4) & 1;
    const bool consumer = wv < 4;
    if (consumer) {
        const int et = wv & 3;
        f32x16 S0, S1, O;
#pragma unroll
        for (int r = 0; r < 16; ++r) { S0[r] = 0.f; S1[r] = 0.f; }
        float gh[16];
#pragma unroll
        for (int r = 0; r < 16; ++r) gh[r] = c.in[11][e * 512 + hh * 128 + 32 * et + (r & 3) + 8 * (r >> 2) + 4 * h];
        __syncthreads(); __syncthreads();
        for (int n = 0; n < 64; ++n) {
            const int bo = (n & 1) * GL_BUF;
            float rs = 0.f;
            const LAS unsigned char* Qs = L + bo + GL_QS; const LAS unsigned char* Ks = L + bo + GL_KS; const LAS unsigned char* Vi = L + bo + GL_V;
            f32x16 X;
#pragma unroll
            for (int r = 0; r < 16; ++r) X[r] = 0.f;
#pragma unroll
            for (int s = 0; s < 4; ++s) { const bf16x8 ka = *(const LAS bf16x8*)(Ks + r32 * GL_PQ + 32 * s + 16 * h), qb = *(const LAS bf16x8*)(Qs + r32 * GL_PQ + 32 * s + 16 * h); X = MFMA32(ka, qb, X); }
#pragma unroll
            for (int r = 0; r < 16; ++r) { const int j = (r & 3) + 8 * (r >> 2) + 4 * h; X[r] = (j <= r32) ? X[r] : 0.f; }
            const bf16x8 px0 = pack_step<0>(X), px1 = pack_step<1>(X);
#pragma unroll
            for (int r = 0; r < 16; ++r) O[r] = 0.f;
            { const LAS unsigned char* vb = Vi + (4 * h + tq) * GL_PV + (32 * et + 16 * blk + 4 * tp) * 2;
              const bf16x8 a0 = cat8(trr(vb), trr(vb + 8 * GL_PV)), a1 = cat8(trr(vb + 16 * GL_PV), trr(vb + 24 * GL_PV));
              O = MFMA32(a0, px0, O); O = MFMA32(a1, px1, O); }
            { const LAS unsigned char* qp = Qs + r32 * GL_PQ + 8 * h;
              const bf16x8 sa0 = pack_step<0>(S0), sa1 = pack_step<1>(S0), sa2 = pack_step<0>(S1), sa3 = pack_step<1>(S1);
              const bf16x8 b0 = cat8u(*(const LAS v2u*)(qp), *(const LAS v2u*)(qp + 16)), b1 = cat8u(*(const LAS v2u*)(qp + 32), *(const LAS v2u*)(qp + 48));
              const bf16x8 b2 = cat8u(*(const LAS v2u*)(qp + 64), *(const LAS v2u*)(qp + 80)), b3 = cat8u(*(const LAS v2u*)(qp + 96), *(const LAS v2u*)(qp + 112));
              O = MFMA32(sa0, b0, O); O = MFMA32(sa1, b1, O); O = MFMA32(sa2, b2, O); O = MFMA32(sa3, b3, O); }
            { const LAS unsigned char* kb = Ks + (8 * h + tq) * GL_PQ + (16 * blk + 4 * tp) * 2; const LAS unsigned char* vb = Vi + (8 * h + tq) * GL_PV + (32 * et + 16 * blk + 4 * tp) * 2;
              const bf16x8 v0 = cat8(trr(vb), trr(vb + 4 * GL_PV)), v1 = cat8(trr(vb + 16 * GL_PV), trr(vb + 20 * GL_PV));
              const bf16x8 k00 = cat8(trr(kb), trr(kb + 4 * GL_PQ)), k01 = cat8(trr(kb + 16 * GL_PQ), trr(kb + 20 * GL_PQ));
              const bf16x8 k10 = cat8(trr(kb + 64), trr(kb + 64 + 4 * GL_PQ)), k11 = cat8(trr(kb + 64 + 16 * GL_PQ), trr(kb + 64 + 20 * GL_PQ));
              S0 = MFMA32(k00, v0, S0); S0 = MFMA32(k01, v1, S0); S1 = MFMA32(k10, v0, S1); S1 = MFMA32(k11, v1, S1);
              const LAS float* el = (const LAS float*)(L + bo + GL_EL);
#pragma unroll
              for (int g4 = 0; g4 < 4; ++g4) { const f32x4 f0 = *(const LAS f32x4*)(el + 8 * g4 + 4 * h), f1 = *(const LAS f32x4*)(el + 32 + 8 * g4 + 4 * h);
#pragma unroll
                  for (int q = 0; q < 4; ++q) { S0[4 * g4 + q] *= f0[q]; S1[4 * g4 + q] *= f1[q]; } } }
            float ss = 0.f;
#pragma unroll
            for (int r = 0; r < 16; ++r) ss += O[r] * O[r];
            ss += __shfl_xor(ss, 32);
            if (h == 0) *(LAS float*)(L + GL_PART + (et * 32 + r32) * 4) = ss;
            __syncthreads();
            const LAS float* part = (const LAS float*)(L + GL_PART);
            const float tot = (part[r32] + part[32 + r32]) + (part[64 + r32] + part[96 + r32]);
            rs = rsqrtf(tot * (1.0f / 128.0f) + EPS);
            const LAS unsigned char* sgp = L + bo + GL_SG + r32 * GL_PSG + (32 * et + 4 * h) * 2;
            bf16* dst = MIX + (size_t)(row0 + 32 * n + r32) * 1024 + hh * 128 + 32 * et + 4 * h;
#pragma unroll
            for (int g4 = 0; g4 < 4; ++g4) { const v2u sg = *(const LAS v2u*)(sgp + 16 * g4);
                v2u ov; ov.x = cvtpk(O[4 * g4] * rs * gh[4 * g4] * bflo(sg.x), O[4 * g4 + 1] * rs * gh[4 * g4 + 1] * bfhi(sg.x));
                ov.y = cvtpk(O[4 * g4 + 2] * rs * gh[4 * g4 + 2] * bflo(sg.y), O[4 * g4 + 3] * rs * gh[4 * g4 + 3] * bfhi(sg.y));
                *(v2u*)(dst + 8 * g4) = ov; }
            __syncthreads();
        }
        float* dst = c.out + OUT_GLAP + (((size_t)e * 8 + b) * 4 + hh) * 8192 + 32 * et + r32;
#pragma unroll
        for (int r = 0; r < 16; ++r) { const int d = (r & 3) + 8 * (r >> 2) + 4 * h; dst[(size_t)d * 128] = S0[r]; dst[(size_t)(32 + d) * 128] = S1[r]; }
    } else {
        const int pt = c.tid - 256, dp = pt & 31, jq = (pt >> 5) & 7;
        f32x2_t la2[4][4]; unsigned q2[4][4], k2[4][4]; v4u vraw[4][2], graw[4][2];
        float cs0[4], cs1[4];
#define GLA_LOAD(chunk, RS) do { const size_t rb_ = (size_t)(row0 + 32 * (chunk)); \
        _Pragma("unroll") for (int j_ = 0; j_ < 4; ++j_) { const size_t rw_ = rb_ + 4 * jq + j_; \
            la2[RS][j_] = *(const f32x2_t*)(LA + rw_ * 256 + hh * 64 + 2 * dp); q2[RS][j_] = *(const unsigned*)(P + rw_ * 2048 + hh * 64 + 2 * dp); k2[RS][j_] = *(const unsigned*)(P + rw_ * 2048 + 256 + hh * 64 + 2 * dp); } \
        _Pragma("unroll") for (int x_ = 0; x_ < 2; ++x_) { const int pc_ = pt + 256 * x_, j_ = pc_ >> 4, e8_ = pc_ & 15; \
            vraw[RS][x_] = *(const v4u*)(P + (rb_ + j_) * 2048 + 512 + hh * 128 + 8 * e8_); graw[RS][x_] = *(const v4u*)(P + (rb_ + j_) * 2048 + 1024 + hh * 128 + 8 * e8_); } } while (0)
#define GLA_PROD1(bufo, RS) do { \
        _Pragma("unroll") for (int x_ = 0; x_ < 2; ++x_) { const int pc_ = pt + 256 * x_, j_ = pc_ >> 4, e8_ = pc_ & 15; \
            *(LAS v4u*)(L + (bufo) + GL_V + j_ * GL_PV + 16 * e8_) = vraw[RS][x_]; *(LAS v4u*)(L + (bufo) + GL_SG + j_ * GL_PSG + 16 * e8_) = graw[RS][x_]; } \
        cs0[0] = la2[RS][0].x; cs1[0] = la2[RS][0].y; \
        _Pragma("unroll") for (int j_ = 1; j_ < 4; ++j_) { cs0[j_] = cs0[j_ - 1] + la2[RS][j_].x; cs1[j_] = cs1[j_ - 1] + la2[RS][j_].y; } \
        *(LAS f32x2_t*)(L + GL_TOT + (jq * 64 + 2 * dp) * 4) = (f32x2_t){cs0[3], cs1[3]}; } while (0)
#define GLA_PROD2(bufo, RS) do { float p0_ = 0.f, p1_ = 0.f, t0_ = 0.f, t1_ = 0.f; \
        _Pragma("unroll") for (int g_ = 0; g_ < 8; ++g_) { const f32x2_t tv_ = *(const LAS f32x2_t*)(L + GL_TOT + (g_ * 64 + 2 * dp) * 4); if (g_ < jq) { p0_ += tv_.x; p1_ += tv_.y; } t0_ += tv_.x; t1_ += tv_.y; } \
        _Pragma("unroll") for (int j_ = 0; j_ < 4; ++j_) { const float c0_ = p0_ + cs0[j_], c1_ = p1_ + cs1[j_]; \
            const float q0_ = bflo(q2[RS][j_]) * __expf(c0_) * 0.125f, q1_ = bfhi(q2[RS][j_]) * __expf(c1_) * 0.125f, k0_ = bflo(k2[RS][j_]) * __expf(-c0_), k1_ = bfhi(k2[RS][j_]) * __expf(-c1_); \
            *(LAS unsigned*)(L + (bufo) + GL_QS + (4 * jq + j_) * GL_PQ + 4 * dp) = cvtpk(q0_, q1_); *(LAS unsigned*)(L + (bufo) + GL_KS + (4 * jq + j_) * GL_PQ + 4 * dp) = cvtpk(k0_, k1_); } \
        if (jq == 0) *(LAS f32x2_t*)(L + (bufo) + GL_EL + 8 * dp) = (f32x2_t){__expf(t0_), __expf(t1_)}; } while (0)

        GLA_LOAD(0, 0); GLA_LOAD(1, 1); GLA_LOAD(2, 2); GLA_LOAD(3, 3); GLA_PROD1(0, 0);
        __syncthreads();
        GLA_PROD2(0, 0);
        __syncthreads();
#define GLA_PITER(n, PAR) do { const int bn = GL_BUF - ((n) & 1) * GL_BUF; \
            if ((n) < 60) GLA_LOAD((n) + 4, PAR); \
            if ((n) < 63) GLA_PROD1(bn, (PAR + 1) & 3); \
            __syncthreads(); \
            if ((n) < 63) GLA_PROD2(bn, (PAR + 1) & 3); \
            __syncthreads(); } while (0)
        for (int nn = 0; nn < 64; nn += 4) { GLA_PITER(nn, 0); GLA_PITER(nn + 1, 1); GLA_PITER(nn + 2, 2); GLA_PITER(nn + 3, 3); }
#undef GLA_PITER
#undef GLA_LOAD
#undef GLA_PROD1
#undef GLA_PROD2
    }
}
constexpr int S5_PBU = 528, S5_PH = 272;
__device__ __forceinline__ float fma_s(float a, float b, float c) { float r; asm("v_fma_f32 %0, %1, %2, %3" : "=v"(r) : "v"(a), "v"(b), "v"(c)); return r; }
constexpr int S5P_ITEM_LDS = 2 * (32 * S5_PBU + 32 * S5_PH);
__device__ __forceinline__ void s5_pipe_block(const Ctx& c, int e, int item0) {
    unsigned char* ws = c.ws; const int lane = c.lane, r32 = lane & 31, h = lane >> 5, wv = c.wave;
    const bf16* P = (const bf16*)(ws + WS_R + R_P); bf16* Z1 = (bf16*)(ws + WS_R + R_Z1);
    const int slot = wv / 3, role = (wv < 6) ? wv - 3 * slot : 3, item = item0 + (slot & 1);
    const int b = item >> 5, g = item & 31, row0 = b * 2048, eg = e * 32 + g;
    LAS unsigned char* BU0 = c.lds + RING_OFF + (slot & 1) * S5P_ITEM_LDS; LAS unsigned char* HB0 = BU0 + 2 * 32 * S5_PBU;
    bf16x8 Bf[4], Cf[8]; float dsk[8]; float ar = 0.f, ai = 0.f, nai = 0.f, hre = 0.f, him = 0.f;
#pragma unroll
    for (int nt = 0; nt < 4; ++nt) Bf[nt] = (bf16x8){0, 0, 0, 0, 0, 0, 0, 0};
#pragma unroll
    for (int s8 = 0; s8 < 8; ++s8) { Cf[s8] = (bf16x8){0, 0, 0, 0, 0, 0, 0, 0}; dsk[s8] = 0.f; }
    if (role == 0) {
#pragma unroll
        for (int nt = 0; nt < 4; ++nt) { const int n = 32 * nt + r32; const float* src = (const float*)(ws + (n < 64 ? CTL_S5BRE : CTL_S5BIM)) + ((size_t)eg * 64 + (n & 63)) * 16 + 8 * h;
            const f32x4 x0 = *(const f32x4*)src, x1 = *(const f32x4*)(src + 4); v4u w; w.x = cvtpk(x0[0], x0[1]); w.y = cvtpk(x0[2], x0[3]); w.z = cvtpk(x1[0], x1[1]); w.w = cvtpk(x1[2], x1[3]); Bf[nt] = __builtin_bit_cast(bf16x8, w); }
    } else if (role == 1) {
        const float* AB = (const float*)(ws + CTL_S5AB); ar = AB[2 * (eg * 64 + lane)]; ai = AB[2 * (eg * 64 + lane) + 1]; nai = -ai;
    } else if (role == 2) {
#pragma unroll
        for (int s8 = 0; s8 < 8; ++s8) { const int n0 = 16 * s8 + 8 * h; v4u w = {0u, 0u, 0u, 0u};
            if (r32 < 16) { const float* src = (n0 < 64 ? c.in[17] : c.in[18]) + ((size_t)eg * 16 + r32) * 64 + (n0 & 63); const float sg = (n0 < 64) ? 1.f : -1.f;
                const f32x4 x0 = *(const f32x4*)src * sg, x1 = *(const f32x4*)(src + 4) * sg; w.x = cvtpk(x0[0], x0[1]); w.y = cvtpk(x0[2], x0[3]); w.z = cvtpk(x1[0], x1[1]); w.w = cvtpk(x1[2], x1[3]); }
            Cf[s8] = __builtin_bit_cast(bf16x8, w); }
#pragma unroll
        for (int r = 0; r < 8; ++r) dsk[r] = c.in[19][eg * 16 + (r & 3) + 8 * (r >> 2) + 4 * h];
    }
    const bf16* up = P + (size_t)row0 * 2048 + 1536 + g * 16 + (size_t)r32 * 2048;
    v4u ucur = {0u, 0u, 0u, 0u}; v2u ua = {0u, 0u}, ub = {0u, 0u};
    if (role == 0) ucur = *(const v4u*)(up + 8 * h);
    for (int step = 0; step < 66; ++step) {
        if (role == 0 && step < 64) {
            const int n = step; LAS unsigned char* BU = BU0 + (n & 1) * 32 * S5_PBU;
            const v4u unext = (n < 63) ? *(const v4u*)(up + 8 * h + (size_t)(n + 1) * 32 * 2048) : ucur;
            const bf16x8 uf = __builtin_bit_cast(bf16x8, ucur);
#pragma unroll
            for (int nt = 0; nt < 4; ++nt) { f32x16 z;
#pragma unroll
                for (int r = 0; r < 16; ++r) z[r] = 0.f;
                const f32x16 d = MFMA32(uf, Bf[nt], z);
#pragma unroll
                for (int r = 0; r < 16; ++r) *(LAS float*)(BU + ((r & 3) + 8 * (r >> 2) + 4 * h) * S5_PBU + (32 * nt + r32) * 4) = d[r]; }
            ucur = unext;
        } else if (role == 1 && step >= 1 && step < 65) {
            const int n = step - 1; const LAS unsigned char* BU = BU0 + (n & 1) * 32 * S5_PBU; LAS unsigned char* HB = HB0 + (n & 1) * 32 * S5_PH;
            float br[32], bi[32];
#pragma unroll
            for (int t = 0; t < 32; ++t) { br[t] = *(const LAS float*)(BU + t * S5_PBU + 4 * lane); bi[t] = *(const LAS float*)(BU + t * S5_PBU + 256 + 4 * lane); }
            asm volatile("s_waitcnt lgkmcnt(0)" ::: "memory");
#pragma unroll
            for (int t = 0; t < 32; ++t) {
                const float t0 = fma_s(ar, hre, br[t]), t1 = fma_s(ar, him, bi[t]); const float nre = fma_s(nai, him, t0), nim = fma_s(ai, hre, t1); hre = nre; him = nim;
                const unsigned pk = cvtpk(hre, him);
                *(LAS bf16*)(HB + t * S5_PH + 2 * lane) = (bf16)(pk & 0xffffu); *(LAS bf16*)(HB + t * S5_PH + 128 + 2 * lane) = (bf16)(pk >> 16); }
        } else if (role == 2) {
            if (step >= 2) {
                const int n = step - 2; const LAS unsigned char* HB = HB0 + (n & 1) * 32 * S5_PH;
                f32x16 y;
#pragma unroll
                for (int r = 0; r < 16; ++r) y[r] = 0.f;
#pragma unroll
                for (int s8 = 0; s8 < 8; ++s8) { const bf16x8 hb = *(const LAS bf16x8*)(HB + r32 * S5_PH + 32 * s8 + 16 * h); y = MFMA32(Cf[s8], hb, y); }
                const float u0 = bflo(ua.x), u1 = bfhi(ua.x), u2 = bflo(ua.y), u3 = bfhi(ua.y), u4 = bflo(ub.x), u5 = bfhi(ub.x), u6 = bflo(ub.y), u7 = bfhi(ub.y);
                v2u o0, o1;
                o0.x = cvtpk(gelu_tanh_f(y[0] + dsk[0] * u0), gelu_tanh_f(y[1] + dsk[1] * u1)); o0.y = cvtpk(gelu_tanh_f(y[2] + dsk[2] * u2), gelu_tanh_f(y[3] + dsk[3] * u3));
                o1.x = cvtpk(gelu_tanh_f(y[4] + dsk[4] * u4), gelu_tanh_f(y[5] + dsk[5] * u5)); o1.y = cvtpk(gelu_tanh_f(y[6] + dsk[6] * u6), gelu_tanh_f(y[7] + dsk[7] * u7));
                bf16* zp = Z1 + (size_t)(row0 + 32 * n + r32) * 512 + g * 16 + 4 * h;
                *(v2u*)zp = o0; *(v2u*)(zp + 8) = o1;
            }
            if (step >= 1 && step < 65) { const bf16* q = up + 4 * h + (size_t)(step - 1) * 32 * 2048; ua = *(const v2u*)q; ub = *(const v2u*)(q + 8); }
        }
        __syncthreads();
    }
    if (role == 1) { c.out[OUT_REP + ((size_t)(e * 8 + b) * 32 + g) * 64 + lane] = hre; c.out[OUT_IMP + ((size_t)(e * 8 + b) * 32 + g) * 64 + lane] = him; }
}
__device__ __forceinline__ void even_mixer_v2(const Ctx& c, int e) {
    const int bid = c.vcu;
    if (bid < 32) { gla_fast_block(c, e, bid); }
    else if (bid < 160) {
        s5_pipe_block(c, e, (bid - 32) * 2);
    }
    else { for (int bi = bid - 160; bi < 128; bi += 96) { gla_naive_block(c, e, bi * 4, true); __syncthreads(); }
           for (int it = (bid - 160) * 8 + c.wave; it < 4096; it += 96 * 8) s5_naive_wave(c, e, it, true, (LAS float*)(c.lds + RING_OFF) + c.wave * 3200); }
}
typedef float f32x16s __attribute__((ext_vector_type(16)));
__device__ __forceinline__ float sq8(const v4u& w) { float s = 0.f;
#pragma unroll
    for (int q = 0; q < 4; ++q) { const float a = bflo(w[q]), b = bfhi(w[q]); s += a * a + b * b; }
    return s; }
template <int TN, bool NORM_A, class Epi> __device__ __forceinline__ void sgemm2(const Ctx& c, const bf16* A, const bf16* Bt, int N, int K, const Epi& E, int first_tile, int tile_stride, int ld = 0) {
    if (ld == 0) ld = K;
    constexpr int ROWS = 64 + TN, NP = ROWS * 16 / 512, PITCH = 272, BUFB = ROWS * PITCH, NSUB = TN / 32, KPARTS = 4 / NSUB, KSTEPS = 8 / KPARTS;
    const int lane = c.lane, r32 = lane & 31, h = lane >> 5, wv = c.wave, tid = c.tid;
    LAS unsigned char* L = c.lds + RING_OFF;
    const int wm = wv & 1, wn = (NSUB == 2) ? ((wv >> 1) & 1) : 0, kp = (NSUB == 2) ? (wv >> 2) : (wv >> 1);
    const int ntiles = 8 * (N / TN), nch = K / 128;
    for (int tile = first_tile; tile < ntiles; tile += tile_stride) {
        const int rb = tile & 7, cb = tile >> 3;
        const unsigned char* src[NP]; int dst[NP];
#pragma unroll
        for (int i = 0; i < NP; ++i) { const int p = tid + 512 * i, row = p >> 4, c16 = p & 15;
            src[i] = (const unsigned char*)((row < 64) ? A + (size_t)(64 * rb + row) * ld : Bt + (size_t)(TN * cb + row - 64) * ld) + 16 * c16; dst[i] = row * PITCH + 16 * c16; }
        v4u ra[NP], rb_[NP], rc_[NP], rd_[NP];
#pragma unroll
        for (int i = 0; i < NP; ++i) { ra[i] = *(const v4u*)(src[i]); rb_[i] = *(const v4u*)(src[i] + 256); rc_[i] = *(const v4u*)(src[i] + 512); rd_[i] = *(const v4u*)(src[i] + 768); }
#pragma unroll
        for (int i = 0; i < NP; ++i) *(LAS v4u*)(L + dst[i]) = ra[i];
        float ssa0 = 0.f, ssa1 = 0.f;
        if (NORM_A) { ssa0 = sq8(ra[0]); ssa1 = sq8(ra[1]); }
        f32x16s acc;
#pragma unroll
        for (int r = 0; r < 16; ++r) acc[r] = 0.f;
        __syncthreads();
#define SG_STEP(ch, RCUR, RNEXT) do { \
            if ((ch) + 4 < nch) { _Pragma("unroll") for (int i = 0; i < NP; ++i) RCUR[i] = *(const v4u*)(src[i] + (size_t)((ch) + 4) * 256); } \
            { const LAS unsigned char* bufp = L + ((ch) & 1) * BUFB; \
              _Pragma("unroll") for (int s = 0; s < KSTEPS; ++s) { const int ks = kp * KSTEPS + s; \
                  const bf16x8 fa = *(const LAS bf16x8*)(bufp + (32 * wm + r32) * PITCH + 32 * ks + 16 * h), fb = *(const LAS bf16x8*)(bufp + (64 + 32 * wn + r32) * PITCH + 32 * ks + 16 * h); \
                  acc = __builtin_amdgcn_mfma_f32_32x32x16_bf16(fa, fb, acc, 0, 0, 0); } } \
            if ((ch) + 1 < nch) { _Pragma("unroll") for (int i = 0; i < NP; ++i) *(LAS v4u*)(L + (((ch) + 1) & 1) * BUFB + dst[i]) = RNEXT[i]; if (NORM_A) { ssa0 += sq8(RNEXT[0]); ssa1 += sq8(RNEXT[1]); } } \
            __syncthreads(); } while (0)
        for (int ch = 0; ch < nch; ch += 4) { SG_STEP(ch, ra, rb_); SG_STEP(ch + 1, rb_, rc_); SG_STEP(ch + 2, rc_, rd_); SG_STEP(ch + 3, rd_, ra); }
#undef SG_STEP
        LAS float* red = (LAS float*)L;
#pragma unroll
        for (int r = 0; r < 16; ++r) red[wv * 1024 + ((r & 3) + 8 * (r >> 2) + 4 * h) * 32 + r32] = acc[r];
        if (NORM_A) {
#pragma unroll
            for (int o = 1; o < 16; o <<= 1) { ssa0 += __shfl_xor(ssa0, o); ssa1 += __shfl_xor(ssa1, o); }
            if ((tid & 15) == 0) { red[8192 + (tid >> 4)] = ssa0; red[8192 + 32 + (tid >> 4)] = ssa1; } }
        __syncthreads();
        if (tid < 64 * (TN / 8)) {
            const int row = tid / (TN / 8), cg = tid % (TN / 8), sm = row >> 5, sn = (8 * cg) >> 5, rr = row & 31, cc = (8 * cg) & 31;
            f32x4 v0 = {0.f, 0.f, 0.f, 0.f}, v1 = {0.f, 0.f, 0.f, 0.f};
#pragma unroll
            for (int q = 0; q < KPARTS; ++q) { const int w = (NSUB == 2) ? (sm + 2 * sn + 4 * q) : (sm + 2 * q);
                v0 = v0 + *(const LAS f32x4*)(red + w * 1024 + rr * 32 + cc); v1 = v1 + *(const LAS f32x4*)(red + w * 1024 + rr * 32 + cc + 4); }
            const int grow = pg8::TP_ROWS + 64 * rb + row; float s = 0.f;
            const float rs = NORM_A ? rsqrtf(red[8192 + row] * (1.0f / 1024.0f) + pg8::EPS_F) : E.row_scale(grow);
            f32x4 cb0, cb1; E.col8(TN * cb + 8 * cg, cb0, cb1);
            const pg8::u32x4 pre = Epi::HAS_PRE ? E.pre8(grow, TN * cb + 8 * cg) : (pg8::u32x4){0u, 0u, 0u, 0u};
            E.row8(grow, TN * cb + 8 * cg, v0, v1, rs, cb0, cb1, pre, s);
        }
        __syncthreads();
    }
}
constexpr int LR_PX = 272, LR_PAB = 264, LR_WAVE = 32 * LR_PX;
constexpr int LR_COMP = 8 * LR_WAVE;
static_assert(32 * LR_PAB <= LR_WAVE && LR_COMP + 4096 + 16384 <= RING_BYTES, "LRU LDS map");
__device__ __forceinline__ void lru_fused(const Ctx& c, int o) {
    unsigned char* ws = c.ws; const int lane = c.lane, r32 = lane & 31, h = lane >> 5, wv = c.wave;
    const bf16* CIN = (const bf16*)(ws + WS_R + R_CIN); const bf16* GT = (const bf16*)(ws + WS_R + R_XC); bf16* HG = (bf16*)(ws + WS_R + R_MIX);
    const int id = c.vcu, b = id >> 5, n = (id >> 2) & 7, cs = id & 3;
    const int chg = 128 * n + 32 * cs + r32;
    LAS unsigned char* XS = c.lds + RING_OFF + wv * LR_WAVE;
    LAS unsigned char* COMP = c.lds + RING_OFF + LR_COMP;
    const bf16* Wg = (const bf16*)(ws + WS_W + W_G) + ((size_t)o * 8 + n) * 256 * 128;
    LAS unsigned char* WF = c.lds + RING_OFF + LR_COMP + 4096;
#pragma unroll
    for (int i = 0; i < 2; ++i) { const int en = c.tid + 512 * i, rw = en >> 9, sk = (en >> 6) & 7, ln = en & 63;
        *(LAS v4u*)(WF + en * 16) = *(const v4u*)(Wg + (size_t)(rw * 128 + 32 * cs + (ln & 31)) * 128 + 16 * sk + 8 * (ln >> 5)); }
    __syncthreads();
    const float brc = c.in[28][o * 1024 + chg], bic = c.in[30][o * 1024 + chg];
    const float sp8 = 8.0f * log1pf(__expf(-c.in[31][o * 1024 + chg]));
    const int c8 = lane & 15, tq = lane >> 4, cch = 128 * n + 8 * c8;
    const float* cw = c.in[25] + (size_t)o * 4 * 1024 + cch; const float* cb = c.in[26] + o * 1024 + cch;
    float hc = 0.f;
    const int ntile = 8 + ((wv < 2) ? 1 : 0);
    for (int tt = 0; tt < 9; ++tt) {
        const bool sample = tt == 8;
        const bool active = tt < ntile;
        const int st = 2 * b + wv;
        const size_t rowb = sample ? (size_t)TP + 32 * st : (size_t)b * 2048 + 256 * tt + 32 * wv;
        float Aw = 1.f, Bw = 0.f, Ao = 1.f, Bo = 0.f;
        unsigned short gt[16];
        if (active) {
            { const size_t orow_ = rowb + 16 * h;
#pragma unroll
              for (int i = 0; i < 16; ++i) gt[i] = GT[(orow_ + i) * 1024 + chg]; }
            { float w0[8], w1[8], w2[8], w3[8], bs[8];
#pragma unroll
              for (int q = 0; q < 2; ++q) { const f32x4 a0 = *(const f32x4*)(cw + 4 * q), a1 = *(const f32x4*)(cw + 1024 + 4 * q), a2 = *(const f32x4*)(cw + 2048 + 4 * q), a3 = *(const f32x4*)(cw + 3072 + 4 * q), bb = *(const f32x4*)(cb + 4 * q);
#pragma unroll
                  for (int i = 0; i < 4; ++i) { w0[4 * q + i] = a0[i]; w1[4 * q + i] = a1[i]; w2[4 * q + i] = a2[i]; w3[4 * q + i] = a3[i]; bs[4 * q + i] = bb[i]; } }
              if (!sample) {
                  v4u xr[11];
#pragma unroll
                  for (int i = 0; i < 11; ++i) { const int tl = 8 * tq + i - 3; xr[i] = (v4u){0u, 0u, 0u, 0u};
                      if (256 * tt + 32 * wv + tl >= 0) xr[i] = *(const v4u*)(CIN + (size_t)((long)rowb + tl) * 1024 + cch); }
#pragma unroll
                  for (int i = 0; i < 8; ++i) { float y[8];
#pragma unroll
                      for (int q = 0; q < 4; ++q) {
                          y[2 * q] = bs[2 * q] + w0[2 * q] * bflo(xr[i][q]) + w1[2 * q] * bflo(xr[i + 1][q]) + w2[2 * q] * bflo(xr[i + 2][q]) + w3[2 * q] * bflo(xr[i + 3][q]);
                          y[2 * q + 1] = bs[2 * q + 1] + w0[2 * q + 1] * bfhi(xr[i][q]) + w1[2 * q + 1] * bfhi(xr[i + 1][q]) + w2[2 * q + 1] * bfhi(xr[i + 2][q]) + w3[2 * q + 1] * bfhi(xr[i + 3][q]); }
                      v4u ov; ov.x = cvtpk(y[0], y[1]); ov.y = cvtpk(y[2], y[3]); ov.z = cvtpk(y[4], y[5]); ov.w = cvtpk(y[6], y[7]);
                      *(LAS v4u*)(XS + (8 * tq + i) * LR_PX + 16 * c8) = ov; }
              } else {
#pragma unroll 1
                  for (int i = 0; i < 8; ++i) {
                      const int bt = 8 * st + 2 * tq + (i >> 2), stp = i & 3; const float* sc = c.in[6] + ((size_t)o * 128 + bt) * 3 * 1024 + cch;
                      float y[8];
#pragma unroll
                      for (int q = 0; q < 8; ++q) y[q] = bs[q];
#pragma unroll
                      for (int j = 0; j < 4; ++j) { const int sj = stp - 3 + j; float x[8];
                          if (sj >= 0) { const v4u x4 = *(const v4u*)(CIN + (rowb + 8 * tq + i - 3 + j) * 1024 + cch);
#pragma unroll
                              for (int q = 0; q < 4; ++q) { x[2 * q] = bflo(x4[q]); x[2 * q + 1] = bfhi(x4[q]); } }
                          else { const f32x4 s0 = *(const f32x4*)(sc + (size_t)(sj + 3) * 1024), s1 = *(const f32x4*)(sc + (size_t)(sj + 3) * 1024 + 4);
#pragma unroll
                              for (int q = 0; q < 4; ++q) { x[q] = s0[q]; x[4 + q] = s1[q]; } }
#pragma unroll
                          for (int q = 0; q < 8; ++q) y[q] += ((j == 0) ? w0[q] : (j == 1) ? w1[q] : (j == 2) ? w2[q] : w3[q]) * x[q]; }
                      v4u ov; ov.x = cvtpk(y[0], y[1]); ov.y = cvtpk(y[2], y[3]); ov.z = cvtpk(y[4], y[5]); ov.w = cvtpk(y[6], y[7]);
                      *(LAS v4u*)(XS + (8 * tq + i) * LR_PX + 16 * c8) = ov; }
              }
            }
            f32x16 accr, acci;
#pragma unroll
            for (int r = 0; r < 16; ++r) { accr[r] = 0.f; acci[r] = 0.f; }
#pragma unroll
            for (int s = 0; s < 8; ++s) { const bf16x8 xa = *(const LAS bf16x8*)(XS + r32 * LR_PX + 32 * s + 16 * h); accr = MFMA32(xa, *(const LAS bf16x8*)(WF + (s * 64 + lane) * 16), accr); acci = MFMA32(xa, *(const LAS bf16x8*)(WF + ((8 + s) * 64 + lane) * 16), acci); }
            float xv[16];
#pragma unroll
            for (int r = 0; r < 16; ++r) xv[r] = bf2f(*(const LAS bf16*)(XS + ((r & 3) + 8 * (r >> 2) + 4 * h) * LR_PX + (32 * cs + r32) * 2));
            asm volatile("s_waitcnt lgkmcnt(0)" ::: "memory");
#pragma unroll
            for (int r = 0; r < 16; ++r) {
                const float rg = sigmoid_f(accr[r] + brc), ig = sigmoid_f(acci[r] + bic);
                const float la = -rg * sp8, a = __expf(la);
                const float bq = __builtin_amdgcn_sqrtf(fmaxf(1.0f - a * a, 0.f)) * ig * xv[r];
                *(LAS f32x2_t*)(XS + ((r & 3) + 8 * (r >> 2) + 4 * h) * LR_PAB + 8 * r32) = (f32x2_t){a, bq};
            }
            asm volatile("s_waitcnt lgkmcnt(0)" ::: "memory");
            if (!sample) {
                float A = 1.f, B = 0.f;
#pragma unroll
                for (int i = 0; i < 16; ++i) { const f32x2_t ab = *(const LAS f32x2_t*)(XS + (16 * h + i) * LR_PAB + 8 * r32); A *= ab.x; B = ab.x * B + ab.y; }
                Ao = __shfl_xor(A, 32); Bo = __shfl_xor(B, 32);
                Aw = A * Ao; Bw = h ? (A * Bo + B) : (Ao * B + Bo);
                if (h == 0) *(LAS f32x2_t*)(COMP + ((tt & 1) * 256 + wv * 32 + r32) * 8) = (f32x2_t){Aw, Bw};
            }
        }
        __syncthreads();
        if (active) {
            float hin;
            if (!sample) {
                float hrun = hc; hin = hc;
#pragma unroll
                for (int w = 0; w < 8; ++w) { const f32x2_t cp = *(const LAS f32x2_t*)(COMP + ((tt & 1) * 256 + w * 32 + r32) * 8); if (w == wv) hin = hrun; hrun = cp.x * hrun + cp.y; }
                hc = hrun;
                if (h) hin = Ao * hin + Bo;
            } else hin = 0.f;
            const size_t orow = rowb + 16 * h;
            float hh = hin;
#pragma unroll
            for (int i = 0; i < 16; ++i) {
                if (sample && (i & 3) == 0) hh = c.in[5][((size_t)o * 128 + 8 * st + 4 * h + (i >> 2)) * 1024 + chg];
                const f32x2_t ab = *(const LAS f32x2_t*)(XS + (16 * h + i) * LR_PAB + 8 * r32);
                hh = ab.x * hh + ab.y;
                HG[(orow + i) * 1024 + chg] = (bf16)cvtpk(bf2f(gt[i]) * hh, 0.f);
                if (sample && (i & 3) == 3) c.out[OUT_LRUS + ((size_t)o * 128 + 8 * st + 4 * h + (i >> 2)) * 1024 + chg] = hh;
            }
            asm volatile("s_waitcnt lgkmcnt(0)" ::: "memory");
        }
    }
    if (wv == 0 && h == 0) c.out[OUT_LRUP + ((size_t)o * 8 + b) * 1024 + chg] = hc;
}
typedef float f32x4g __attribute__((ext_vector_type(4)));
__device__ __forceinline__ void gate_job(const Ctx& c, int e, const float* ssq, int first_tile, int tile_stride) {
    unsigned char* ws = c.ws; const int lane = c.lane, wv = c.wave, l15 = lane & 15, quad = lane >> 4, r32 = lane & 31, h = lane >> 5;
    const bf16* XB = (const bf16*)(ws + WS_XB); float* LA = (float*)(ws + WS_R + R_LA);
    const bf16* WaT = (const bf16*)(ws + WS_WA) + (size_t)e * 16 * 1024;
    const bf16* A2T = (const bf16*)(ws + WS_WA) + 2 * 16 * 1024 + (size_t)e * 256 * 16;
    const float* b_a2 = c.in[10] + e * 256;
    LAS float* part = (LAS float*)(c.lds + RING_OFF);
    LAS bf16* alr = (LAS bf16*)(c.lds + RING_OFF + 32768);
    LAS float* pss = (LAS float*)(c.lds + RING_OFF + 32768 + 2048);
    for (int tile = first_tile; tile < T / 64; tile += tile_stride) {
        const int rowb = 64 * tile;
        bf16x8 bw[4];
#pragma unroll
        for (int s = 0; s < 4; ++s) bw[s] = *(const bf16x8*)(WaT + (size_t)l15 * 1024 + 128 * wv + 32 * s + 8 * quad);
        f32x4g acc[4];
#pragma unroll
        for (int mt = 0; mt < 4; ++mt) { acc[mt] = (f32x4g){0.f, 0.f, 0.f, 0.f};
            bf16x8 xa[4];
#pragma unroll
            for (int s = 0; s < 4; ++s) xa[s] = *(const bf16x8*)(XB + (size_t)(rowb + 16 * mt + l15) * 1024 + 128 * wv + 32 * s + 8 * quad);
#pragma unroll
            for (int s = 0; s < 4; ++s) acc[mt] = __builtin_amdgcn_mfma_f32_16x16x32_bf16(bw[s], xa[s], acc[mt], 0, 0, 0);
            float sq = 0.f;
#pragma unroll
            for (int s = 0; s < 4; ++s) { const v4u w4 = __builtin_bit_cast(v4u, xa[s]);
#pragma unroll
                for (int q = 0; q < 4; ++q) { const float a = bflo(w4[q]), b = bfhi(w4[q]); sq += a * a + b * b; } }
            sq += __shfl_xor(sq, 16); sq += __shfl_xor(sq, 32);
            if (quad == 0) pss[wv * 64 + 16 * mt + l15] = sq; }
#pragma unroll
        for (int mt = 0; mt < 4; ++mt)
#pragma unroll
            for (int q = 0; q < 4; ++q) part[wv * 1024 + (16 * mt + l15) * 16 + 4 * quad + q] = acc[mt][q];
        __syncthreads();
#pragma unroll
        for (int i = 0; i < 2; ++i) { const int idx = c.tid + 512 * i, row = idx >> 4; float s = 0.f;
#pragma unroll
            for (int w = 0; w < 8; ++w) s += part[w * 1024 + idx];
            float sq = 0.f;
#pragma unroll
            for (int w = 0; w < 8; ++w) sq += pss[w * 64 + row];
            const float rs = rsqrtf(sq * (1.0f / 1024.0f) + EPS);
            alr[idx] = (bf16)f2bf(s * rs); }
        __syncthreads();
        { const int rh = wv & 1;
          v4u aw = *(const LAS v4u*)(alr + (32 * rh + r32) * 16 + 8 * h); const bf16x8 af = __builtin_bit_cast(bf16x8, aw);
#pragma unroll
          for (int ct = 0; ct < 2; ++ct) { const int n = 32 * (2 * (wv >> 1) + ct) + r32;
              const bf16x8 bf = *(const bf16x8*)(A2T + (size_t)n * 16 + 8 * h);
              f32x16 z;
#pragma unroll
              for (int r = 0; r < 16; ++r) z[r] = 0.f;
              const f32x16 d = MFMA32(af, bf, z);
              const float bn = b_a2[n];
#pragma unroll
              for (int r = 0; r < 16; ++r) { const int row = rowb + 32 * rh + (r & 3) + 8 * (r >> 2) + 4 * h;
                  LA[(size_t)row * 256 + n] = pg8::logsigmoid_f(d[r] + bn) * 0.0625f; } } }
        __syncthreads();
    }
}
#ifndef REP_PROL
#define REP_PROL 1
#endif
#ifndef REP_IN
#define REP_IN 1
#endif
#ifndef REP_EMIX
#define REP_EMIX 1
#endif
#ifndef REP_GLU
#define REP_GLU 1
#endif
#ifndef REP_CONV
#define REP_CONV 1
#endif
#ifndef REP_GATES
#define REP_GATES 1
#endif
#ifndef REP_UP
#define REP_UP 1
#endif
#ifndef REP_LRU
#define REP_LRU 1
#endif
constexpr int N_PHASES = 24;
__global__ void __launch_bounds__(NWAVES * 64, 2) mk_fwd(Args args) {
    extern __shared__ __attribute__((aligned(16))) unsigned char lds_raw[];
    const int wave_s_ = __builtin_amdgcn_readfirstlane((int)threadIdx.x >> 6);
#define TID_NOW(var) int var; { int l_; asm volatile("v_mbcnt_lo_u32_b32 %0, -1, 0\n\tv_mbcnt_hi_u32_b32 %0, -1, %0" : "=v"(l_)); var = (wave_s_ << 6) | l_; }
    const int lo = args.ph_lo, hi = args.ph_hi;
    {
        LAS unsigned char* l0 = (LAS unsigned char*)lds_raw;
        TID_NOW(t0_)
        for (int u = t0_; u < (LDS_BYTES - LDSCTL_OFF) / 4; u += NWAVES * 64) ((LAS unsigned*)(l0 + LDSCTL_OFF))[u] = 0u;
        __syncthreads();
    }
    XcdBarrier bar; bar.bar = (unsigned*)(args.ws + WS_CTL) + CW_BAR + args.li * XCD_BAR_WORDS; bar.x = 0; bar.st = nullptr;
    TID_NOW(t0b_)
    if (hi - lo > 1) bar = xcd_barrier_post((unsigned*)(args.ws + WS_CTL) + CW_BAR + args.li * XCD_BAR_WORDS, (volatile LAS unsigned*)((LAS unsigned char*)lds_raw + MISC_OFF) + 8, t0b_);
    int pc = 0;
#define PHASE_BEGINR(R) { int pc_ = pc; asm volatile("" : "+s"(pc_)); if (pc_ >= lo && pc_ < hi) { for (int rep_ = 0; rep_ < (R); ++rep_) { if (rep_) __syncthreads(); unsigned char* wsr_ = args.ws; asm volatile("" : "+s"(wsr_)); unsigned char* ws = as_global(wsr_); float* outr_ = args.out; asm volatile("" : "+s"(outr_)); float* out_ = as_global(outr_); \
    TID_NOW(t_) int bx = blockIdx.x; asm volatile("" : "+s"(bx)); int G_ = gridDim.x; asm volatile("" : "+s"(G_)); \
    Ctx c; c.var = args.pad; c.in.p = args.in; c.out = out_; c.ws = ws; c.lds = (LAS unsigned char*)lds_raw; c.tid = t_; c.lane = c.tid & 63; c.wave = __builtin_amdgcn_readfirstlane(c.tid >> 6); \
    c.G = G_; c.vcu = (c.G % 8 == 0) ? (bx % 8) * (c.G / 8) + bx / 8 : bx; c.gw = c.vcu * NWAVES + c.wave; c.NGW = c.G * NWAVES; \
    PG8_LAS unsigned char* ring = (PG8_LAS unsigned char*)(c.lds + RING_OFF); (void)ring; \
    bf16* XB = (bf16*)(ws + WS_XB); float* X = c.out; float* ssq = (float*)(ws + WS_SSQ); bf16* MIX = (bf16*)(ws + WS_R + R_MIX); (void)XB; (void)X; (void)ssq; (void)MIX;
#define PHASE_BEGIN PHASE_BEGINR(1)
#define PHASE_END   } if (pc_ + 1 < hi) { TID_NOW(tb_) xcd_barrier(bar, tb_); } } } ++pc;

    PHASE_BEGINR(REP_PROL) p0_prologue(c); PHASE_END

    for (int l = 0; l < 4; ++l) {
        const int hf = l >> 1;
        if ((l & 1) == 0) {
            PHASE_BEGINR(REP_IN)
                const bf16* wt = (const bf16*)(ws + WS_W + W_INE) + (size_t)hf * NIN_E * 1024; pg8::Gemm g{XB, wt, TP, 2048, 1024, 1024}; pg8::StaticOrder S; S.init(TP, 2048, c.G, bx);
                pg8::EpiInE E{(bf16*)(ws + WS_R + R_P), ssq + (size_t)(2 * l) * 4 * T};
                if (bx & 1) { if (l == 0) p0_weights_rest(c); gate_job(c, hf, ssq + (size_t)(2 * l) * 4 * T, bx, c.G); sgemm2<64, true>(c, XB + (size_t)TP * 1024, wt, 2048, 1024, E, bx, c.G); pg8::gemm_phase<pg8::EpiInE, pg8::StaticOrder, true, true>(ring, g, S, E, c.tid); }
                else { pg8::gemm_phase<pg8::EpiInE, pg8::StaticOrder, true, true>(ring, g, S, E, c.tid); sgemm2<64, true>(c, XB + (size_t)TP * 1024, wt, 2048, 1024, E, bx, c.G); gate_job(c, hf, ssq + (size_t)(2 * l) * 4 * T, bx, c.G); if (l == 0) p0_weights_rest(c); }
            PHASE_END
            PHASE_BEGINR(REP_EMIX) even_mixer_v2(c, hf); PHASE_END
            PHASE_BEGINR(REP_GLU)
                gla_post(c, hf);
                bf16* Z1 = (bf16*)(ws + WS_R + R_Z1); const bf16* wt = (const bf16*)(ws + WS_W + W_GLU) + (size_t)hf * 512 * 512; pg8::Gemm g{Z1, wt, TP, 512, 512, 512}; pg8::StaticOrder S; S.init(TP, 512, c.G, bx);
                pg8::EpiGlu E{Z1, MIX, c.in[21] + hf * 512};
                if (bx & 1) { sgemm2<32, false>(c, Z1 + (size_t)TP * 512, wt, 512, 512, E, bx >= 128 ? bx - 128 : (1 << 30), c.G - 128); pg8::gemm_phase<pg8::EpiGlu, pg8::StaticOrder, true, true>(ring, g, S, E, c.tid); }
                else { pg8::gemm_phase<pg8::EpiGlu, pg8::StaticOrder, true, true>(ring, g, S, E, c.tid); sgemm2<32, false>(c, Z1 + (size_t)TP * 512, wt, 512, 512, E, bx >= 128 ? bx - 128 : (1 << 30), c.G - 128); }
            PHASE_END
        } else {
            PHASE_BEGINR(REP_IN)
                const bf16* wt = (const bf16*)(ws + WS_W + W_INO) + (size_t)hf * NIN_O * 1024; pg8::Gemm g{XB, wt, TP, NIN_O, 1024, 1024}; pg8::StaticOrder S; S.init(TP, NIN_O, c.G, bx);
                pg8::EpiInO E{(bf16*)(ws + WS_R + R_XC), (bf16*)(ws + WS_R + R_CIN), ssq + (size_t)(2 * l) * 4 * T, c.out + OUT_CONVP + (size_t)hf * 8 * 3 * 1024, c.out + OUT_CONVS + (size_t)hf * 128 * 3 * 1024};
                if (bx & 1) { sgemm2<64, true>(c, XB + (size_t)TP * 1024, wt, NIN_O, 1024, E, bx, c.G); pg8::gemm_phase<pg8::EpiInO, pg8::StaticOrder, true, true>(ring, g, S, E, c.tid); }
                else { pg8::gemm_phase<pg8::EpiInO, pg8::StaticOrder, true, true>(ring, g, S, E, c.tid); sgemm2<64, true>(c, XB + (size_t)TP * 1024, wt, NIN_O, 1024, E, bx, c.G); }
            PHASE_END
            PHASE_BEGINR(REP_LRU) lru_fused(c, hf); PHASE_END
        }
        PHASE_BEGIN
            const bf16* wo = (l & 1) ? (const bf16*)(ws + WS_W + W_OUTO) + (size_t)hf * 1024 * 1024 : (const bf16*)(ws + WS_W + W_OUTE) + (size_t)hf * 1024 * 1024;
            pg8::Gemm g{MIX, wo, TP, 1024, 1024, 1024}; pg8::StaticOrder S; S.init(TP, 1024, c.G, bx);
            pg8::EpiRes E{XB, ssq + (size_t)(2 * l + 1) * 4 * T};
            if (bx & 1) { sgemm2<32, false>(c, MIX + (size_t)TP * 1024, wo, 1024, 1024, E, bx, c.G); pg8::gemm_phase<pg8::EpiRes, pg8::StaticOrder, false, true>(ring, g, S, E, c.tid); }
            else { pg8::gemm_phase<pg8::EpiRes, pg8::StaticOrder, false, true>(ring, g, S, E, c.tid); sgemm2<32, false>(c, MIX + (size_t)TP * 1024, wo, 1024, 1024, E, bx, c.G); }
        PHASE_END
        PHASE_BEGINR(REP_UP)
            const bf16* wt = (const bf16*)(ws + WS_W + W_UP) + (size_t)l * 4096 * 1024; pg8::Gemm g{XB, wt, TP, FF, 1024, 1024}; pg8::StaticOrder S; S.init(TP, FF, c.G, bx);
            pg8::EpiUp E{(bf16*)(ws + WS_R + R_H), ssq + (size_t)(2 * l + 1) * 4 * T};
            if (bx & 1) { sgemm2<64, true>(c, XB + (size_t)TP * 1024, wt, FF, 1024, E, bx, c.G); pg8::gemm_phase<pg8::EpiUp, pg8::StaticOrder, true, true>(ring, g, S, E, c.tid); }
            else { pg8::gemm_phase<pg8::EpiUp, pg8::StaticOrder, true, true>(ring, g, S, E, c.tid); sgemm2<64, true>(c, XB + (size_t)TP * 1024, wt, FF, 1024, E, bx, c.G); }
        PHASE_END
        PHASE_BEGIN
            const bf16* wt = (const bf16*)(ws + WS_W + W_DN) + (size_t)l * 1024 * LD_FF; pg8::Gemm g{(bf16*)(ws + WS_R + R_H), wt, TP, 1024, FF, LD_FF}; pg8::StaticOrder S; S.init(TP, 1024, c.G, bx);
            pg8::EpiRes E{XB, ssq + (size_t)(2 * l + 2) * 4 * T};
            if (bx & 1) { sgemm2<32, false>(c, (const bf16*)(ws + WS_R + R_H) + (size_t)TP * LD_FF, wt, 1024, FF, E, bx, c.G, LD_FF); pg8::gemm_phase<pg8::EpiRes, pg8::StaticOrder, false, true>(ring, g, S, E, c.tid); }
            else { pg8::gemm_phase<pg8::EpiRes, pg8::StaticOrder, false, true>(ring, g, S, E, c.tid); sgemm2<32, false>(c, (const bf16*)(ws + WS_R + R_H) + (size_t)TP * LD_FF, wt, 1024, FF, E, bx, c.G, LD_FF); }
        PHASE_END
    }
    PHASE_BEGINR(1) final_norm(c); PHASE_END
#undef PHASE_BEGIN
#undef PHASE_BEGINR
#undef PHASE_END
}

#ifndef MK_N_LAUNCHES
#define MK_N_LAUNCHES 1
#endif
extern "C" void kernel_launch(void* const* d_in, const int* in_sizes, int n_in, void* d_out, int out_size, void* d_ws, size_t ws_size, hipStream_t stream) {
    static int grid = 0;
    if (grid == 0) {
        if (n_in != 37 || out_size != (int)OUT_END || ws_size < WS_END) { fprintf(stderr, "kernel_launch: shape mismatch (n_in %d out %d ws %zu)\n", n_in, out_size, ws_size); grid = -1; return; }
        int dev = 0, cus = 0;
        if (hipGetDevice(&dev) != hipSuccess || hipDeviceGetAttribute(&cus, hipDeviceAttributeMultiprocessorCount, dev) != hipSuccess) { grid = -1; return; }
        if (hipFuncSetAttribute((const void*)mk_fwd, hipFuncAttributeMaxDynamicSharedMemorySize, LDS_BYTES) != hipSuccess) { fprintf(stderr, "kernel_launch: hipFuncSetAttribute failed\n"); grid = -1; return; }
        int per_cu = 0;
        if (hipOccupancyMaxActiveBlocksPerMultiprocessor(&per_cu, (const void*)mk_fwd, NWAVES * 64, LDS_BYTES) != hipSuccess || per_cu < 1) fprintf(stderr, "kernel_launch: occupancy query says %d\n", per_cu);
        (void)hipGetLastError();
        grid = cus;
        if (grid != 256) fprintf(stderr, "kernel_launch: %d CUs; this kernel's static work split assumes 256\n", grid);
    }
    if (grid < 0) return;
    if (hipMemsetAsync((char*)d_ws + WS_CTL, 0, CTL_ZERO_BYTES, stream) != hipSuccess) return;
    Args a{};
    for (int i = 0; i < 37; ++i) a.in[i] = (const float*)d_in[i];
    a.out = (float*)d_out; a.ws = (unsigned char*)d_ws;
    if (MK_N_LAUNCHES == 1) { a.ph_lo = 0; a.ph_hi = N_PHASES; hipLaunchKernelGGL(mk_fwd, dim3(grid), dim3(NWAVES * 64), LDS_BYTES, stream, a); }
    else { for (int p = 0; p < N_PHASES; ++p) { a.ph_lo = p; a.ph_hi = p + 1; hipLaunchKernelGGL(mk_fwd, dim3(grid), dim3(NWAVES * 64), LDS_BYTES, stream, a); } }
}
```

```cpp
#include <hip/hip_runtime.h>
#include <cstdio>
#include <cstdint>
namespace pg8 {
#define PG8_LAS __attribute__((address_space(3)))
typedef unsigned short bf16_t;
typedef short bf16x8 __attribute__((ext_vector_type(8)));
typedef float f32x4 __attribute__((ext_vector_type(4)));
typedef unsigned u32x4 __attribute__((ext_vector_type(4)));
constexpr int BM = 256, BK = 64, HALF = 128, HTB = HALF * BK * 2  , STAGE_BYTES = 8 * HTB, NXCD = 8, WGM = 8;

__host__ __device__ __forceinline__ int lds_byte(int r, int c) { const int st = (r >> 4) * 2 + (c >> 5), rr = r & 15, cc = c & 31, ob = rr * 64 + cc * 2; return st * 1024 + (ob ^ (((ob >> 9) & 1) << 5)); }
__host__ __device__ __forceinline__ void stage_rc(int b, int& R, int& C) { const int st = b / 1024, sb = b % 1024, swz = sb ^ (((sb >> 9) & 1) << 5); R = (st >> 1) * 16 + swz / 64; C = (st & 1) * 32 + (swz % 64) / 2; }
__host__ __device__ __forceinline__ int perm32(int rho) { const int n = rho >> 4, i = rho & 15; return 8 * (i >> 2) + 4 * n + (i & 3); }

struct Unit { int pm, pn; };
struct Gemm { const bf16_t* A; const bf16_t* Bt; int M, N, K, ld; };

struct StaticOrder {
    int nM, nN, nwg, G, c;
    __host__ __device__ void init(int M, int N, int G_, int c_) { nM = M / BM; nN = N / BM; nwg = nM * nN; G = G_; c = c_; }
    __host__ __device__ bool next(int i, Unit& u) const {
        const long L = (long)i * G + c; if (L >= nwg) return false;
        int wgid = (int)L; { const int q = nwg / NXCD, r = nwg % NXCD, xcd = wgid % NXCD, off = wgid / NXCD; wgid = (xcd < r ? xcd * (q + 1) : r * (q + 1) + (xcd - r) * q) + off; }
        const int nig = WGM * nN, gid = wgid / nig, fm = gid * WGM, gsz = (nM - fm) < WGM ? (nM - fm) : WGM;
        u.pm = fm + ((wgid % nig) % gsz); u.pn = (wgid % nig) / gsz; return true;
    }
    __device__ __forceinline__ void a_ready(const Unit&) const {}
    __device__ __forceinline__ void done(const Unit&) const {}
};

__device__ __forceinline__ unsigned cvt_pk_bf16(float lo, float hi) { unsigned r; asm volatile("v_cvt_pk_bf16_f32 %0, %1, %2" : "=v"(r) : "v"(lo), "v"(hi)); return r; }
template <class Epi, class Sched, bool ALIGN_EPI = false, bool SP2 = false>
__device__ __forceinline__ void gemm_phase(PG8_LAS unsigned char* lds, const Gemm g, const Sched& S, const Epi& E, int tid_in) {
    int tid_ = tid_in; asm volatile("" : "+v"(tid_));
    const int tid = tid_, wid = __builtin_amdgcn_readfirstlane(tid >> 6), lane = tid & 63, wr = wid >> 2, wc = wid & 3, fr = lane & 15, fq = lane >> 4;
    const int K = g.K, nt = K / BK, LD = g.ld;
    unsigned voffA[2], voffB[2];
#pragma unroll
    for (int i = 0; i < 2; ++i) { int R, C; stage_rc(tid * 16 + i * 8192, R, C); const int Rb = Epi::PERM ? ((R & ~31) + perm32(R & 31)) : R;
        voffA[i] = (unsigned)(R * LD + C) * 2u; voffB[i] = (unsigned)(Rb * LD + C) * 2u; }
    const size_t kstep = (size_t)(BK * 2);
    const size_t hstep = (size_t)HALF * LD * 2;
    const size_t tstep = 2 * hstep;
    const unsigned ldsw = (unsigned)wid * 1024u;
    const int aoff = lds_byte(wr * 64 + fr, fq * 8), boff = lds_byte(wc * 32 + fr, fq * 8);
#define PG8_SA(b, h) (((b) * 2 + (h)) * HTB)
#define PG8_SB(b, h) ((4 + (b) * 2 + (h)) * HTB)
#define PG8_STAGE(bufoff, gbase, voff) do { _Pragma("unroll") for (int _i = 0; _i < 2; ++_i) \
        __builtin_amdgcn_global_load_lds((const unsigned*)((const char*)(gbase) + (voff)[_i]), (PG8_LAS unsigned*)(lds + (bufoff) + ldsw + _i * 8192), 16, 0, 0); } while (0)
#define PG8_LDA(dst, b, h) do { _Pragma("unroll") for (int m = 0; m < 4; ++m) _Pragma("unroll") for (int k = 0; k < 2; ++k) dst[m][k] = *(const PG8_LAS bf16x8*)(lds + PG8_SA(b, h) + aoff + m * 2048 + k * 1024); } while (0)
#define PG8_LDB(dst, b, h) do { _Pragma("unroll") for (int n = 0; n < 2; ++n) _Pragma("unroll") for (int k = 0; k < 2; ++k) dst[n][k] = *(const PG8_LAS bf16x8*)(lds + PG8_SB(b, h) + boff + n * 2048 + k * 1024); } while (0)
#define PG8_MMA(ai, bj, At, Bt) do { __builtin_amdgcn_s_setprio(1); _Pragma("unroll") for (int m = 0; m < 4; ++m) _Pragma("unroll") for (int n = 0; n < 2; ++n) _Pragma("unroll") for (int k = 0; k < 2; ++k) \
        acc[ai][bj][m][n] = __builtin_amdgcn_mfma_f32_16x16x32_bf16(Bt[n][k], At[m][k], acc[ai][bj][m][n], 0, 0, 0); __builtin_amdgcn_s_setprio(0); } while (0)
#define PG8_WAIT_V(n) asm volatile("s_waitcnt vmcnt(" #n ")" ::: "memory")
#define PG8_WAIT_L(n) asm volatile("s_waitcnt lgkmcnt(" #n ")" ::: "memory")
#define PG8_BAR __builtin_amdgcn_s_barrier()
#define PG8_SCHED __builtin_amdgcn_sched_barrier(0)
    Unit cur, nxt; int ui = 0;
    if (!S.next(0, cur)) return;
    f32x4 acc[2][2][4][2];
#pragma unroll
    for (int a = 0; a < 2; ++a)
#pragma unroll
        for (int b = 0; b < 2; ++b)
#pragma unroll
            for (int m = 0; m < 4; ++m)
#pragma unroll
                for (int n = 0; n < 2; ++n) acc[a][b][m][n] = (f32x4){0.f, 0.f, 0.f, 0.f};
    bf16x8 At[4][2], B0[2][2], B1[2][2];
    const char* cA = (const char*)g.A + (size_t)cur.pm * tstep; const char* cB = (const char*)g.Bt + (size_t)cur.pn * tstep;
    S.a_ready(cur);
    if constexpr (SP2) {
        PG8_STAGE(PG8_SB(0, 0), cB, voffB); PG8_STAGE(PG8_SB(0, 1), cB + hstep, voffB); PG8_STAGE(PG8_SA(0, 0), cA, voffA); PG8_STAGE(PG8_SA(0, 1), cA + hstep, voffA);
        if (wr == 1) PG8_BAR;
        PG8_WAIT_V(2); PG8_BAR;
        PG8_STAGE(PG8_SB(1, 0), cB + kstep, voffB); PG8_STAGE(PG8_SA(1, 0), cA + kstep, voffA); PG8_STAGE(PG8_SB(1, 1), cB + hstep + kstep, voffB);
        PG8_WAIT_V(6); PG8_BAR;
    } else {
        PG8_STAGE(PG8_SB(0, 0), cB, voffB); PG8_STAGE(PG8_SA(0, 0), cA, voffA); PG8_STAGE(PG8_SB(0, 1), cB + hstep, voffB); PG8_STAGE(PG8_SA(0, 1), cA + hstep, voffA);
        if (wr == 1) PG8_BAR;
        PG8_WAIT_V(4); PG8_BAR;
        PG8_STAGE(PG8_SB(1, 0), cB + kstep, voffB); PG8_STAGE(PG8_SA(1, 0), cA + kstep, voffA); PG8_STAGE(PG8_SB(1, 1), cB + hstep + kstep, voffB);
        PG8_WAIT_V(6); PG8_BAR;
    }
    for (;;) {
        const bool has_next = S.next(ui + 1, nxt);
        const char* nA = has_next ? (const char*)g.A + (size_t)nxt.pm * tstep : cA; const char* nB = has_next ? (const char*)g.Bt + (size_t)nxt.pn * tstep : cB;
        for (int t = 0; t < nt; t += 2) {
            const bool last = (t == nt - 2);
            const char* a1 = cA + (size_t)(t + 1) * kstep;
            const char* a2 = last ? nA : cA + (size_t)(t + 2) * kstep; const char* b2 = last ? nB : cB + (size_t)(t + 2) * kstep;
            const char* a3 = a2 + kstep; const char* b3 = b2 + kstep;
            if (last && has_next) S.a_ready(nxt);
            if constexpr (SP2) {
            PG8_LDB(B0, 0, 0); PG8_LDB(B1, 0, 1); PG8_SCHED; PG8_LDA(At, 0, 0); PG8_STAGE(PG8_SA(1, 1), a1 + hstep, voffA);
            PG8_WAIT_V(8); PG8_WAIT_L(0); PG8_BAR; PG8_MMA(0, 0, At, B0); PG8_MMA(0, 1, At, B1); PG8_BAR; PG8_SCHED;
            PG8_LDA(At, 0, 1); PG8_STAGE(PG8_SB(0, 0), b2, voffB); PG8_STAGE(PG8_SB(0, 1), b2 + hstep, voffB); PG8_STAGE(PG8_SA(0, 0), a2, voffA);
            PG8_WAIT_V(8); PG8_WAIT_L(0); PG8_BAR; PG8_MMA(1, 0, At, B0); PG8_MMA(1, 1, At, B1); PG8_BAR; PG8_SCHED;
            PG8_LDB(B0, 1, 0); PG8_LDB(B1, 1, 1); PG8_SCHED; PG8_LDA(At, 1, 0); PG8_STAGE(PG8_SA(0, 1), a2 + hstep, voffA);
            PG8_WAIT_V(8); PG8_WAIT_L(0); PG8_BAR; PG8_MMA(0, 0, At, B0); PG8_MMA(0, 1, At, B1); PG8_BAR; PG8_SCHED;
            PG8_LDA(At, 1, 1); PG8_STAGE(PG8_SB(1, 0), b3, voffB); PG8_STAGE(PG8_SB(1, 1), b3 + hstep, voffB); PG8_STAGE(PG8_SA(1, 0), a3, voffA);
            PG8_WAIT_V(8); PG8_WAIT_L(0); PG8_BAR; PG8_MMA(1, 0, At, B0); PG8_MMA(1, 1, At, B1); PG8_BAR; PG8_SCHED;
            } else {
            PG8_LDB(B0, 0, 0); PG8_SCHED; PG8_LDA(At, 0, 0); PG8_STAGE(PG8_SA(1, 1), a1 + hstep, voffA);
            PG8_WAIT_L(8); PG8_BAR; PG8_WAIT_L(0); PG8_MMA(0, 0, At, B0); PG8_BAR; PG8_SCHED;
            PG8_LDB(B1, 0, 1); PG8_STAGE(PG8_SB(0, 0), b2, voffB);
            PG8_BAR; PG8_WAIT_L(0); PG8_MMA(0, 1, At, B1); PG8_BAR;
            PG8_LDA(At, 0, 1); PG8_STAGE(PG8_SA(0, 0), a2, voffA);
            PG8_BAR; PG8_WAIT_L(0); PG8_MMA(1, 0, At, B0); PG8_BAR; PG8_SCHED;
            PG8_STAGE(PG8_SB(0, 1), b2 + hstep, voffB);
            PG8_WAIT_V(6); PG8_BAR; PG8_MMA(1, 1, At, B1); PG8_BAR;
            PG8_LDB(B0, 1, 0); PG8_SCHED; PG8_LDA(At, 1, 0); PG8_STAGE(PG8_SA(0, 1), a2 + hstep, voffA);
            PG8_WAIT_L(8); PG8_BAR; PG8_WAIT_L(0); PG8_MMA(0, 0, At, B0); PG8_BAR; PG8_SCHED;
            PG8_LDB(B1, 1, 1); PG8_STAGE(PG8_SB(1, 0), b3, voffB);
            PG8_BAR; PG8_WAIT_L(0); PG8_MMA(0, 1, At, B1); PG8_BAR;
            PG8_LDA(At, 1, 1); PG8_STAGE(PG8_SA(1, 0), a3, voffA);
            PG8_BAR; PG8_WAIT_L(0); PG8_MMA(1, 0, At, B0); PG8_BAR; PG8_SCHED;
            PG8_STAGE(PG8_SB(1, 1), b3 + hstep, voffB);
            PG8_WAIT_V(6); PG8_BAR; PG8_MMA(1, 1, At, B1); PG8_BAR;
            }
        }
        if constexpr (ALIGN_EPI) { if (wr == 0) PG8_BAR; }
        if constexpr (!Epi::AFTER_DRAIN) { E(acc, cur, wr, wc, fr, fq); S.done(cur); }
        if (!has_next) break;
#pragma unroll
        for (int a = 0; a < 2; ++a)
#pragma unroll
            for (int b = 0; b < 2; ++b)
#pragma unroll
                for (int m = 0; m < 4; ++m)
#pragma unroll
                    for (int n = 0; n < 2; ++n) acc[a][b][m][n] = (f32x4){0.f, 0.f, 0.f, 0.f};
        cur = nxt; cA = nA; cB = nB; ++ui;
        if constexpr (ALIGN_EPI) { if (wr == 1) PG8_BAR; }
    }
    PG8_WAIT_V(0);
    if constexpr (!ALIGN_EPI) { if (wr == 0) PG8_BAR; }
    PG8_BAR;
    if constexpr (Epi::AFTER_DRAIN) { E.fused(acc, cur, wr, wc, fr, fq, lds, wid, lane); S.done(cur); }
#undef PG8_SA
#undef PG8_SB
#undef PG8_STAGE
#undef PG8_LDA
#undef PG8_LDB
#undef PG8_MMA
#undef PG8_WAIT_V
#undef PG8_WAIT_L
#undef PG8_BAR
#undef PG8_SCHED
}
}
#ifndef PG8_SP2
#define PG8_SP2 true
#endif
namespace pg8 {
constexpr int TP_ROWS = 16384, T_ROWS = 16896;
constexpr float EPS_F = 1e-6f;
__device__ __forceinline__ float sigmoid_f(float x) { return __builtin_amdgcn_rcpf(1.0f + __expf(-x)); }
__device__ __forceinline__ float gelu_tanh_f(float x) { const float u = 0.7978845608028654f * (x + 0.044715f * x * x * x); return x * __builtin_amdgcn_rcpf(1.0f + __expf(-2.0f * u)); }
__device__ __forceinline__ float logsigmoid_f(float x) { return fminf(x, 0.f) - __logf(1.0f + __expf(-fabsf(x))); }
__device__ __forceinline__ u32x4 pack8(const f32x4& a, const f32x4& b) { u32x4 w; w.x = cvt_pk_bf16(a[0], a[1]); w.y = cvt_pk_bf16(a[2], a[3]); w.z = cvt_pk_bf16(b[0], b[1]); w.w = cvt_pk_bf16(b[2], b[3]); return w; }
__device__ __forceinline__ void unpack8(const u32x4& w, f32x4& a, f32x4& b) {
    a = (f32x4){__uint_as_float(w.x << 16), __uint_as_float(w.x & 0xffff0000u), __uint_as_float(w.y << 16), __uint_as_float(w.y & 0xffff0000u)};
    b = (f32x4){__uint_as_float(w.z << 16), __uint_as_float(w.z & 0xffff0000u), __uint_as_float(w.w << 16), __uint_as_float(w.w & 0xffff0000u)}; }
__device__ __forceinline__ float ssq4(const float* ssq, int row) { return rsqrtf(((ssq[row] + ssq[T_ROWS + row]) + (ssq[2 * T_ROWS + row] + ssq[3 * T_ROWS + row])) * (1.0f / 1024.0f) + EPS_F); }

template <class E> __device__ __forceinline__ void drive_epi(const E& e, const f32x4 (&acc)[2][2][4][2], const Unit& u, int wr, int wc, int fr, int fq, float (&sums)[8]) {
    const int row0 = u.pm * BM + wr * 64 + fr, col0 = u.pn * BM + wc * 32 + 8 * fq;
    float rs[8]; f32x4 cb0[2], cb1[2];
#pragma unroll
    for (int g = 0; g < 8; ++g) rs[g] = e.row_scale(row0 + (g >> 2) * HALF + (g & 3) * 16);
#pragma unroll
    for (int bj = 0; bj < 2; ++bj) e.col8(col0 + bj * HALF, cb0[bj], cb1[bj]);
#pragma unroll
    for (int hf = 0; hf < 2; ++hf) {
        u32x4 pre[4][2];
        if (E::HAS_PRE) {
#pragma unroll
            for (int m = 0; m < 4; ++m)
#pragma unroll
                for (int bj = 0; bj < 2; ++bj) pre[m][bj] = e.pre8(row0 + hf * HALF + m * 16, col0 + bj * HALF);
        }
#pragma unroll
        for (int m = 0; m < 4; ++m) { const int g = 4 * hf + m, row = row0 + hf * HALF + m * 16; float s = 0.f;
#pragma unroll
            for (int bj = 0; bj < 2; ++bj) e.row8(row, col0 + bj * HALF, acc[hf][bj][m][0], acc[hf][bj][m][1], rs[g], cb0[bj], cb1[bj], E::HAS_PRE ? pre[m][bj] : (u32x4){0u, 0u, 0u, 0u}, s);
            sums[g] = s; }
        if (E::HAS_PRE) asm volatile("" ::: "memory");
    }
}
struct EpiInE {
    static constexpr bool PERM = true, AFTER_DRAIN = false, HAS_PRE = false;
    bf16_t* P; const float* ssq;
    __device__ __forceinline__ float row_scale(int row) const { return ssq4(ssq, row); }
    __device__ __forceinline__ void col8(int, f32x4& b0, f32x4& b1) const { b0 = (f32x4){0.f, 0.f, 0.f, 0.f}; b1 = b0; }
    __device__ __forceinline__ u32x4 pre8(int, int) const { return (u32x4){0u, 0u, 0u, 0u}; }
    __device__ __forceinline__ void row8(int row, int col, f32x4 v0, f32x4 v1, float rs, const f32x4&, const f32x4&, const u32x4&, float&) const {
        v0 = v0 * rs; v1 = v1 * rs;
        if (col >= 1024 && col < 1536) {
#pragma unroll
            for (int e = 0; e < 4; ++e) { v0[e] = v0[e] * sigmoid_f(v0[e]); v1[e] = v1[e] * sigmoid_f(v1[e]); } }
        *(u32x4*)(P + (size_t)row * 2048 + col) = pack8(v0, v1);
    }
    __device__ __forceinline__ void operator()(const f32x4 (&acc)[2][2][4][2], const Unit& u, int wr, int wc, int fr, int fq) const { float sm[8]; drive_epi(*this, acc, u, wr, wc, fr, fq, sm); }
};
struct EpiInO {
    static constexpr bool PERM = true, AFTER_DRAIN = false, HAS_PRE = false;
    bf16_t* GATE; bf16_t* CIN; const float* ssq; float* conv_p; float* conv_s;
    __device__ __forceinline__ float row_scale(int row) const { return ssq4(ssq, row); }
    __device__ __forceinline__ void col8(int, f32x4& b0, f32x4& b1) const { b0 = (f32x4){0.f, 0.f, 0.f, 0.f}; b1 = b0; }
    __device__ __forceinline__ u32x4 pre8(int, int) const { return (u32x4){0u, 0u, 0u, 0u}; }
    __device__ __forceinline__ void row8(int row, int col, f32x4 v0, f32x4 v1, float rs, const f32x4&, const f32x4&, const u32x4&, float&) const {
        v0 = v0 * rs; v1 = v1 * rs;
        if (col < 1024) {
#pragma unroll
            for (int e = 0; e < 4; ++e) { v0[e] = gelu_tanh_f(v0[e]); v1[e] = gelu_tanh_f(v1[e]); }
            *(u32x4*)(GATE + (size_t)row * 1024 + col) = pack8(v0, v1);
        } else {
            const int cc = col - 1024;
            *(u32x4*)(CIN + (size_t)row * 1024 + cc) = pack8(v0, v1);
            float* cdst = nullptr;
            if (row < TP_ROWS) { const int t = row & 2047; if (t >= 2045) cdst = conv_p + ((size_t)(row >> 11) * 3 + (t - 2045)) * 1024; }
            else { const int r2 = row - TP_ROWS, t = r2 & 3; if (t >= 1) cdst = conv_s + ((size_t)(r2 >> 2) * 3 + (t - 1)) * 1024; }
            if (cdst) { *(f32x4*)(cdst + cc) = v0; *(f32x4*)(cdst + cc + 4) = v1; }
        }
    }
    __device__ __forceinline__ void operator()(const f32x4 (&acc)[2][2][4][2], const Unit& u, int wr, int wc, int fr, int fq) const { float sm[8]; drive_epi(*this, acc, u, wr, wc, fr, fq, sm); }
};
struct EpiRes {
    static constexpr bool PERM = true, AFTER_DRAIN = true, HAS_PRE = true;
    bf16_t* XB; float* ssq_out;
    __device__ __forceinline__ float row_scale(int) const { return 1.f; }
    __device__ __forceinline__ void col8(int, f32x4& b0, f32x4& b1) const { b0 = (f32x4){0.f, 0.f, 0.f, 0.f}; b1 = b0; }
    __device__ __forceinline__ u32x4 pre8(int row, int col) const { return *(const u32x4*)(XB + (size_t)row * 1024 + col); }
    __device__ __forceinline__ void row8(int row, int col, f32x4 v0, f32x4 v1, float, const f32x4&, const f32x4&, const u32x4& pre, float& s) const {
        f32x4 o0, o1; unpack8(pre, o0, o1); o0 = o0 + v0; o1 = o1 + v1;
        *(u32x4*)(XB + (size_t)row * 1024 + col) = pack8(o0, o1);
        s += (o0[0] * o0[0] + o0[1] * o0[1]) + (o0[2] * o0[2] + o0[3] * o0[3]) + (o1[0] * o1[0] + o1[1] * o1[1]) + (o1[2] * o1[2] + o1[3] * o1[3]);
    }
    __device__ __forceinline__ void fused(f32x4 (&acc)[2][2][4][2], const Unit& u, int wr, int wc, int fr, int fq, PG8_LAS unsigned char* lds, int wid, int lane) const {
        PG8_LAS float* part = (PG8_LAS float*)lds;
        float sm[8]; drive_epi(*this, acc, u, wr, wc, fr, fq, sm);
#pragma unroll
        for (int g = 0; g < 8; ++g) { float s = sm[g]; s += __shfl_xor(s, 16); s += __shfl_xor(s, 32);
            if (fq == 0) part[wc * 256 + (g >> 2) * HALF + wr * 64 + (g & 3) * 16 + fr] = s; }
        asm volatile("s_waitcnt lgkmcnt(0)" ::: "memory"); __builtin_amdgcn_s_barrier(); asm volatile("" ::: "memory");
        const int t = wid * 64 + lane;
        if (t < 256) ssq_out[(size_t)u.pn * T_ROWS + u.pm * BM + t] = (part[t] + part[256 + t]) + (part[512 + t] + part[768 + t]);
        asm volatile("s_waitcnt lgkmcnt(0)" ::: "memory"); __builtin_amdgcn_s_barrier(); asm volatile("" ::: "memory");
    }
    __device__ __forceinline__ void operator()(const f32x4 (&acc)[2][2][4][2], const Unit& u, int wr, int wc, int fr, int fq) const {}
};
struct EpiUp {
    static constexpr bool PERM = true, AFTER_DRAIN = false, HAS_PRE = false;
    bf16_t* H; const float* ssq;
    __device__ __forceinline__ float row_scale(int row) const { return ssq4(ssq, row); }
    __device__ __forceinline__ void col8(int, f32x4& b0, f32x4& b1) const { b0 = (f32x4){0.f, 0.f, 0.f, 0.f}; b1 = b0; }
    __device__ __forceinline__ u32x4 pre8(int, int) const { return (u32x4){0u, 0u, 0u, 0u}; }
    __device__ __forceinline__ void row8(int row, int col, f32x4 v0, f32x4 v1, float rs, const f32x4&, const f32x4&, const u32x4&, float&) const {
        v0 = v0 * rs; v1 = v1 * rs;
#pragma unroll
        for (int e = 0; e < 4; ++e) { const float a = fmaxf(v0[e], 0.f), b = fmaxf(v1[e], 0.f); v0[e] = a * a; v1[e] = b * b; }
        { const u32x4 pk_ = pack8(v0, v1); bf16_t* dp_ = H + (size_t)row * 4224 + col;
          asm volatile("global_store_dwordx4 %0, %1, off sc1\n\ts_nop 1" :: "v"(dp_), "v"(pk_) : "memory"); }
    }
    __device__ __forceinline__ void operator()(const f32x4 (&acc)[2][2][4][2], const Unit& u, int wr, int wc, int fr, int fq) const { float sm[8]; drive_epi(*this, acc, u, wr, wc, fr, fq, sm); }
};
struct EpiGlu {
    static constexpr bool PERM = true, AFTER_DRAIN = false, HAS_PRE = true;
    const bf16_t* Z1; bf16_t* MIX; const float* b_glu;
    __device__ __forceinline__ float row_scale(int) const { return 1.f; }
    __device__ __forceinline__ void col8(int col, f32x4& b0, f32x4& b1) const { b0 = *(const f32x4*)(b_glu + col); b1 = *(const f32x4*)(b_glu + col + 4); }
    __device__ __forceinline__ u32x4 pre8(int row, int col) const { return *(const u32x4*)(Z1 + (size_t)row * 512 + col); }
    __device__ __forceinline__ void row8(int row, int col, f32x4 v0, f32x4 v1, float, const f32x4& b0, const f32x4& b1, const u32x4& pre, float&) const {
        f32x4 z0, z1; unpack8(pre, z0, z1);
#pragma unroll
        for (int e = 0; e < 4; ++e) { v0[e] = z0[e] * sigmoid_f(v0[e] + b0[e]); v1[e] = z1[e] * sigmoid_f(v1[e] + b1[e]); }
        *(u32x4*)(MIX + (size_t)row * 1024 + 512 + col) = pack8(v0, v1);
    }
    __device__ __forceinline__ void operator()(const f32x4 (&acc)[2][2][4][2], const Unit& u, int wr, int wc, int fr, int fq) const { float sm[8]; drive_epi(*this, acc, u, wr, wc, fr, fq, sm); }
};
}
constexpr int NWAVES = 8;
constexpr int D = 1024, TP = 16384, TS = 512, T = TP + TS, FF = 4096;
constexpr int NIN_E = 2304, NIN_O = 2048;
constexpr float EPS = 1e-6f;
constexpr size_t MiB = 1u << 20;
constexpr size_t WS_CTL = 0, CTL_ZERO_BYTES = 2 * MiB;
constexpr size_t WS_SSQ = 277 * MiB;
constexpr size_t CTL_S5AB = 1 * MiB;
constexpr size_t CTL_S5BRE = 1 * MiB + 64 * 1024;
constexpr size_t CTL_S5BIM = CTL_S5BRE + 256 * 1024;
constexpr size_t WS_W = 2 * MiB;
constexpr size_t W_INE = 0, W_GLU = 9437184, W_OUTE = 10485760, W_INO = 14680064, W_G = 23068672, W_OUTO = 24117248, W_UP = 28311552, W_DN = 61865984, W_END = 96468992;
constexpr size_t WS_WA = 94 * MiB;
constexpr int LD_FF = 4224;
constexpr size_t WS_XB = 95 * MiB, WS_R = 128 * MiB;
constexpr size_t R_H = 0, R_P = 0, R_LA = 66 * MiB, R_Z1 = 82 * MiB + MiB / 2, R_MIX = 99 * MiB, R_ORAW = 132 * MiB;
constexpr size_t R_CIN = 0, R_LOGA = 0, R_XC = 33 * MiB, R_BB = 66 * MiB;
constexpr size_t WS_END = WS_SSQ + (size_t)9 * 4 * T * 4;
static_assert(WS_R + 148 * MiB + MiB / 2 <= WS_SSQ, "ws map");
static_assert(WS_W + W_END <= WS_XB && WS_XB + (size_t)T * D * 2 <= WS_R, "ws map");
constexpr size_t OUT_YP = 0, OUT_YS = 16777216, OUT_GLAP = 17301504, OUT_REP = 17825792, OUT_IMP = 17858560, OUT_LRUP = 17891328, OUT_CONVP = 17907712,
                 OUT_GLAS = 17956864, OUT_RES = 26345472, OUT_IMS = 26869760, OUT_LRUS = 27394048, OUT_CONVS = 27656192, OUT_END = 28442624;
constexpr int CW_TMO = 0, CW_CODE = 1, CW_BAR = 4096;
constexpr int RING_OFF = 0, RING_BYTES = 131072, LDSCTL_OFF = RING_BYTES, MISC_OFF = LDSCTL_OFF + 320, LDS_BYTES = 147456;

#define GAS __attribute__((address_space(1)))
#define LAS __attribute__((address_space(3)))
typedef unsigned short bf16;
typedef unsigned v4u __attribute__((ext_vector_type(4)));
typedef unsigned v2u __attribute__((ext_vector_type(2)));
typedef float f32x4 __attribute__((ext_vector_type(4)));
typedef short bf16x8 __attribute__((ext_vector_type(8)));
typedef GAS unsigned gu32;
#define RLX_AGENT __ATOMIC_RELAXED, __HIP_MEMORY_SCOPE_AGENT
#define LDS_WAIT() asm volatile("s_waitcnt lgkmcnt(0)" ::: "memory")
#define VM_WAIT() asm volatile("s_waitcnt vmcnt(0)" ::: "memory")
__device__ __forceinline__ unsigned f2bf(float f) { unsigned u = __builtin_bit_cast(unsigned, f); return (u + 0x7fffu + ((u >> 16) & 1u)) >> 16; }
__device__ __forceinline__ unsigned pk2(float lo, float hi) { return f2bf(lo) | (f2bf(hi) << 16); }
__device__ __forceinline__ float bflo(unsigned w) { return __uint_as_float(w << 16); }
__device__ __forceinline__ float bfhi(unsigned w) { return __uint_as_float(w & 0xffff0000u); }
__device__ __forceinline__ float bf2f(bf16 h) { return __uint_as_float((unsigned)h << 16); }
__device__ __forceinline__ float sigmoid_f(float x) { return __builtin_amdgcn_rcpf(1.0f + __expf(-x)); }
__device__ __forceinline__ float gelu_tanh_f(float x) { const float u = 0.7978845608028654f * (x + 0.044715f * x * x * x); return x * __builtin_amdgcn_rcpf(1.0f + __expf(-2.0f * u)); }
__device__ __forceinline__ float wave_sum(float v) {
#pragma unroll
    for (int o = 1; o < 64; o <<= 1) v += __shfl_xor(v, o);
    return v;
}
#define XB_TMO      128
#define XB_XCNT(j)  (256  + 64 * (j))
#define XB_XSUB(j)  (1280 + 64 * (j))
#define XB_XGEN(j)  (2304 + 64 * (j))
#define XB_TOP      3328
#define XB_TOPGEN   3392
#define XCD_BAR_WORDS 3456
#define XB_SPIN_CAP (1u << 18)

__device__ __forceinline__ unsigned xb_ld(unsigned* p)              { return __hip_atomic_load(p, __ATOMIC_RELAXED, __HIP_MEMORY_SCOPE_AGENT); }
__device__ __forceinline__ unsigned xb_add(unsigned* p, unsigned v) { return __hip_atomic_fetch_add(p, v, __ATOMIC_RELAXED, __HIP_MEMORY_SCOPE_AGENT); }
__device__ __forceinline__ unsigned xb_xcc_id() { return (unsigned)__builtin_amdgcn_s_getreg((3 << 11) | 20) & 0xFu; }
#define XB_SPIN(cond, bar) do { unsigned _sp = 0; while (cond) { __builtin_amdgcn_s_sleep(1); \
    if ((++_sp & 255u) == 0u) { if (xb_ld(&(bar)[XB_TMO])) break; if (_sp > XB_SPIN_CAP) { atomicAdd(&(bar)[XB_TMO], 1u); break; } } } } while (0)

struct XcdBarrier {
    unsigned* bar; unsigned x;
    volatile LAS unsigned* st;
};

__device__ __forceinline__ XcdBarrier xcd_barrier_post(unsigned* bar, volatile LAS unsigned* st, int tid) {
    XcdBarrier b; b.bar = bar; b.x = xb_xcc_id(); b.st = st;
    if (tid == 0) (void)xb_add(&bar[XB_XCNT(b.x)], 1u);
    return b;
}
__device__ __forceinline__ void xcd_barrier_complete(unsigned* bar, unsigned x, unsigned& nloc, unsigned& nx) {
    const unsigned G = gridDim.x * gridDim.y * gridDim.z;
    unsigned sum, cnt, mine, sp = 0u;
    for (;;) {
        sum = 0u; cnt = 0u; mine = 0u;
#pragma unroll
        for (unsigned j = 0; j < 16; ++j) { const unsigned c = xb_ld(&bar[XB_XCNT(j)]); sum += c; cnt += (c > 0u) ? 1u : 0u; mine = (j == x) ? c : mine; }
        if (sum == G) break;
        __builtin_amdgcn_s_sleep(1);
        if ((++sp & 255u) == 0u) { if (xb_ld(&bar[XB_TMO])) break; if (sp > XB_SPIN_CAP) { atomicAdd(&bar[XB_TMO], 1u); break; } }
    }
    nloc = mine > 0u ? mine : 1u; nx = cnt > 0u ? cnt : 1u;
}

__device__ __forceinline__ void xcd_barrier(const XcdBarrier& b, int tid) {
    asm volatile("s_waitcnt vmcnt(0)" ::: "memory");
    __syncthreads();
    if (tid == 0) {
        unsigned* bar = b.bar;
        __builtin_amdgcn_s_waitcnt(0);
        unsigned nloc = b.st[0], nx = b.st[1];
        if (nloc == 0u) { xcd_barrier_complete(bar, b.x, nloc, nx); b.st[0] = nloc; b.st[1] = nx; }
        const unsigned old = xb_add(&bar[XB_XSUB(b.x)], 1u);
        const unsigned gen = old / nloc;
        if (old + 1u == (gen + 1u) * nloc) {
            __builtin_amdgcn_fence(__ATOMIC_RELEASE, "agent");
            asm volatile("s_waitcnt vmcnt(0)" ::: "memory");
            const unsigned og = xb_add(&bar[XB_TOP], 1u);
            const unsigned tg = og / nx;
            if (og + 1u == (tg + 1u) * nx) xb_add(&bar[XB_TOPGEN], 1u);
            else XB_SPIN(xb_ld(&bar[XB_TOPGEN]) == tg, bar);
            __builtin_amdgcn_fence(__ATOMIC_ACQUIRE, "agent");
            xb_add(&bar[XB_XGEN(b.x)], 1u);
            asm volatile("s_waitcnt vmcnt(0)" ::: "memory");
        } else {
            XB_SPIN(xb_ld(&bar[XB_XGEN(b.x)]) == gen, bar);
            __builtin_amdgcn_fence(__ATOMIC_ACQUIRE, "agent");
            asm volatile("s_waitcnt vmcnt(0)" ::: "memory");
        }
    }
    __syncthreads();
}
struct Args { const float* in[37]; float* out; unsigned char* ws; int ph_lo, ph_hi, li, pad; };
template <class T> __device__ __forceinline__ T* as_global(T* p) { const unsigned long long u = (unsigned long long)p; return (T*)(GAS T*)u; }
struct InPtrs { const float* const* p; __device__ __forceinline__ const float* operator[](int i) const { return as_global(p[i]); } };
struct Ctx { InPtrs in; float* out; unsigned char* ws; LAS unsigned char* lds; int tid, lane, wave, vcu, G, gw, NGW, var; };

__device__ __forceinline__ void tr_item(const float* W, int ldw, int K, const float* gain, bf16* WT, LAS float* scr, int kb, int nb, int lane, int ldo) {
    const int k0 = 64 * kb, n0 = 32 * nb;
    f32x4 v[8];
#pragma unroll
    for (int i = 0; i < 8; ++i) v[i] = __builtin_nontemporal_load((const f32x4*)(W + (size_t)(k0 + 8 * i + (lane >> 3)) * ldw + n0 + 4 * (lane & 7)));
#pragma unroll
    for (int i = 0; i < 8; ++i) { const int kk = 8 * i + (lane >> 3); f32x4 x = v[i]; if (gain) x = x * gain[k0 + kk];
        LAS float* d = scr + kk * 33 + 4 * (lane & 7); d[0] = x[0]; d[1] = x[1]; d[2] = x[2]; d[3] = x[3]; }
    LDS_WAIT(); asm volatile("" ::: "memory");
    const int c = lane & 7;
#pragma unroll
    for (int j = 0; j < 4; ++j) { const int n = (lane >> 3) + 8 * j; const LAS float* s = scr + (8 * c) * 33 + n;
        v4u o; o.x = pk2(s[0 * 33], s[1 * 33]); o.y = pk2(s[2 * 33], s[3 * 33]); o.z = pk2(s[4 * 33], s[5 * 33]); o.w = pk2(s[6 * 33], s[7 * 33]);
        __builtin_nontemporal_store(o, (GAS v4u*)(WT + (size_t)(n0 + n) * ldo + k0 + 8 * c)); }
    LDS_WAIT(); asm volatile("" ::: "memory");
}
__device__ __forceinline__ void tr_job(const Ctx& c, int& base, const float* W, int ldw, int ncols, int K, const float* gain, bf16* WT, LAS float* scr, int ldo = 0) {
    if (ldo == 0) ldo = K;
    const int nblk = ncols / 32, nitems = (K / 64) * nblk;
    int first = (c.gw - base) % c.NGW; if (first < 0) first += c.NGW;
    for (int it = first; it < nitems; it += c.NGW) tr_item(W, ldw, K, gain, WT, scr, it / nblk, it % nblk, c.lane, ldo);
    base = (base + nitems) % c.NGW;
}
__device__ __forceinline__ void sincos_d(double x, double& s, double& c) {
    const double j = __builtin_rint(x * 0.63661977236758134308);
    double r = __builtin_fma(-j, 1.57079632673412561417e+00, x); r = __builtin_fma(-j, 6.07710050650619224932e-11, r);
    const double z = r * r;
    const double sp = r + r * z * (-1.66666666666666307295e-1 + z * (8.33333333332211858878e-3 + z * (-1.98412698295895385996e-4 + z * (2.75573136213857245213e-6 + z * (-2.50507477628578072866e-8 + z * 1.58962301576546568060e-10)))));
    const double cp = 1.0 - 0.5 * z + z * z * (4.16666666666665929218e-2 + z * (-1.38888888888730564116e-3 + z * (2.48015872888517045348e-5 + z * (-2.75573141792967388112e-7 + z * (2.08757008419747316778e-9 + z * -1.13585365213876817300e-11)))));
    const int q = ((int)j) & 3;
    s = (q == 0) ? sp : (q == 1) ? cp : (q == 2) ? -sp : -cp;
    c = (q == 0) ? cp : (q == 1) ? -sp : (q == 2) ? -cp : sp;
}
__device__ __forceinline__ void p0_weights_rest(const Ctx& c) {
    LAS float* scr = (LAS float*)(c.lds + RING_OFF + c.wave * 16384);
    const InPtrs in = c.in; unsigned char* ws = c.ws;
    bf16* Wb = (bf16*)(ws + WS_W);
    int base = 0;
    for (int e = 0; e < 2; ++e) {
        if (e == 1) { const float* w = in[8] + (size_t)e * 1024 * 2064; const float* g = in[7] + e * 1024; bf16* dst = (bf16*)((unsigned char*)Wb + W_INE) + (size_t)e * NIN_E * 1024;
            tr_job(c, base, w, 2064, 1536, 1024, g, dst, scr);
            tr_job(c, base, w + 1552, 2064, 512, 1024, g, dst + (size_t)1536 * 1024, scr); }
        tr_job(c, base, in[20] + (size_t)e * 512 * 512, 512, 512, 512, nullptr, (bf16*)((unsigned char*)Wb + W_GLU) + (size_t)e * 512 * 512, scr);
        tr_job(c, base, in[22] + (size_t)e * 1024 * 1024, 1024, 1024, 1024, nullptr, (bf16*)((unsigned char*)Wb + W_OUTE) + (size_t)e * 1024 * 1024, scr);
    }
    for (int o = 0; o < 2; ++o) {
        tr_job(c, base, in[24] + (size_t)o * 1024 * 2048, 2048, 2048, 1024, in[23] + o * 1024, (bf16*)((unsigned char*)Wb + W_INO) + (size_t)o * 2048 * 1024, scr);
        tr_job(c, base, in[32] + (size_t)o * 1024 * 1024, 1024, 1024, 1024, nullptr, (bf16*)((unsigned char*)Wb + W_OUTO) + (size_t)o * 1024 * 1024, scr);
        for (int n = 0; n < 8; ++n) {
            bf16* dst = (bf16*)((unsigned char*)Wb + W_G) + ((size_t)o * 8 + n) * 256 * 128;
            tr_job(c, base, in[27] + ((size_t)o * 8 + n) * 128 * 128, 128, 128, 128, nullptr, dst, scr);
            tr_job(c, base, in[29] + ((size_t)o * 8 + n) * 128 * 128, 128, 128, 128, nullptr, dst + 128 * 128, scr);
        }
    }
    for (int l = 0; l < 4; ++l) {
        tr_job(c, base, in[34] + (size_t)l * 1024 * 4096, 4096, 4096, 1024, in[33] + l * 1024, (bf16*)((unsigned char*)Wb + W_UP) + (size_t)l * 4096 * 1024, scr);
        tr_job(c, base, in[35] + (size_t)l * 4096 * 1024, 1024, 1024, 4096, nullptr, (bf16*)((unsigned char*)Wb + W_DN) + (size_t)l * 1024 * LD_FF, scr, LD_FF);
    }
    __syncthreads();
}
__device__ __forceinline__ void p0_prologue(const Ctx& c) {
    LAS float* scr = (LAS float*)(c.lds + RING_OFF + c.wave * 16384);
    const InPtrs in = c.in; unsigned char* ws = c.ws;
    bf16* Wb = (bf16*)(ws + WS_W);
    int base = 0;
    { const float* w = in[8]; const float* g = in[7]; bf16* dst = (bf16*)((unsigned char*)Wb + W_INE);
      tr_job(c, base, w, 2064, 1536, 1024, g, dst, scr);
      tr_job(c, base, w + 1552, 2064, 512, 1024, g, dst + (size_t)1536 * 1024, scr); }
    const int gtid = c.vcu * (NWAVES * 64) + c.tid, NT = c.G * NWAVES * 64;
    for (int i = gtid; i < 2 * 16 * 128; i += NT) {
        const int e = i >> 11, j = (i >> 7) & 15, k0 = (i & 127) * 8; const float* w = in[8] + (size_t)e * 1024 * 2064 + 1536 + j; const float* g = in[7] + e * 1024;
        float o[8];
#pragma unroll
        for (int kk = 0; kk < 8; ++kk) o[kk] = w[(size_t)(k0 + kk) * 2064] * g[k0 + kk];
        v4u pk; pk.x = pk2(o[0], o[1]); pk.y = pk2(o[2], o[3]); pk.z = pk2(o[4], o[5]); pk.w = pk2(o[6], o[7]);
        *(v4u*)((bf16*)(ws + WS_WA) + ((size_t)e * 16 + j) * 1024 + k0) = pk;
    }
    for (int i = gtid; i < 2 * 256 * 2; i += NT) {
        const int e = i >> 9, n = (i >> 1) & 255, j0 = (i & 1) * 8; const float* a2 = in[9] + (size_t)e * 16 * 256 + n;
        float o[8];
#pragma unroll
        for (int jj = 0; jj < 8; ++jj) o[jj] = a2[(size_t)(j0 + jj) * 256];
        v4u pk; pk.x = pk2(o[0], o[1]); pk.y = pk2(o[2], o[3]); pk.z = pk2(o[4], o[5]); pk.w = pk2(o[6], o[7]);
        *(v4u*)((bf16*)(ws + WS_WA) + 2 * 16 * 1024 + ((size_t)e * 256 + n) * 16 + j0) = pk;
    }
    for (int i = gtid; i < 2 * 32 * 64; i += NT) {
        const double dt = exp((double)in[14][i >> 6]);
        const double are = (double)in[12][i], aim = (double)in[13][i];
        const double zr = dt * are, zi = dt * aim; double sn, cs; sincos_d(zi, sn, cs);
        const double mag = exp(zr), abre = mag * cs, abim = mag * sn;
        double sh, ch; sincos_d(0.5 * zi, sh, ch);
        const double m1re = expm1(zr) * cs - 2.0 * sh * sh, m1im = abim;
        const double den = are * are + aim * aim;
        const double cre = (m1re * are + m1im * aim) / den, cim = (m1im * are - m1re * aim) / den;
        float* AB = (float*)(ws + CTL_S5AB); AB[2 * i] = (float)abre; AB[2 * i + 1] = (float)abim;
        float* BRE = (float*)(ws + CTL_S5BRE) + (size_t)i * 16; float* BIM = (float*)(ws + CTL_S5BIM) + (size_t)i * 16;
        const float* bre = in[15] + (size_t)i * 16; const float* bim = in[16] + (size_t)i * 16;
#pragma unroll
        for (int q = 0; q < 16; ++q) { const double br = bre[q], bi = bim[q]; BRE[q] = (float)(cre * br - cim * bi); BIM[q] = (float)(cre * bi + cim * br); }
    }
    bf16* XB = (bf16*)(ws + WS_XB); float* ssq0 = (float*)(ws + WS_SSQ);
    for (int m = c.gw; m < T; m += c.NGW) {
        const float* xr = (m < TP) ? in[0] + (size_t)m * D : in[1] + (size_t)(m - TP) * D;
        const GAS f32x4* x4 = (const GAS f32x4*)xr + c.lane; f32x4 v[4]; float s = 0.f;
#pragma unroll
        for (int j = 0; j < 4; ++j) { v[j] = __builtin_nontemporal_load(x4 + 64 * j); s += (v[j].x * v[j].x + v[j].y * v[j].y) + (v[j].z * v[j].z + v[j].w * v[j].w); }
        s = wave_sum(s);
        GAS v2u* o8 = (GAS v2u*)(XB + (size_t)m * D) + c.lane;
#pragma unroll
        for (int j = 0; j < 4; ++j) { v2u w; w.x = pk2(v[j].x, v[j].y); w.y = pk2(v[j].z, v[j].w); o8[64 * j] = w; }
        if (c.lane < 4) ssq0[(size_t)c.lane * T + m] = (c.lane == 0) ? s : 0.f;
    }
}
__device__ __forceinline__ void gla_naive_block(const Ctx& c, int e, int item0, bool sample) {
    unsigned char* ws = c.ws;
    const bf16* P = (const bf16*)(ws + WS_R + R_P); const float* LA = (const float*)(ws + WS_R + R_LA); bf16* ORAW = (bf16*)(ws + WS_R + R_ORAW);
    const int sub = c.tid >> 7, st = c.tid & 127, item = item0 + sub, b = item >> 2, h = item & 3;
    const int row0 = sample ? TP + b * 4 : b * 2048, n = sample ? 4 : 2048;
    float S[64];
    if (sample) { const float* s0 = c.in[2] + (((size_t)e * 128 + b) * 4 + h) * 8192;
#pragma unroll
        for (int d = 0; d < 64; ++d) S[d] = s0[d * 128 + st]; }
    else {
#pragma unroll
        for (int d = 0; d < 64; ++d) S[d] = 0.f; }
    LAS float* lq = (LAS float*)(c.lds + RING_OFF) + sub * 5120; LAS float* lk = lq + 1024; LAS float* la = lq + 2048; LAS float* lv = lq + 3072;
    for (int t0 = 0; t0 < n; t0 += 16) {
        const int nt = (n - t0) < 16 ? (n - t0) : 16;
        __syncthreads();
#pragma unroll
        for (int i = 0; i < 8; ++i) { const int idx = st + 128 * i, tt = idx >> 6, d = idx & 63;
            if (tt < nt) { const size_t row = (size_t)(row0 + t0 + tt);
                lq[idx] = bf2f(P[row * 2048 + h * 64 + d]); lk[idx] = bf2f(P[row * 2048 + 256 + h * 64 + d]); la[idx] = __expf(LA[row * 256 + h * 64 + d]); } }
#pragma unroll
        for (int tt = 0; tt < 16; ++tt) if (tt < nt) lv[tt * 128 + st] = bf2f(P[(size_t)(row0 + t0 + tt) * 2048 + 512 + h * 128 + st]);
        __syncthreads();
#pragma unroll 1
        for (int tt = 0; tt < nt; ++tt) {
            const float v = lv[tt * 128 + st]; float o = 0.f;
#pragma unroll
            for (int d4 = 0; d4 < 16; ++d4) { const f32x4 a4 = *(const LAS f32x4*)(la + tt * 64 + 4 * d4), k4 = *(const LAS f32x4*)(lk + tt * 64 + 4 * d4), q4 = *(const LAS f32x4*)(lq + tt * 64 + 4 * d4);
#pragma unroll
                for (int i = 0; i < 4; ++i) { S[4 * d4 + i] = a4[i] * S[4 * d4 + i] + k4[i] * v; o += q4[i] * S[4 * d4 + i]; } }
            ORAW[(size_t)(row0 + t0 + tt) * 512 + h * 128 + st] = (bf16)f2bf(o * 0.125f);
        }
    }
    float* dst = c.out + (sample ? OUT_GLAS + (((size_t)e * 128 + b) * 4 + h) * 8192 : OUT_GLAP + (((size_t)e * 8 + b) * 4 + h) * 8192);
#pragma unroll
    for (int d = 0; d < 64; ++d) dst[d * 128 + st] = S[d];
}
__device__ __forceinline__ void s5_naive_wave(const Ctx& c, int e, int item, bool sample, LAS float* wl) {
    unsigned char* ws = c.ws; const int lane = c.lane;
    const bf16* P = (const bf16*)(ws + WS_R + R_P); bf16* Z1 = (bf16*)(ws + WS_R + R_Z1);
    const int b = item >> 5, g = item & 31, row0 = sample ? TP + b * 4 : b * 2048, n = sample ? 4 : 2048;
    const int idx = (e * 32 + g) * 64 + lane;
    const float* AB = (const float*)(ws + CTL_S5AB); const float ar = AB[2 * idx], ai = AB[2 * idx + 1];
    float bre[16], bim[16];
    { const f32x4* r4 = (const f32x4*)((const float*)(ws + CTL_S5BRE) + (size_t)idx * 16); const f32x4* i4 = (const f32x4*)((const float*)(ws + CTL_S5BIM) + (size_t)idx * 16);
#pragma unroll
      for (int q = 0; q < 4; ++q) { const f32x4 a = r4[q], bb = i4[q];
#pragma unroll
          for (int j = 0; j < 4; ++j) { bre[4 * q + j] = a[j]; bim[4 * q + j] = bb[j]; } } }
    float hre = 0.f, him = 0.f;
    if (sample) { hre = c.in[3][(((size_t)e * 128 + b) * 32 + g) * 64 + lane]; him = c.in[4][(((size_t)e * 128 + b) * 32 + g) * 64 + lane]; }
    LAS float* lcre = wl; LAS float* lcim = wl + 1024; LAS float* lu = wl + 2048; LAS float* hs = wl + 2176;
    { const float* cr = c.in[17] + (size_t)(e * 32 + g) * 1024; const float* ci = c.in[18] + (size_t)(e * 32 + g) * 1024;
#pragma unroll
      for (int i = 0; i < 16; ++i) { lcre[i * 64 + lane] = cr[i * 64 + lane]; lcim[i * 64 + lane] = ci[i * 64 + lane]; } }
    const int ott = lane >> 3, oc0 = 2 * (lane & 7);
    const float dsk0 = c.in[19][(e * 32 + g) * 16 + oc0], dsk1 = c.in[19][(e * 32 + g) * 16 + oc0 + 1];
    for (int t0 = 0; t0 < n; t0 += 8) {
        const int nt = (n - t0) < 8 ? (n - t0) : 8;
#pragma unroll
        for (int i = 0; i < 2; ++i) { const int ix = lane + 64 * i, tt = ix >> 4, cc = ix & 15;
            lu[ix] = (tt < nt) ? bf2f(P[(size_t)(row0 + t0 + tt) * 2048 + 1536 + g * 16 + cc]) : 0.f; }
        LDS_WAIT(); asm volatile("" ::: "memory");
#pragma unroll
        for (int tt = 0; tt < 8; ++tt) {
            if (tt < nt) {
                float bur = 0.f, bui = 0.f;
#pragma unroll
                for (int q = 0; q < 4; ++q) { const f32x4 u4 = *(const LAS f32x4*)(lu + tt * 16 + 4 * q);
#pragma unroll
                    for (int j = 0; j < 4; ++j) { bur += u4[j] * bre[4 * q + j]; bui += u4[j] * bim[4 * q + j]; } }
                const float nre = ar * hre - ai * him + bur, nim = ar * him + ai * hre + bui; hre = nre; him = nim;
                hs[tt * 128 + lane] = hre; hs[tt * 128 + 64 + lane] = him;
            }
        }
        LDS_WAIT(); asm volatile("" ::: "memory");
        if (ott < nt) {
            float y0 = 0.f, y1 = 0.f;
#pragma unroll
            for (int p4 = 0; p4 < 16; ++p4) {
                const f32x4 hr = *(const LAS f32x4*)(hs + ott * 128 + 4 * p4), hi = *(const LAS f32x4*)(hs + ott * 128 + 64 + 4 * p4);
                const f32x4 c0r = *(const LAS f32x4*)(lcre + oc0 * 64 + 4 * p4), c0i = *(const LAS f32x4*)(lcim + oc0 * 64 + 4 * p4);
                const f32x4 c1r = *(const LAS f32x4*)(lcre + (oc0 + 1) * 64 + 4 * p4), c1i = *(const LAS f32x4*)(lcim + (oc0 + 1) * 64 + 4 * p4);
#pragma unroll
                for (int j = 0; j < 4; ++j) { y0 += hr[j] * c0r[j] - hi[j] * c0i[j]; y1 += hr[j] * c1r[j] - hi[j] * c1i[j]; }
            }
            y0 += dsk0 * lu[ott * 16 + oc0]; y1 += dsk1 * lu[ott * 16 + oc0 + 1];
            *(unsigned*)(Z1 + (size_t)(row0 + t0 + ott) * 512 + g * 16 + oc0) = pk2(gelu_tanh_f(y0), gelu_tanh_f(y1));
        }
        LDS_WAIT(); asm volatile("" ::: "memory");
    }
    float* dre = c.out + (sample ? OUT_RES + (((size_t)e * 128 + b) * 32 + g) * 64 : OUT_REP + (((size_t)e * 8 + b) * 32 + g) * 64);
    float* dim = c.out + (sample ? OUT_IMS + (((size_t)e * 128 + b) * 32 + g) * 64 : OUT_IMP + (((size_t)e * 8 + b) * 32 + g) * 64);
    dre[lane] = hre; dim[lane] = him;
}
__device__ __forceinline__ void gla_post(const Ctx& c, int e) {
    unsigned char* ws = c.ws; const int lane = c.lane;
    const bf16* P = (const bf16*)(ws + WS_R + R_P); const bf16* ORAW = (const bf16*)(ws + WS_R + R_ORAW); bf16* MIX = (bf16*)(ws + WS_R + R_MIX);
    const float* gn = c.in[11] + e * 512;
    for (int wi = TP * 4 + c.gw; wi < T * 4; wi += c.NGW) {
        const int row = wi >> 2, h = wi & 3;
        const unsigned ow = *(const unsigned*)(ORAW + (size_t)row * 512 + h * 128 + 2 * lane);
        const float o0 = bflo(ow), o1 = bfhi(ow);
        const float ss = wave_sum(o0 * o0 + o1 * o1), rs = rsqrtf(ss * (1.0f / 128.0f) + EPS);
        const unsigned gw = *(const unsigned*)(P + (size_t)row * 2048 + 1024 + h * 128 + 2 * lane);
        *(unsigned*)(MIX + (size_t)row * 1024 + h * 128 + 2 * lane) = pk2(o0 * rs * gn[h * 128 + 2 * lane] * bflo(gw), o1 * rs * gn[h * 128 + 2 * lane + 1] * bfhi(gw));
    }
}
__device__ __forceinline__ void final_norm(const Ctx& c) {
    const float* nf = c.in[36]; const bf16* XB = (const bf16*)(c.ws + WS_XB);
    for (int m = c.gw; m < T; m += c.NGW) {
        const v4u* x8 = (const v4u*)(XB + (size_t)m * D) + c.lane; float v[16]; float s = 0.f;
#pragma unroll
        for (int j = 0; j < 2; ++j) { const v4u w = x8[64 * j];
#pragma unroll
            for (int q = 0; q < 4; ++q) { v[8 * j + 2 * q] = bflo(w[q]); v[8 * j + 2 * q + 1] = bfhi(w[q]); } }
#pragma unroll
        for (int i = 0; i < 16; ++i) s += v[i] * v[i];
        const float rs = rsqrtf(wave_sum(s) * (1.0f / 1024.0f) + EPS);
#pragma unroll
        for (int j = 0; j < 2; ++j) { const int col = 512 * j + 8 * c.lane; const f32x4 g0 = *(const f32x4*)(nf + col), g1 = *(const f32x4*)(nf + col + 4);
            f32x4 o0, o1;
#pragma unroll
            for (int q = 0; q < 4; ++q) { o0[q] = v[8 * j + q] * rs * g0[q]; o1[q] = v[8 * j + 4 + q] * rs * g1[q]; }
            *(f32x4*)(c.out + (size_t)m * D + col) = o0; *(f32x4*)(c.out + (size_t)m * D + col + 4) = o1; }
    }
}
typedef float f32x16 __attribute__((ext_vector_type(16)));
typedef short s16x4 __attribute__((ext_vector_type(4)));
typedef float f32x2_t __attribute__((ext_vector_type(2)));
typedef __bf16 bf16x2_t __attribute__((ext_vector_type(2)));
#define MFMA32(a, b, c) __builtin_amdgcn_mfma_f32_32x32x16_bf16((a), (b), (c), 0, 0, 0)
__device__ __forceinline__ unsigned cvtpk(float lo, float hi) { f32x2_t v = {lo, hi}; bf16x2_t b = __builtin_convertvector(v, bf16x2_t); return __builtin_bit_cast(unsigned, b); }
template <int S_> __device__ __forceinline__ bf16x8 pack_step(const f32x16& x) {
    v4u p; p.x = cvtpk(x[8 * S_], x[8 * S_ + 1]); p.y = cvtpk(x[8 * S_ + 2], x[8 * S_ + 3]); p.z = cvtpk(x[8 * S_ + 4], x[8 * S_ + 5]); p.w = cvtpk(x[8 * S_ + 6], x[8 * S_ + 7]);
    return __builtin_bit_cast(bf16x8, p);
}
__device__ __forceinline__ s16x4 trr(const LAS unsigned char* p) { return __builtin_bit_cast(s16x4, __builtin_amdgcn_ds_read_tr16_b64_v4i16((LAS s16x4*)p)); }
__device__ __forceinline__ bf16x8 cat8(s16x4 lo, s16x4 hi) { return __builtin_shufflevector(lo, hi, 0, 1, 2, 3, 4, 5, 6, 7); }
__device__ __forceinline__ bf16x8 cat8u(v2u lo, v2u hi) { v4u w; w.x = lo.x; w.y = lo.y; w.z = hi.x; w.w = hi.y; return __builtin_bit_cast(bf16x8, w); }
constexpr int GL_PQ = 144, GL_PV = 320, GL_PSG = 272;
constexpr int GL_QS = 0, GL_KS = 32 * GL_PQ, GL_V = 2 * 32 * GL_PQ, GL_SG = GL_V + 32 * GL_PV, GL_EL = GL_SG + 32 * GL_PSG, GL_BUF = GL_EL + 256;
constexpr int GL_TOT = 2 * GL_BUF, GL_PART = GL_TOT + 2048, GL_END = GL_PART + 512;
static_assert(GL_BUF % 16 == 0 && GL_END <= RING_BYTES, "GLA LDS map");

__device__ __forceinline__ void gla_fast_block(const Ctx& c, int e, int item) {
    unsigned char* ws = c.ws;
    const bf16* P = (const bf16*)(ws + WS_R + R_P); const float* LA = (const float*)(ws + WS_R + R_LA); bf16* MIX = (bf16*)(ws + WS_R + R_MIX);
    const int b = item >> 2, hh = item & 3, row0 = b * 2048;
    const int lane = c.lane, r32 = lane & 31, h = lane >> 5, wv = c.wave;
    LAS unsigned char* L = c.lds + RING_OFF;
    const int i16 = lane & 15, tq = i16 >> 2, tp = i16 & 3, blk = (lane >> 4) & 1;
    const bool consumer = wv < 4;
    if (consumer) {
        const int et = wv & 3;
        f32x16 S0, S1, O;
#pragma unroll
        for (int r = 0; r < 16; ++r) { S0[r] = 0.f; S1[r] = 0.f; }
        float gh[16];
#pragma unroll
        for (int r = 0; r < 16; ++r) gh[r] = c.in[11][e * 512 + hh * 128 + 32 * et + (r & 3) + 8 * (r >> 2) + 4 * h];
        __syncthreads(); __syncthreads();
        for (int n = 0; n < 64; ++n) {
            const int bo = (n & 1) * GL_BUF;
            float rs = 0.f;
            const LAS unsigned char* Qs = L + bo + GL_QS; const LAS unsigned char* Ks = L + bo + GL_KS; const LAS unsigned char* Vi = L + bo + GL_V;
            f32x16 X;
#pragma unroll
            for (int r = 0; r < 16; ++r) X[r] = 0.f;
#pragma unroll
            for (int s = 0; s < 4; ++s) { const bf16x8 ka = *(const LAS bf16x8*)(Ks + r32 * GL_PQ + 32 * s + 16 * h), qb = *(const LAS bf16x8*)(Qs + r32 * GL_PQ + 32 * s + 16 * h); X = MFMA32(ka, qb, X); }
#pragma unroll
            for (int r = 0; r < 16; ++r) { const int j = (r & 3) + 8 * (r >> 2) + 4 * h; X[r] = (j <= r32) ? X[r] : 0.f; }
            const bf16x8 px0 = pack_step<0>(X), px1 = pack_step<1>(X);
#pragma unroll
            for (int r = 0; r < 16; ++r) O[r] = 0.f;
            { const LAS unsigned char* vb = Vi + (4 * h + tq) * GL_PV + (32 * et + 16 * blk + 4 * tp) * 2;
              const bf16x8 a0 = cat8(trr(vb), trr(vb + 8 * GL_PV)), a1 = cat8(trr(vb + 16 * GL_PV), trr(vb + 24 * GL_PV));
              O = MFMA32(a0, px0, O); O = MFMA32(a1, px1, O); }
            { const LAS unsigned char* qp = Qs + r32 * GL_PQ + 8 * h;
              const bf16x8 sa0 = pack_step<0>(S0), sa1 = pack_step<1>(S0), sa2 = pack_step<0>(S1), sa3 = pack_step<1>(S1);
              const bf16x8 b0 = cat8u(*(const LAS v2u*)(qp), *(const LAS v2u*)(qp + 16)), b1 = cat8u(*(const LAS v2u*)(qp + 32), *(const LAS v2u*)(qp + 48));
              const bf16x8 b2 = cat8u(*(const LAS v2u*)(qp + 64), *(const LAS v2u*)(qp + 80)), b3 = cat8u(*(const LAS v2u*)(qp + 96), *(const LAS v2u*)(qp + 112));
              O = MFMA32(sa0, b0, O); O = MFMA32(sa1, b1, O); O = MFMA32(sa2, b2, O); O = MFMA32(sa3, b3, O); }
            { const LAS unsigned char* kb = Ks + (8 * h + tq) * GL_PQ + (16 * blk + 4 * tp) * 2; const LAS unsigned char* vb = Vi + (8 * h + tq) * GL_PV + (32 * et + 16 * blk + 4 * tp) * 2;
              const bf16x8 v0 = cat8(trr(vb), trr(vb + 4 * GL_PV)), v1 = cat8(trr(vb + 16 * GL_PV), trr(vb + 20 * GL_PV));
              const bf16x8 k00 = cat8(trr(kb), trr(kb + 4 * GL_PQ)), k01 = cat8(trr(kb + 16 * GL_PQ), trr(kb + 20 * GL_PQ));
              const bf16x8 k10 = cat8(trr(kb + 64), trr(kb + 64 + 4 * GL_PQ)), k11 = cat8(trr(kb + 64 + 16 * GL_PQ), trr(kb + 64 + 20 * GL_PQ));
              S0 = MFMA32(k00, v0, S0); S0 = MFMA32(k01, v1, S0); S1 = MFMA32(k10, v0, S1); S1 = MFMA32(k11, v1, S1);
              const LAS float* el = (const LAS float*)(L + bo + GL_EL);
#pragma unroll
              for (int g4 = 0; g4 < 4; ++g4) { const f32x4 f0 = *(const LAS f32x4*)(el + 8 * g4 + 4 * h), f1 = *(const LAS f32x4*)(el + 32 + 8 * g4 + 4 * h);
#pragma unroll
                  for (int q = 0; q < 4; ++q) { S0[4 * g4 + q] *= f0[q]; S1[4 * g4 + q] *= f1[q]; } } }
            float ss = 0.f;
#pragma unroll
            for (int r = 0; r < 16; ++r) ss += O[r] * O[r];
            ss += __shfl_xor(ss, 32);
            if (h == 0) *(LAS float*)(L + GL_PART + (et * 32 + r32) * 4) = ss;
            __syncthreads();
            const LAS float* part = (const LAS float*)(L + GL_PART);
            const float tot = (part[r32] + part[32 + r32]) + (part[64 + r32] + part[96 + r32]);
            rs = rsqrtf(tot * (1.0f / 128.0f) + EPS);
            const LAS unsigned char* sgp = L + bo + GL_SG + r32 * GL_PSG + (32 * et + 4 * h) * 2;
            bf16* dst = MIX + (size_t)(row0 + 32 * n + r32) * 1024 + hh * 128 + 32 * et + 4 * h;
#pragma unroll
            for (int g4 = 0; g4 < 4; ++g4) { const v2u sg = *(const LAS v2u*)(sgp + 16 * g4);
                v2u ov; ov.x = cvtpk(O[4 * g4] * rs * gh[4 * g4] * bflo(sg.x), O[4 * g4 + 1] * rs * gh[4 * g4 + 1] * bfhi(sg.x));
                ov.y = cvtpk(O[4 * g4 + 2] * rs * gh[4 * g4 + 2] * bflo(sg.y), O[4 * g4 + 3] * rs * gh[4 * g4 + 3] * bfhi(sg.y));
                *(v2u*)(dst + 8 * g4) = ov; }
            __syncthreads();
        }
        float* dst = c.out + OUT_GLAP + (((size_t)e * 8 + b) * 4 + hh) * 8192 + 32 * et + r32;
#pragma unroll
        for (int r = 0; r < 16; ++r) { const int d = (r & 3) + 8 * (r >> 2) + 4 * h; dst[(size_t)d * 128] = S0[r]; dst[(size_t)(32 + d) * 128] = S1[r]; }
    } else {
        const int pt = c.tid - 256, dp = pt & 31, jq = (pt >> 5) & 7;
        f32x2_t la2[4][4]; unsigned q2[4][4], k2[4][4]; v4u vraw[4][2], graw[4][2];
        float cs0[4], cs1[4];
#define GLA_LOAD(chunk, RS) do { const size_t rb_ = (size_t)(row0 + 32 * (chunk)); \
        _Pragma("unroll") for (int j_ = 0; j_ < 4; ++j_) { const size_t rw_ = rb_ + 4 * jq + j_; \
            la2[RS][j_] = *(const f32x2_t*)(LA + rw_ * 256 + hh * 64 + 2 * dp); q2[RS][j_] = *(const unsigned*)(P + rw_ * 2048 + hh * 64 + 2 * dp); k2[RS][j_] = *(const unsigned*)(P + rw_ * 2048 + 256 + hh * 64 + 2 * dp); } \
        _Pragma("unroll") for (int x_ = 0; x_ < 2; ++x_) { const int pc_ = pt + 256 * x_, j_ = pc_ >> 4, e8_ = pc_ & 15; \
            vraw[RS][x_] = *(const v4u*)(P + (rb_ + j_) * 2048 + 512 + hh * 128 + 8 * e8_); graw[RS][x_] = *(const v4u*)(P + (rb_ + j_) * 2048 + 1024 + hh * 128 + 8 * e8_); } } while (0)
#define GLA_PROD1(bufo, RS) do { \
        _Pragma("unroll") for (int x_ = 0; x_ < 2; ++x_) { const int pc_ = pt + 256 * x_, j_ = pc_ >> 4, e8_ = pc_ & 15; \
            *(LAS v4u*)(L + (bufo) + GL_V + j_ * GL_PV + 16 * e8_) = vraw[RS][x_]; *(LAS v4u*)(L + (bufo) + GL_SG + j_ * GL_PSG + 16 * e8_) = graw[RS][x_]; } \
        cs0[0] = la2[RS][0].x; cs1[0] = la2[RS][0].y; \
        _Pragma("unroll") for (int j_ = 1; j_ < 4; ++j_) { cs0[j_] = cs0[j_ - 1] + la2[RS][j_].x; cs1[j_] = cs1[j_ - 1] + la2[RS][j_].y; } \
        *(LAS f32x2_t*)(L + GL_TOT + (jq * 64 + 2 * dp) * 4) = (f32x2_t){cs0[3], cs1[3]}; } while (0)
#define GLA_PROD2(bufo, RS) do { float p0_ = 0.f, p1_ = 0.f, t0_ = 0.f, t1_ = 0.f; \
        _Pragma("unroll") for (int g_ = 0; g_ < 8; ++g_) { const f32x2_t tv_ = *(const LAS f32x2_t*)(L + GL_TOT + (g_ * 64 + 2 * dp) * 4); if (g_ < jq) { p0_ += tv_.x; p1_ += tv_.y; } t0_ += tv_.x; t1_ += tv_.y; } \
        _Pragma("unroll") for (int j_ = 0; j_ < 4; ++j_) { const float c0_ = p0_ + cs0[j_], c1_ = p1_ + cs1[j_]; \
            const float q0_ = bflo(q2[RS][j_]) * __expf(c0_) * 0.125f, q1_ = bfhi(q2[RS][j_]) * __expf(c1_) * 0.125f, k0_ = bflo(k2[RS][j_]) * __expf(-c0_), k1_ = bfhi(k2[RS][j_]) * __expf(-c1_); \
            *(LAS unsigned*)(L + (bufo) + GL_QS + (4 * jq + j_) * GL_PQ + 4 * dp) = cvtpk(q0_, q1_); *(LAS unsigned*)(L + (bufo) + GL_KS + (4 * jq + j_) * GL_PQ + 4 * dp) = cvtpk(k0_, k1_); } \
        if (jq == 0) *(LAS f32x2_t*)(L + (bufo) + GL_EL + 8 * dp) = (f32x2_t){__expf(t0_), __expf(t1_)}; } while (0)

        GLA_LOAD(0, 0); GLA_LOAD(1, 1); GLA_LOAD(2, 2); GLA_LOAD(3, 3); GLA_PROD1(0, 0);
        __syncthreads();
        GLA_PROD2(0, 0);
        __syncthreads();
#define GLA_PITER(n, PAR) do { const int bn = GL_BUF - ((n) & 1) * GL_BUF; \
            if ((n) < 60) GLA_LOAD((n) + 4, PAR); \
            if ((n) < 63) GLA_PROD1(bn, (PAR + 1) & 3); \
            __syncthreads(); \
            if ((n) < 63) GLA_PROD2(bn, (PAR + 1) & 3); \
            __syncthreads(); } while (0)
        for (int nn = 0; nn < 64; nn += 4) { GLA_PITER(nn, 0); GLA_PITER(nn + 1, 1); GLA_PITER(nn + 2, 2); GLA_PITER(nn + 3, 3); }
#undef GLA_PITER
#undef GLA_LOAD
#undef GLA_PROD1
#undef GLA_PROD2
    }
}
constexpr int S5_PBU = 528, S5_PH = 272;
__device__ __forceinline__ float fma_s(float a, float b, float c) { float r; asm("v_fma_f32 %0, %1, %2, %3" : "=v"(r) : "v"(a), "v"(b), "v"(c)); return r; }
constexpr int S5P_ITEM_LDS = 2 * (32 * S5_PBU + 32 * S5_PH);
__device__ __forceinline__ void s5_pipe_block(const Ctx& c, int e, int item0) {
    unsigned char* ws = c.ws; const int lane = c.lane, r32 = lane & 31, h = lane >> 5, wv = c.wave;
    const bf16* P = (const bf16*)(ws + WS_R + R_P); bf16* Z1 = (bf16*)(ws + WS_R + R_Z1);
    const int slot = wv / 3, role = (wv < 6) ? wv - 3 * slot : 3, item = item0 + (slot & 1);
    const int b = item >> 5, g = item & 31, row0 = b * 2048, eg = e * 32 + g;
    LAS unsigned char* BU0 = c.lds + RING_OFF + (slot & 1) * S5P_ITEM_LDS; LAS unsigned char* HB0 = BU0 + 2 * 32 * S5_PBU;
    bf16x8 Bf[4], Cf[8]; float dsk[8]; float ar = 0.f, ai = 0.f, nai = 0.f, hre = 0.f, him = 0.f;
#pragma unroll
    for (int nt = 0; nt < 4; ++nt) Bf[nt] = (bf16x8){0, 0, 0, 0, 0, 0, 0, 0};
#pragma unroll
    for (int s8 = 0; s8 < 8; ++s8) { Cf[s8] = (bf16x8){0, 0, 0, 0, 0, 0, 0, 0}; dsk[s8] = 0.f; }
    if (role == 0) {
#pragma unroll
        for (int nt = 0; nt < 4; ++nt) { const int n = 32 * nt + r32; const float* src = (const float*)(ws + (n < 64 ? CTL_S5BRE : CTL_S5BIM)) + ((size_t)eg * 64 + (n & 63)) * 16 + 8 * h;
            const f32x4 x0 = *(const f32x4*)src, x1 = *(const f32x4*)(src + 4); v4u w; w.x = cvtpk(x0[0], x0[1]); w.y = cvtpk(x0[2], x0[3]); w.z = cvtpk(x1[0], x1[1]); w.w = cvtpk(x1[2], x1[3]); Bf[nt] = __builtin_bit_cast(bf16x8, w); }
    } else if (role == 1) {
        const float* AB = (const float*)(ws + CTL_S5AB); ar = AB[2 * (eg * 64 + lane)]; ai = AB[2 * (eg * 64 + lane) + 1]; nai = -ai;
    } else if (role == 2) {
#pragma unroll
        for (int s8 = 0; s8 < 8; ++s8) { const int n0 = 16 * s8 + 8 * h; v4u w = {0u, 0u, 0u, 0u};
            if (r32 < 16) { const float* src = (n0 < 64 ? c.in[17] : c.in[18]) + ((size_t)eg * 16 + r32) * 64 + (n0 & 63); const float sg = (n0 < 64) ? 1.f : -1.f;
                const f32x4 x0 = *(const f32x4*)src * sg, x1 = *(const f32x4*)(src + 4) * sg; w.x = cvtpk(x0[0], x0[1]); w.y = cvtpk(x0[2], x0[3]); w.z = cvtpk(x1[0], x1[1]); w.w = cvtpk(x1[2], x1[3]); }
            Cf[s8] = __builtin_bit_cast(bf16x8, w); }
#pragma unroll
        for (int r = 0; r < 8; ++r) dsk[r] = c.in[19][eg * 16 + (r & 3) + 8 * (r >> 2) + 4 * h];
    }
    const bf16* up = P + (size_t)row0 * 2048 + 1536 + g * 16 + (size_t)r32 * 2048;
    v4u ucur = {0u, 0u, 0u, 0u}; v2u ua = {0u, 0u}, ub = {0u, 0u};
    if (role == 0) ucur = *(const v4u*)(up + 8 * h);
    for (int step = 0; step < 66; ++step) {
        if (role == 0 && step < 64) {
            const int n = step; LAS unsigned char* BU = BU0 + (n & 1) * 32 * S5_PBU;
            const v4u unext = (n < 63) ? *(const v4u*)(up + 8 * h + (size_t)(n + 1) * 32 * 2048) : ucur;
            const bf16x8 uf = __builtin_bit_cast(bf16x8, ucur);
#pragma unroll
            for (int nt = 0; nt < 4; ++nt) { f32x16 z;
#pragma unroll
                for (int r = 0; r < 16; ++r) z[r] = 0.f;
                const f32x16 d = MFMA32(uf, Bf[nt], z);
#pragma unroll
                for (int r = 0; r < 16; ++r) *(LAS float*)(BU + ((r & 3) + 8 * (r >> 2) + 4 * h) * S5_PBU + (32 * nt + r32) * 4) = d[r]; }
            ucur = unext;
        } else if (role == 1 && step >= 1 && step < 65) {
            const int n = step - 1; const LAS unsigned char* BU = BU0 + (n & 1) * 32 * S5_PBU; LAS unsigned char* HB = HB0 + (n & 1) * 32 * S5_PH;
            float br[32], bi[32];
#pragma unroll
            for (int t = 0; t < 32; ++t) { br[t] = *(const LAS float*)(BU + t * S5_PBU + 4 * lane); bi[t] = *(const LAS float*)(BU + t * S5_PBU + 256 + 4 * lane); }
            asm volatile("s_waitcnt lgkmcnt(0)" ::: "memory");
#pragma unroll
            for (int t = 0; t < 32; ++t) {
                const float t0 = fma_s(ar, hre, br[t]), t1 = fma_s(ar, him, bi[t]); const float nre = fma_s(nai, him, t0), nim = fma_s(ai, hre, t1); hre = nre; him = nim;
                const unsigned pk = cvtpk(hre, him);
                *(LAS bf16*)(HB + t * S5_PH + 2 * lane) = (bf16)(pk & 0xffffu); *(LAS bf16*)(HB + t * S5_PH + 128 + 2 * lane) = (bf16)(pk >> 16); }
        } else if (role == 2) {
            if (step >= 2) {
                const int n = step - 2; const LAS unsigned char* HB = HB0 + (n & 1) * 32 * S5_PH;
                f32x16 y;
#pragma unroll
                for (int r = 0; r < 16; ++r) y[r] = 0.f;
#pragma unroll
                for (int s8 = 0; s8 < 8; ++s8) { const bf16x8 hb = *(const LAS bf16x8*)(HB + r32 * S5_PH + 32 * s8 + 16 * h); y = MFMA32(Cf[s8], hb, y); }
                const float u0 = bflo(ua.x), u1 = bfhi(ua.x), u2 = bflo(ua.y), u3 = bfhi(ua.y), u4 = bflo(ub.x), u5 = bfhi(ub.x), u6 = bflo(ub.y), u7 = bfhi(ub.y);
                v2u o0, o1;
                o0.x = cvtpk(gelu_tanh_f(y[0] + dsk[0] * u0), gelu_tanh_f(y[1] + dsk[1] * u1)); o0.y = cvtpk(gelu_tanh_f(y[2] + dsk[2] * u2), gelu_tanh_f(y[3] + dsk[3] * u3));
                o1.x = cvtpk(gelu_tanh_f(y[4] + dsk[4] * u4), gelu_tanh_f(y[5] + dsk[5] * u5)); o1.y = cvtpk(gelu_tanh_f(y[6] + dsk[6] * u6), gelu_tanh_f(y[7] + dsk[7] * u7));
                bf16* zp = Z1 + (size_t)(row0 + 32 * n + r32) * 512 + g * 16 + 4 * h;
                *(v2u*)zp = o0; *(v2u*)(zp + 8) = o1;
            }
            if (step >= 1 && step < 65) { const bf16* q = up + 4 * h + (size_t)(step - 1) * 32 * 2048; ua = *(const v2u*)q; ub = *(const v2u*)(q + 8); }
        }
        __syncthreads();
    }
    if (role == 1) { c.out[OUT_REP + ((size_t)(e * 8 + b) * 32 + g) * 64 + lane] = hre; c.out[OUT_IMP + ((size_t)(e * 8 + b) * 32 + g) * 64 + lane] = him; }
}
__device__ __forceinline__ void even_mixer_v2(const Ctx& c, int e) {
    const int bid = (c.vcu & 31) * 8 + (c.vcu >> 5);
    if (bid < 32) { gla_fast_block(c, e, bid); }
    else if (bid < 160) {
        s5_pipe_block(c, e, (bid - 32) * 2);
    }
    else { for (int bi = bid - 160; bi < 128; bi += 96) { gla_naive_block(c, e, bi * 4, true); __syncthreads(); }
           for (int it = (bid - 160) * 8 + c.wave; it < 4096; it += 96 * 8) s5_naive_wave(c, e, it, true, (LAS float*)(c.lds + RING_OFF) + c.wave * 3200); }
}
typedef float f32x16s __attribute__((ext_vector_type(16)));
__device__ __forceinline__ float sq8(const v4u& w) { float s = 0.f;
#pragma unroll
    for (int q = 0; q < 4; ++q) { const float a = bflo(w[q]), b = bfhi(w[q]); s += a * a + b * b; }
    return s; }
template <int TN, bool NORM_A, class Epi> __device__ __forceinline__ void sgemm2(const Ctx& c, const bf16* A, const bf16* Bt, int N, int K, const Epi& E, int first_tile, int tile_stride, int ld = 0) {
    if (ld == 0) ld = K;
    constexpr int ROWS = 64 + TN, NP = ROWS * 16 / 512, PITCH = 272, BUFB = ROWS * PITCH, NSUB = TN / 32, KPARTS = 4 / NSUB, KSTEPS = 8 / KPARTS;
    const int lane = c.lane, r32 = lane & 31, h = lane >> 5, wv = c.wave, tid = c.tid;
    LAS unsigned char* L = c.lds + RING_OFF;
    const int wm = wv & 1, wn = (NSUB == 2) ? ((wv >> 1) & 1) : 0, kp = (NSUB == 2) ? (wv >> 2) : (wv >> 1);
    const int ntiles = 8 * (N / TN), nch = K / 128;
    for (int tile = first_tile; tile < ntiles; tile += tile_stride) {
        const int rb = tile & 7, cb = tile >> 3;
        const unsigned char* src[NP]; int dst[NP];
#pragma unroll
        for (int i = 0; i < NP; ++i) { const int p = tid + 512 * i, row = p >> 4, c16 = p & 15;
            src[i] = (const unsigned char*)((row < 64) ? A + (size_t)(64 * rb + row) * ld : Bt + (size_t)(TN * cb + row - 64) * ld) + 16 * c16; dst[i] = row * PITCH + 16 * c16; }
        v4u ra[NP], rb_[NP], rc_[NP], rd_[NP];
#pragma unroll
        for (int i = 0; i < NP; ++i) { ra[i] = *(const v4u*)(src[i]); rb_[i] = *(const v4u*)(src[i] + 256); rc_[i] = *(const v4u*)(src[i] + 512); rd_[i] = *(const v4u*)(src[i] + 768); }
#pragma unroll
        for (int i = 0; i < NP; ++i) *(LAS v4u*)(L + dst[i]) = ra[i];
        float ssa0 = 0.f, ssa1 = 0.f;
        if (NORM_A) { ssa0 = sq8(ra[0]); ssa1 = sq8(ra[1]); }
        f32x16s acc;
#pragma unroll
        for (int r = 0; r < 16; ++r) acc[r] = 0.f;
        __syncthreads();
#define SG_STEP(ch, RCUR, RNEXT) do { \
            if ((ch) + 4 < nch) { _Pragma("unroll") for (int i = 0; i < NP; ++i) RCUR[i] = *(const v4u*)(src[i] + (size_t)((ch) + 4) * 256); } \
            { const LAS unsigned char* bufp = L + ((ch) & 1) * BUFB; \
              _Pragma("unroll") for (int s = 0; s < KSTEPS; ++s) { const int ks = kp * KSTEPS + s; \
                  const bf16x8 fa = *(const LAS bf16x8*)(bufp + (32 * wm + r32) * PITCH + 32 * ks + 16 * h), fb = *(const LAS bf16x8*)(bufp + (64 + 32 * wn + r32) * PITCH + 32 * ks + 16 * h); \
                  acc = __builtin_amdgcn_mfma_f32_32x32x16_bf16(fa, fb, acc, 0, 0, 0); } } \
            if ((ch) + 1 < nch) { _Pragma("unroll") for (int i = 0; i < NP; ++i) *(LAS v4u*)(L + (((ch) + 1) & 1) * BUFB + dst[i]) = RNEXT[i]; if (NORM_A) { ssa0 += sq8(RNEXT[0]); ssa1 += sq8(RNEXT[1]); } } \
            __syncthreads(); } while (0)
        for (int ch = 0; ch < nch; ch += 4) { SG_STEP(ch, ra, rb_); SG_STEP(ch + 1, rb_, rc_); SG_STEP(ch + 2, rc_, rd_); SG_STEP(ch + 3, rd_, ra); }
#undef SG_STEP
        LAS float* red = (LAS float*)L;
#pragma unroll
        for (int r = 0; r < 16; ++r) red[wv * 1024 + ((r & 3) + 8 * (r >> 2) + 4 * h) * 32 + r32] = acc[r];
        if (NORM_A) {
#pragma unroll
            for (int o = 1; o < 16; o <<= 1) { ssa0 += __shfl_xor(ssa0, o); ssa1 += __shfl_xor(ssa1, o); }
            if ((tid & 15) == 0) { red[8192 + (tid >> 4)] = ssa0; red[8192 + 32 + (tid >> 4)] = ssa1; } }
        __syncthreads();
        if (tid < 64 * (TN / 8)) {
            const int row = tid / (TN / 8), cg = tid % (TN / 8), sm = row >> 5, sn = (8 * cg) >> 5, rr = row & 31, cc = (8 * cg) & 31;
            f32x4 v0 = {0.f, 0.f, 0.f, 0.f}, v1 = {0.f, 0.f, 0.f, 0.f};
#pragma unroll
            for (int q = 0; q < KPARTS; ++q) { const int w = (NSUB == 2) ? (sm + 2 * sn + 4 * q) : (sm + 2 * q);
                v0 = v0 + *(const LAS f32x4*)(red + w * 1024 + rr * 32 + cc); v1 = v1 + *(const LAS f32x4*)(red + w * 1024 + rr * 32 + cc + 4); }
            const int grow = pg8::TP_ROWS + 64 * rb + row; float s = 0.f;
            const float rs = NORM_A ? rsqrtf(red[8192 + row] * (1.0f / 1024.0f) + pg8::EPS_F) : E.row_scale(grow);
            f32x4 cb0, cb1; E.col8(TN * cb + 8 * cg, cb0, cb1);
            const pg8::u32x4 pre = Epi::HAS_PRE ? E.pre8(grow, TN * cb + 8 * cg) : (pg8::u32x4){0u, 0u, 0u, 0u};
            E.row8(grow, TN * cb + 8 * cg, v0, v1, rs, cb0, cb1, pre, s);
        }
        __syncthreads();
    }
}
constexpr int LR_PX = 272, LR_PAB = 264, LR_WAVE = 32 * LR_PX;
constexpr int LR_COMP = 8 * LR_WAVE;
static_assert(32 * LR_PAB <= LR_WAVE && LR_COMP + 4096 + 16384 <= RING_BYTES, "LRU LDS map");
__device__ __forceinline__ void lru_fused(const Ctx& c, int o) {
    unsigned char* ws = c.ws; const int lane = c.lane, r32 = lane & 31, h = lane >> 5, wv = c.wave;
    const bf16* CIN = (const bf16*)(ws + WS_R + R_CIN); const bf16* GT = (const bf16*)(ws + WS_R + R_XC); bf16* HG = (bf16*)(ws + WS_R + R_MIX);
    const int id = c.vcu, b = id >> 5, n = (id >> 2) & 7, cs = id & 3;
    const int chg = 128 * n + 32 * cs + r32;
    LAS unsigned char* XS = c.lds + RING_OFF + wv * LR_WAVE;
    LAS unsigned char* COMP = c.lds + RING_OFF + LR_COMP;
    const bf16* Wg = (const bf16*)(ws + WS_W + W_G) + ((size_t)o * 8 + n) * 256 * 128;
    LAS unsigned char* WF = c.lds + RING_OFF + LR_COMP + 4096;
#pragma unroll
    for (int i = 0; i < 2; ++i) { const int en = c.tid + 512 * i, rw = en >> 9, sk = (en >> 6) & 7, ln = en & 63;
        *(LAS v4u*)(WF + en * 16) = *(const v4u*)(Wg + (size_t)(rw * 128 + 32 * cs + (ln & 31)) * 128 + 16 * sk + 8 * (ln >> 5)); }
    __syncthreads();
    const float brc = c.in[28][o * 1024 + chg], bic = c.in[30][o * 1024 + chg];
    const float sp8 = 8.0f * log1pf(__expf(-c.in[31][o * 1024 + chg]));
    const int c8 = lane & 15, tq = lane >> 4, cch = 128 * n + 8 * c8;
    const float* cw = c.in[25] + (size_t)o * 4 * 1024 + cch; const float* cb = c.in[26] + o * 1024 + cch;
    float hc = 0.f;
    const int ntile = 8 + ((wv < 2) ? 1 : 0);
    for (int tt = 0; tt < 9; ++tt) {
        const bool sample = tt == 8;
        const bool active = tt < ntile;
        const int st = 2 * b + wv;
        const size_t rowb = sample ? (size_t)TP + 32 * st : (size_t)b * 2048 + 256 * tt + 32 * wv;
        float Aw = 1.f, Bw = 0.f, Ao = 1.f, Bo = 0.f;
        unsigned short gt[16];
        if (active) {
            { const size_t orow_ = rowb + 16 * h;
#pragma unroll
              for (int i = 0; i < 16; ++i) gt[i] = GT[(orow_ + i) * 1024 + chg]; }
            { float w0[8], w1[8], w2[8], w3[8], bs[8];
#pragma unroll
              for (int q = 0; q < 2; ++q) { const f32x4 a0 = *(const f32x4*)(cw + 4 * q), a1 = *(const f32x4*)(cw + 1024 + 4 * q), a2 = *(const f32x4*)(cw + 2048 + 4 * q), a3 = *(const f32x4*)(cw + 3072 + 4 * q), bb = *(const f32x4*)(cb + 4 * q);
#pragma unroll
                  for (int i = 0; i < 4; ++i) { w0[4 * q + i] = a0[i]; w1[4 * q + i] = a1[i]; w2[4 * q + i] = a2[i]; w3[4 * q + i] = a3[i]; bs[4 * q + i] = bb[i]; } }
              if (!sample) {
                  v4u xr[11];
#pragma unroll
                  for (int i = 0; i < 11; ++i) { const int tl = 8 * tq + i - 3; xr[i] = (v4u){0u, 0u, 0u, 0u};
                      if (256 * tt + 32 * wv + tl >= 0) xr[i] = *(const v4u*)(CIN + (size_t)((long)rowb + tl) * 1024 + cch); }
#pragma unroll
                  for (int i = 0; i < 8; ++i) { float y[8];
#pragma unroll
                      for (int q = 0; q < 4; ++q) {
                          y[2 * q] = bs[2 * q] + w0[2 * q] * bflo(xr[i][q]) + w1[2 * q] * bflo(xr[i + 1][q]) + w2[2 * q] * bflo(xr[i + 2][q]) + w3[2 * q] * bflo(xr[i + 3][q]);
                          y[2 * q + 1] = bs[2 * q + 1] + w0[2 * q + 1] * bfhi(xr[i][q]) + w1[2 * q + 1] * bfhi(xr[i + 1][q]) + w2[2 * q + 1] * bfhi(xr[i + 2][q]) + w3[2 * q + 1] * bfhi(xr[i + 3][q]); }
                      v4u ov; ov.x = cvtpk(y[0], y[1]); ov.y = cvtpk(y[2], y[3]); ov.z = cvtpk(y[4], y[5]); ov.w = cvtpk(y[6], y[7]);
                      *(LAS v4u*)(XS + (8 * tq + i) * LR_PX + 16 * c8) = ov; }
              } else {
#pragma unroll 1
                  for (int i = 0; i < 8; ++i) {
                      const int bt = 8 * st + 2 * tq + (i >> 2), stp = i & 3; const float* sc = c.in[6] + ((size_t)o * 128 + bt) * 3 * 1024 + cch;
                      float y[8];
#pragma unroll
                      for (int q = 0; q < 8; ++q) y[q] = bs[q];
#pragma unroll
                      for (int j = 0; j < 4; ++j) { const int sj = stp - 3 + j; float x[8];
                          if (sj >= 0) { const v4u x4 = *(const v4u*)(CIN + (rowb + 8 * tq + i - 3 + j) * 1024 + cch);
#pragma unroll
                              for (int q = 0; q < 4; ++q) { x[2 * q] = bflo(x4[q]); x[2 * q + 1] = bfhi(x4[q]); } }
                          else { const f32x4 s0 = *(const f32x4*)(sc + (size_t)(sj + 3) * 1024), s1 = *(const f32x4*)(sc + (size_t)(sj + 3) * 1024 + 4);
#pragma unroll
                              for (int q = 0; q < 4; ++q) { x[q] = s0[q]; x[4 + q] = s1[q]; } }
#pragma unroll
                          for (int q = 0; q < 8; ++q) y[q] += ((j == 0) ? w0[q] : (j == 1) ? w1[q] : (j == 2) ? w2[q] : w3[q]) * x[q]; }
                      v4u ov; ov.x = cvtpk(y[0], y[1]); ov.y = cvtpk(y[2], y[3]); ov.z = cvtpk(y[4], y[5]); ov.w = cvtpk(y[6], y[7]);
                      *(LAS v4u*)(XS + (8 * tq + i) * LR_PX + 16 * c8) = ov; }
              }
            }
            f32x16 accr, acci;
#pragma unroll
            for (int r = 0; r < 16; ++r) { accr[r] = 0.f; acci[r] = 0.f; }
#pragma unroll
            for (int s = 0; s < 8; ++s) { const bf16x8 xa = *(const LAS bf16x8*)(XS + r32 * LR_PX + 32 * s + 16 * h); accr = MFMA32(xa, *(const LAS bf16x8*)(WF + (s * 64 + lane) * 16), accr); acci = MFMA32(xa, *(const LAS bf16x8*)(WF + ((8 + s) * 64 + lane) * 16), acci); }
            float xv[16];
#pragma unroll
            for (int r = 0; r < 16; ++r) xv[r] = bf2f(*(const LAS bf16*)(XS + ((r & 3) + 8 * (r >> 2) + 4 * h) * LR_PX + (32 * cs + r32) * 2));
            asm volatile("s_waitcnt lgkmcnt(0)" ::: "memory");
#pragma unroll
            for (int r = 0; r < 16; ++r) {
                const float rg = sigmoid_f(accr[r] + brc), ig = sigmoid_f(acci[r] + bic);
                const float la = -rg * sp8, a = __expf(la);
                const float bq = __builtin_amdgcn_sqrtf(fmaxf(1.0f - a * a, 0.f)) * ig * xv[r];
                *(LAS f32x2_t*)(XS + ((r & 3) + 8 * (r >> 2) + 4 * h) * LR_PAB + 8 * r32) = (f32x2_t){a, bq};
            }
            asm volatile("s_waitcnt lgkmcnt(0)" ::: "memory");
            if (!sample) {
                float A = 1.f, B = 0.f;
#pragma unroll
                for (int i = 0; i < 16; ++i) { const f32x2_t ab = *(const LAS f32x2_t*)(XS + (16 * h + i) * LR_PAB + 8 * r32); A *= ab.x; B = ab.x * B + ab.y; }
                Ao = __shfl_xor(A, 32); Bo = __shfl_xor(B, 32);
                Aw = A * Ao; Bw = h ? (A * Bo + B) : (Ao * B + Bo);
                if (h == 0) *(LAS f32x2_t*)(COMP + ((tt & 1) * 256 + wv * 32 + r32) * 8) = (f32x2_t){Aw, Bw};
            }
        }
        __syncthreads();
        if (active) {
            float hin;
            if (!sample) {
                float hrun = hc; hin = hc;
#pragma unroll
                for (int w = 0; w < 8; ++w) { const f32x2_t cp = *(const LAS f32x2_t*)(COMP + ((tt & 1) * 256 + w * 32 + r32) * 8); if (w == wv) hin = hrun; hrun = cp.x * hrun + cp.y; }
                hc = hrun;
                if (h) hin = Ao * hin + Bo;
            } else hin = 0.f;
            const size_t orow = rowb + 16 * h;
            float hh = hin;
#pragma unroll
            for (int i = 0; i < 16; ++i) {
                if (sample && (i & 3) == 0) hh = c.in[5][((size_t)o * 128 + 8 * st + 4 * h + (i >> 2)) * 1024 + chg];
                const f32x2_t ab = *(const LAS f32x2_t*)(XS + (16 * h + i) * LR_PAB + 8 * r32);
                hh = ab.x * hh + ab.y;
                HG[(orow + i) * 1024 + chg] = (bf16)cvtpk(bf2f(gt[i]) * hh, 0.f);
                if (sample && (i & 3) == 3) c.out[OUT_LRUS + ((size_t)o * 128 + 8 * st + 4 * h + (i >> 2)) * 1024 + chg] = hh;
            }
            asm volatile("s_waitcnt lgkmcnt(0)" ::: "memory");
        }
    }
    if (wv == 0 && h == 0) c.out[OUT_LRUP + ((size_t)o * 8 + b) * 1024 + chg] = hc;
}
typedef float f32x4g __attribute__((ext_vector_type(4)));
__device__ __forceinline__ void gate_job(const Ctx& c, int e, const float* ssq, int first_tile, int tile_stride) {
    unsigned char* ws = c.ws; const int lane = c.lane, wv = c.wave, l15 = lane & 15, quad = lane >> 4, r32 = lane & 31, h = lane >> 5;
    const bf16* XB = (const bf16*)(ws + WS_XB); float* LA = (float*)(ws + WS_R + R_LA);
    const bf16* WaT = (const bf16*)(ws + WS_WA) + (size_t)e * 16 * 1024;
    const bf16* A2T = (const bf16*)(ws + WS_WA) + 2 * 16 * 1024 + (size_t)e * 256 * 16;
    const float* b_a2 = c.in[10] + e * 256;
    LAS float* part = (LAS float*)(c.lds + RING_OFF);
    LAS bf16* alr = (LAS bf16*)(c.lds + RING_OFF + 32768);
    LAS float* pss = (LAS float*)(c.lds + RING_OFF + 32768 + 2048);
    for (int tile = first_tile; tile < T / 64; tile += tile_stride) {
        const int rowb = 64 * tile;
        bf16x8 bw[4];
#pragma unroll
        for (int s = 0; s < 4; ++s) bw[s] = *(const bf16x8*)(WaT + (size_t)l15 * 1024 + 128 * wv + 32 * s + 8 * quad);
        f32x4g acc[4];
#pragma unroll
        for (int mt = 0; mt < 4; ++mt) { acc[mt] = (f32x4g){0.f, 0.f, 0.f, 0.f};
            bf16x8 xa[4];
#pragma unroll
            for (int s = 0; s < 4; ++s) xa[s] = *(const bf16x8*)(XB + (size_t)(rowb + 16 * mt + l15) * 1024 + 128 * wv + 32 * s + 8 * quad);
#pragma unroll
            for (int s = 0; s < 4; ++s) acc[mt] = __builtin_amdgcn_mfma_f32_16x16x32_bf16(bw[s], xa[s], acc[mt], 0, 0, 0);
            float sq = 0.f;
#pragma unroll
            for (int s = 0; s < 4; ++s) { const v4u w4 = __builtin_bit_cast(v4u, xa[s]);
#pragma unroll
                for (int q = 0; q < 4; ++q) { const float a = bflo(w4[q]), b = bfhi(w4[q]); sq += a * a + b * b; } }
            sq += __shfl_xor(sq, 16); sq += __shfl_xor(sq, 32);
            if (quad == 0) pss[wv * 64 + 16 * mt + l15] = sq; }
#pragma unroll
        for (int mt = 0; mt < 4; ++mt)
#pragma unroll
            for (int q = 0; q < 4; ++q) part[wv * 1024 + (16 * mt + l15) * 16 + 4 * quad + q] = acc[mt][q];
        __syncthreads();
#pragma unroll
        for (int i = 0; i < 2; ++i) { const int idx = c.tid + 512 * i, row = idx >> 4; float s = 0.f;
#pragma unroll
            for (int w = 0; w < 8; ++w) s += part[w * 1024 + idx];
            float sq = 0.f;
#pragma unroll
            for (int w = 0; w < 8; ++w) sq += pss[w * 64 + row];
            const float rs = rsqrtf(sq * (1.0f / 1024.0f) + EPS);
            alr[idx] = (bf16)f2bf(s * rs); }
        __syncthreads();
        { const int rh = wv & 1;
          v4u aw = *(const LAS v4u*)(alr + (32 * rh + r32) * 16 + 8 * h); const bf16x8 af = __builtin_bit_cast(bf16x8, aw);
#pragma unroll
          for (int ct = 0; ct < 2; ++ct) { const int n = 32 * (2 * (wv >> 1) + ct) + r32;
              const bf16x8 bf = *(const bf16x8*)(A2T + (size_t)n * 16 + 8 * h);
              f32x16 z;
#pragma unroll
              for (int r = 0; r < 16; ++r) z[r] = 0.f;
              const f32x16 d = MFMA32(af, bf, z);
              const float bn = b_a2[n];
#pragma unroll
              for (int r = 0; r < 16; ++r) { const int row = rowb + 32 * rh + (r & 3) + 8 * (r >> 2) + 4 * h;
                  LA[(size_t)row * 256 + n] = pg8::logsigmoid_f(d[r] + bn) * 0.0625f; } } }
        __syncthreads();
    }
}
#ifndef REP_PROL
#define REP_PROL 1
#endif
#ifndef REP_IN
#define REP_IN 1
#endif
#ifndef REP_EMIX
#define REP_EMIX 1
#endif
#ifndef REP_GLU
#define REP_GLU 1
#endif
#ifndef REP_CONV
#define REP_CONV 1
#endif
#ifndef REP_GATES
#define REP_GATES 1
#endif
#ifndef REP_UP
#define REP_UP 1
#endif
#ifndef REP_LRU
#define REP_LRU 1
#endif
constexpr int N_PHASES = 24;
__global__ void __launch_bounds__(NWAVES * 64, 2) mk_fwd(Args args) {
    extern __shared__ __attribute__((aligned(16))) unsigned char lds_raw[];
    const int wave_s_ = __builtin_amdgcn_readfirstlane((int)threadIdx.x >> 6);
#define TID_NOW(var) int var; { int l_; asm volatile("v_mbcnt_lo_u32_b32 %0, -1, 0\n\tv_mbcnt_hi_u32_b32 %0, -1, %0" : "=v"(l_)); var = (wave_s_ << 6) | l_; }
    const int lo = args.ph_lo, hi = args.ph_hi;
    {
        LAS unsigned char* l0 = (LAS unsigned char*)lds_raw;
        TID_NOW(t0_)
        for (int u = t0_; u < (LDS_BYTES - LDSCTL_OFF) / 4; u += NWAVES * 64) ((LAS unsigned*)(l0 + LDSCTL_OFF))[u] = 0u;
        __syncthreads();
    }
    XcdBarrier bar; bar.bar = (unsigned*)(args.ws + WS_CTL) + CW_BAR + args.li * XCD_BAR_WORDS; bar.x = 0; bar.st = nullptr;
    TID_NOW(t0b_)
    if (hi - lo > 1) bar = xcd_barrier_post((unsigned*)(args.ws + WS_CTL) + CW_BAR + args.li * XCD_BAR_WORDS, (volatile LAS unsigned*)((LAS unsigned char*)lds_raw + MISC_OFF) + 8, t0b_);
    int pc = 0;
#define PHASE_BEGINR(R) { int pc_ = pc; asm volatile("" : "+s"(pc_)); if (pc_ >= lo && pc_ < hi) { for (int rep_ = 0; rep_ < (R); ++rep_) { if (rep_) __syncthreads(); unsigned char* wsr_ = args.ws; asm volatile("" : "+s"(wsr_)); unsigned char* ws = as_global(wsr_); float* outr_ = args.out; asm volatile("" : "+s"(outr_)); float* out_ = as_global(outr_); \
    TID_NOW(t_) int bx = blockIdx.x; asm volatile("" : "+s"(bx)); int G_ = gridDim.x; asm volatile("" : "+s"(G_)); \
    Ctx c; c.var = args.pad; c.in.p = args.in; c.out = out_; c.ws = ws; c.lds = (LAS unsigned char*)lds_raw; c.tid = t_; c.lane = c.tid & 63; c.wave = __builtin_amdgcn_readfirstlane(c.tid >> 6); \
    c.G = G_; c.vcu = (c.G % 8 == 0) ? (bx % 8) * (c.G / 8) + bx / 8 : bx; c.gw = c.vcu * NWAVES + c.wave; c.NGW = c.G * NWAVES; \
    PG8_LAS unsigned char* ring = (PG8_LAS unsigned char*)(c.lds + RING_OFF); (void)ring; \
    bf16* XB = (bf16*)(ws + WS_XB); float* X = c.out; float* ssq = (float*)(ws + WS_SSQ); bf16* MIX = (bf16*)(ws + WS_R + R_MIX); (void)XB; (void)X; (void)ssq; (void)MIX;
#define PHASE_BEGIN PHASE_BEGINR(1)
#define PHASE_END   } if (pc_ + 1 < hi) { TID_NOW(tb_) xcd_barrier(bar, tb_); } } } ++pc;

    PHASE_BEGINR(REP_PROL) p0_prologue(c); PHASE_END

    for (int l = 0; l < 4; ++l) {
        const int hf = l >> 1;
        if ((l & 1) == 0) {
            PHASE_BEGINR(REP_IN)
                const bf16* wt = (const bf16*)(ws + WS_W + W_INE) + (size_t)hf * NIN_E * 1024; pg8::Gemm g{XB, wt, TP, 2048, 1024, 1024}; pg8::StaticOrder S; S.init(TP, 2048, c.G, bx);
                pg8::EpiInE E{(bf16*)(ws + WS_R + R_P), ssq + (size_t)(2 * l) * 4 * T};
                if (bx & 1) { if (l == 0) p0_weights_rest(c); gate_job(c, hf, ssq + (size_t)(2 * l) * 4 * T, bx, c.G); sgemm2<64, true>(c, XB + (size_t)TP * 1024, wt, 2048, 1024, E, bx, c.G); pg8::gemm_phase<pg8::EpiInE, pg8::StaticOrder, true, true>(ring, g, S, E, c.tid); }
                else { pg8::gemm_phase<pg8::EpiInE, pg8::StaticOrder, true, true>(ring, g, S, E, c.tid); sgemm2<64, true>(c, XB + (size_t)TP * 1024, wt, 2048, 1024, E, bx, c.G); gate_job(c, hf, ssq + (size_t)(2 * l) * 4 * T, bx, c.G); if (l == 0) p0_weights_rest(c); }
            PHASE_END
            PHASE_BEGINR(REP_EMIX) even_mixer_v2(c, hf); PHASE_END
            PHASE_BEGINR(REP_GLU)
                gla_post(c, hf);
                bf16* Z1 = (bf16*)(ws + WS_R + R_Z1); const bf16* wt = (const bf16*)(ws + WS_W + W_GLU) + (size_t)hf * 512 * 512; pg8::Gemm g{Z1, wt, TP, 512, 512, 512}; pg8::StaticOrder S; S.init(TP, 512, c.G, bx);
                pg8::EpiGlu E{Z1, MIX, c.in[21] + hf * 512};
                if (bx & 1) { sgemm2<32, false>(c, Z1 + (size_t)TP * 512, wt, 512, 512, E, bx >= 128 ? bx - 128 : (1 << 30), c.G - 128); pg8::gemm_phase<pg8::EpiGlu, pg8::StaticOrder, true, true>(ring, g, S, E, c.tid); }
                else { pg8::gemm_phase<pg8::EpiGlu, pg8::StaticOrder, true, true>(ring, g, S, E, c.tid); sgemm2<32, false>(c, Z1 + (size_t)TP * 512, wt, 512, 512, E, bx >= 128 ? bx - 128 : (1 << 30), c.G - 128); }
            PHASE_END
        } else {
            PHASE_BEGINR(REP_IN)
                const bf16* wt = (const bf16*)(ws + WS_W + W_INO) + (size_t)hf * NIN_O * 1024; pg8::Gemm g{XB, wt, TP, NIN_O, 1024, 1024}; pg8::StaticOrder S; S.init(TP, NIN_O, c.G, bx);
                pg8::EpiInO E{(bf16*)(ws + WS_R + R_XC), (bf16*)(ws + WS_R + R_CIN), ssq + (size_t)(2 * l) * 4 * T, c.out + OUT_CONVP + (size_t)hf * 8 * 3 * 1024, c.out + OUT_CONVS + (size_t)hf * 128 * 3 * 1024};
                if (bx & 1) { sgemm2<64, true>(c, XB + (size_t)TP * 1024, wt, NIN_O, 1024, E, bx, c.G); pg8::gemm_phase<pg8::EpiInO, pg8::StaticOrder, true, true>(ring, g, S, E, c.tid); }
                else { pg8::gemm_phase<pg8::EpiInO, pg8::StaticOrder, true, true>(ring, g, S, E, c.tid); sgemm2<64, true>(c, XB + (size_t)TP * 1024, wt, NIN_O, 1024, E, bx, c.G); }
            PHASE_END
            PHASE_BEGINR(REP_LRU) lru_fused(c, hf); PHASE_END
        }
        PHASE_BEGIN
            const bf16* wo = (l & 1) ? (const bf16*)(ws + WS_W + W_OUTO) + (size_t)hf * 1024 * 1024 : (const bf16*)(ws + WS_W + W_OUTE) + (size_t)hf * 1024 * 1024;
            pg8::Gemm g{MIX, wo, TP, 1024, 1024, 1024}; pg8::StaticOrder S; S.init(TP, 1024, c.G, bx);
            pg8::EpiRes E{XB, ssq + (size_t)(2 * l + 1) * 4 * T};
            if (bx & 1) { sgemm2<32, false>(c, MIX + (size_t)TP * 1024, wo, 1024, 1024, E, bx, c.G); pg8::gemm_phase<pg8::EpiRes, pg8::StaticOrder, false, true>(ring, g, S, E, c.tid); }
            else { pg8::gemm_phase<pg8::EpiRes, pg8::StaticOrder, false, true>(ring, g, S, E, c.tid); sgemm2<32, false>(c, MIX + (size_t)TP * 1024, wo, 1024, 1024, E, bx, c.G); }
        PHASE_END
        PHASE_BEGINR(REP_UP)
            const bf16* wt = (const bf16*)(ws + WS_W + W_UP) + (size_t)l * 4096 * 1024; pg8::Gemm g{XB, wt, TP, FF, 1024, 1024}; pg8::StaticOrder S; S.init(TP, FF, c.G, bx);
            pg8::EpiUp E{(bf16*)(ws + WS_R + R_H), ssq + (size_t)(2 * l + 1) * 4 * T};
            if (bx & 1) { sgemm2<64, true>(c, XB + (size_t)TP * 1024, wt, FF, 1024, E, bx, c.G); pg8::gemm_phase<pg8::EpiUp, pg8::StaticOrder, true, true>(ring, g, S, E, c.tid); }
            else { pg8::gemm_phase<pg8::EpiUp, pg8::StaticOrder, true, true>(ring, g, S, E, c.tid); sgemm2<64, true>(c, XB + (size_t)TP * 1024, wt, FF, 1024, E, bx, c.G); }
        PHASE_END
        PHASE_BEGIN
            const bf16* wt = (const bf16*)(ws + WS_W + W_DN) + (size_t)l * 1024 * LD_FF; pg8::Gemm g{(bf16*)(ws + WS_R + R_H), wt, TP, 1024, FF, LD_FF}; pg8::StaticOrder S; S.init(TP, 1024, c.G, bx);
            pg8::EpiRes E{XB, ssq + (size_t)(2 * l + 2) * 4 * T};
            if (bx & 1) { sgemm2<32, false>(c, (const bf16*)(ws + WS_R + R_H) + (size_t)TP * LD_FF, wt, 1024, FF, E, bx, c.G, LD_FF); pg8::gemm_phase<pg8::EpiRes, pg8::StaticOrder, false, true>(ring, g, S, E, c.tid); }
            else { pg8::gemm_phase<pg8::EpiRes, pg8::StaticOrder, false, true>(ring, g, S, E, c.tid); sgemm2<32, false>(c, (const bf16*)(ws + WS_R + R_H) + (size_t)TP * LD_FF, wt, 1024, FF, E, bx, c.G, LD_FF); }
        PHASE_END
    }
    PHASE_BEGINR(1) final_norm(c); PHASE_END
#undef PHASE_BEGIN
#undef PHASE_BEGINR
#undef PHASE_END
}

#ifndef MK_N_LAUNCHES
#define MK_N_LAUNCHES 1
#endif
extern "C" void kernel_launch(void* const* d_in, const int* in_sizes, int n_in, void* d_out, int out_size, void* d_ws, size_t ws_size, hipStream_t stream) {
    static int grid = 0;
    if (grid == 0) {
        if (n_in != 37 || out_size != (int)OUT_END || ws_size < WS_END) { fprintf(stderr, "kernel_launch: shape mismatch (n_in %d out %d ws %zu)\n", n_in, out_size, ws_size); grid = -1; return; }
        int dev = 0, cus = 0;
        if (hipGetDevice(&dev) != hipSuccess || hipDeviceGetAttribute(&cus, hipDeviceAttributeMultiprocessorCount, dev) != hipSuccess) { grid = -1; return; }
        if (hipFuncSetAttribute((const void*)mk_fwd, hipFuncAttributeMaxDynamicSharedMemorySize, LDS_BYTES) != hipSuccess) { fprintf(stderr, "kernel_launch: hipFuncSetAttribute failed\n"); grid = -1; return; }
        int per_cu = 0;
        if (hipOccupancyMaxActiveBlocksPerMultiprocessor(&per_cu, (const void*)mk_fwd, NWAVES * 64, LDS_BYTES) != hipSuccess || per_cu < 1) fprintf(stderr, "kernel_launch: occupancy query says %d\n", per_cu);
        (void)hipGetLastError();
        grid = cus;
        if (grid != 256) fprintf(stderr, "kernel_launch: %d CUs; this kernel's static work split assumes 256\n", grid);
    }
    if (grid < 0) return;
    if (hipMemsetAsync((char*)d_ws + WS_CTL, 0, CTL_ZERO_BYTES, stream) != hipSuccess) return;
    Args a{};
    for (int i = 0; i < 37; ++i) a.in[i] = (const float*)d_in[i];
    a.out = (float*)d_out; a.ws = (unsigned char*)d_ws;
    if (MK_N_LAUNCHES == 1) { a.ph_lo = 0; a.ph_hi = N_PHASES; hipLaunchKernelGGL(mk_fwd, dim3(grid), dim3(NWAVES * 64), LDS_BYTES, stream, a); }
    else { for (int p = 0; p < N_PHASES; ++p) { a.ph_lo = p; a.ph_hi = p + 1; hipLaunchKernelGGL(mk_fwd, dim3(grid), dim3(NWAVES * 64), LDS_BYTES, stream, a); } }
}
```

```cpp
#include <hip/hip_runtime.h>
#include <cstdio>
#include <cstdint>
namespace pg8 {
#define PG8_LAS __attribute__((address_space(3)))
typedef unsigned short bf16_t;
typedef short bf16x8 __attribute__((ext_vector_type(8)));
typedef float f32x4 __attribute__((ext_vector_type(4)));
typedef unsigned u32x4 __attribute__((ext_vector_type(4)));
constexpr int BM = 256, BK = 64, HALF = 128, HTB = HALF * BK * 2  , STAGE_BYTES = 8 * HTB, NXCD = 8, WGM = 8;

__host__ __device__ __forceinline__ int lds_byte(int r, int c) { const int st = (r >> 4) * 2 + (c >> 5), rr = r & 15, cc = c & 31, ob = rr * 64 + cc * 2; return st * 1024 + (ob ^ (((ob >> 9) & 1) << 5)); }
__host__ __device__ __forceinline__ void stage_rc(int b, int& R, int& C) { const int st = b / 1024, sb = b % 1024, swz = sb ^ (((sb >> 9) & 1) << 5); R = (st >> 1) * 16 + swz / 64; C = (st & 1) * 32 + (swz % 64) / 2; }
__host__ __device__ __forceinline__ int perm32(int rho) { const int n = rho >> 4, i = rho & 15; return 8 * (i >> 2) + 4 * n + (i & 3); }

struct Unit { int pm, pn; };
struct Gemm { const bf16_t* A; const bf16_t* Bt; int M, N, K, ld; };

struct StaticOrder {
    int nM, nN, nwg, G, c;
    __host__ __device__ void init(int M, int N, int G_, int c_) { nM = M / BM; nN = N / BM; nwg = nM * nN; G = G_; c = c_; }
    __host__ __device__ bool next(int i, Unit& u) const {
        const long L = (long)i * G + c; if (L >= nwg) return false;
        int wgid = (int)L; { const int q = nwg / NXCD, r = nwg % NXCD, xcd = wgid % NXCD, off = wgid / NXCD; wgid = (xcd < r ? xcd * (q + 1) : r * (q + 1) + (xcd - r) * q) + off; }
        const int nig = WGM * nN, gid = wgid / nig, fm = gid * WGM, gsz = (nM - fm) < WGM ? (nM - fm) : WGM;
        u.pm = fm + ((wgid % nig) % gsz); u.pn = (wgid % nig) / gsz; return true;
    }
    __device__ __forceinline__ void a_ready(const Unit&) const {}
    __device__ __forceinline__ void done(const Unit&) const {}
};

__device__ __forceinline__ unsigned cvt_pk_bf16(float lo, float hi) { unsigned r; asm volatile("v_cvt_pk_bf16_f32 %0, %1, %2" : "=v"(r) : "v"(lo), "v"(hi)); return r; }
template <class Epi, class Sched, bool ALIGN_EPI = false, bool SP2 = false>
__device__ __forceinline__ void gemm_phase(PG8_LAS unsigned char* lds, const Gemm g, const Sched& S, const Epi& E, int tid_in) {
    int tid_ = tid_in; asm volatile("" : "+v"(tid_));
    const int tid = tid_, wid = __builtin_amdgcn_readfirstlane(tid >> 6), lane = tid & 63, wr = wid >> 2, wc = wid & 3, fr = lane & 15, fq = lane >> 4;
    const int K = g.K, nt = K / BK, LD = g.ld;
    unsigned voffA[2], voffB[2];
#pragma unroll
    for (int i = 0; i < 2; ++i) { int R, C; stage_rc(tid * 16 + i * 8192, R, C); const int Rb = Epi::PERM ? ((R & ~31) + perm32(R & 31)) : R;
        voffA[i] = (unsigned)(R * LD + C) * 2u; voffB[i] = (unsigned)(Rb * LD + C) * 2u; }
    const size_t kstep = (size_t)(BK * 2);
    const size_t hstep = (size_t)HALF * LD * 2;
    const size_t tstep = 2 * hstep;
    const unsigned ldsw = (unsigned)wid * 1024u;
    const int aoff = lds_byte(wr * 64 + fr, fq * 8), boff = lds_byte(wc * 32 + fr, fq * 8);
#define PG8_SA(b, h) (((b) * 2 + (h)) * HTB)
#define PG8_SB(b, h) ((4 + (b) * 2 + (h)) * HTB)
#define PG8_STAGE(bufoff, gbase, voff) do { _Pragma("unroll") for (int _i = 0; _i < 2; ++_i) \
        __builtin_amdgcn_global_load_lds((const unsigned*)((const char*)(gbase) + (voff)[_i]), (PG8_LAS unsigned*)(lds + (bufoff) + ldsw + _i * 8192), 16, 0, 0); } while (0)
#define PG8_LDA(dst, b, h) do { _Pragma("unroll") for (int m = 0; m < 4; ++m) _Pragma("unroll") for (int k = 0; k < 2; ++k) dst[m][k] = *(const PG8_LAS bf16x8*)(lds + PG8_SA(b, h) + aoff + m * 2048 + k * 1024); } while (0)
#define PG8_LDB(dst, b, h) do { _Pragma("unroll") for (int n = 0; n < 2; ++n) _Pragma("unroll") for (int k = 0; k < 2; ++k) dst[n][k] = *(const PG8_LAS bf16x8*)(lds + PG8_SB(b, h) + boff + n * 2048 + k * 1024); } while (0)
#define PG8_MMA(ai, bj, At, Bt) do { __builtin_amdgcn_s_setprio(1); _Pragma("unroll") for (int m = 0; m < 4; ++m) _Pragma("unroll") for (int n = 0; n < 2; ++n) _Pragma("unroll") for (int k = 0; k < 2; ++k) \
        acc[ai][bj][m][n] = __builtin_amdgcn_mfma_f32_16x16x32_bf16(Bt[n][k], At[m][k], acc[ai][bj][m][n], 0, 0, 0); __builtin_amdgcn_s_setprio(0); } while (0)
#define PG8_WAIT_V(n) asm volatile("s_waitcnt vmcnt(" #n ")" ::: "memory")
#define PG8_WAIT_L(n) asm volatile("s_waitcnt lgkmcnt(" #n ")" ::: "memory")
#define PG8_BAR __builtin_amdgcn_s_barrier()
#define PG8_SCHED __builtin_amdgcn_sched_barrier(0)
    Unit cur, nxt; int ui = 0;
    if (!S.next(0, cur)) return;
    f32x4 acc[2][2][4][2];
#pragma unroll
    for (int a = 0; a < 2; ++a)
#pragma unroll
        for (int b = 0; b < 2; ++b)
#pragma unroll
            for (int m = 0; m < 4; ++m)
#pragma unroll
                for (int n = 0; n < 2; ++n) acc[a][b][m][n] = (f32x4){0.f, 0.f, 0.f, 0.f};
    bf16x8 At[4][2], B0[2][2], B1[2][2];
    const char* cA = (const char*)g.A + (size_t)cur.pm * tstep; const char* cB = (const char*)g.Bt + (size_t)cur.pn * tstep;
    S.a_ready(cur);
    if constexpr (SP2) {
        PG8_STAGE(PG8_SB(0, 0), cB, voffB); PG8_STAGE(PG8_SB(0, 1), cB + hstep, voffB); PG8_STAGE(PG8_SA(0, 0), cA, voffA); PG8_STAGE(PG8_SA(0, 1), cA + hstep, voffA);
        if (wr == 1) PG8_BAR;
        PG8_WAIT_V(2); PG8_BAR;
        PG8_STAGE(PG8_SB(1, 0), cB + kstep, voffB); PG8_STAGE(PG8_SA(1, 0), cA + kstep, voffA); PG8_STAGE(PG8_SB(1, 1), cB + hstep + kstep, voffB);
        PG8_WAIT_V(6); PG8_BAR;
    } else {
        PG8_STAGE(PG8_SB(0, 0), cB, voffB); PG8_STAGE(PG8_SA(0, 0), cA, voffA); PG8_STAGE(PG8_SB(0, 1), cB + hstep, voffB); PG8_STAGE(PG8_SA(0, 1), cA + hstep, voffA);
        if (wr == 1) PG8_BAR;
        PG8_WAIT_V(4); PG8_BAR;
        PG8_STAGE(PG8_SB(1, 0), cB + kstep, voffB); PG8_STAGE(PG8_SA(1, 0), cA + kstep, voffA); PG8_STAGE(PG8_SB(1, 1), cB + hstep + kstep, voffB);
        PG8_WAIT_V(6); PG8_BAR;
    }
    for (;;) {
        const bool has_next = S.next(ui + 1, nxt);
        const char* nA = has_next ? (const char*)g.A + (size_t)nxt.pm * tstep : cA; const char* nB = has_next ? (const char*)g.Bt + (size_t)nxt.pn * tstep : cB;
        for (int t = 0; t < nt; t += 2) {
            const bool last = (t == nt - 2);
            const char* a1 = cA + (size_t)(t + 1) * kstep;
            const char* a2 = last ? nA : cA + (size_t)(t + 2) * kstep; const char* b2 = last ? nB : cB + (size_t)(t + 2) * kstep;
            const char* a3 = a2 + kstep; const char* b3 = b2 + kstep;
            if (last && has_next) S.a_ready(nxt);
            if constexpr (SP2) {
            PG8_LDB(B0, 0, 0); PG8_LDB(B1, 0, 1); PG8_SCHED; PG8_LDA(At, 0, 0); PG8_STAGE(PG8_SA(1, 1), a1 + hstep, voffA);
            PG8_WAIT_V(8); PG8_WAIT_L(0); PG8_BAR; PG8_MMA(0, 0, At, B0); PG8_MMA(0, 1, At, B1); PG8_BAR; PG8_SCHED;
            PG8_LDA(At, 0, 1); PG8_STAGE(PG8_SB(0, 0), b2, voffB); PG8_STAGE(PG8_SB(0, 1), b2 + hstep, voffB); PG8_STAGE(PG8_SA(0, 0), a2, voffA);
            PG8_WAIT_V(8); PG8_WAIT_L(0); PG8_BAR; PG8_MMA(1, 0, At, B0); PG8_MMA(1, 1, At, B1); PG8_BAR; PG8_SCHED;
            PG8_LDB(B0, 1, 0); PG8_LDB(B1, 1, 1); PG8_SCHED; PG8_LDA(At, 1, 0); PG8_STAGE(PG8_SA(0, 1), a2 + hstep, voffA);
            PG8_WAIT_V(8); PG8_WAIT_L(0); PG8_BAR; PG8_MMA(0, 0, At, B0); PG8_MMA(0, 1, At, B1); PG8_BAR; PG8_SCHED;
            PG8_LDA(At, 1, 1); PG8_STAGE(PG8_SB(1, 0), b3, voffB); PG8_STAGE(PG8_SB(1, 1), b3 + hstep, voffB); PG8_STAGE(PG8_SA(1, 0), a3, voffA);
            PG8_WAIT_V(8); PG8_WAIT_L(0); PG8_BAR; PG8_MMA(1, 0, At, B0); PG8_MMA(1, 1, At, B1); PG8_BAR; PG8_SCHED;
            } else {
            PG8_LDB(B0, 0, 0); PG8_SCHED; PG8_LDA(At, 0, 0); PG8_STAGE(PG8_SA(1, 1), a1 + hstep, voffA);
            PG8_WAIT_L(8); PG8_BAR; PG8_WAIT_L(0); PG8_MMA(0, 0, At, B0); PG8_BAR; PG8_SCHED;
            PG8_LDB(B1, 0, 1); PG8_STAGE(PG8_SB(0, 0), b2, voffB);
            PG8_BAR; PG8_WAIT_L(0); PG8_MMA(0, 1, At, B1); PG8_BAR;
            PG8_LDA(At, 0, 1); PG8_STAGE(PG8_SA(0, 0), a2, voffA);
            PG8_BAR; PG8_WAIT_L(0); PG8_MMA(1, 0, At, B0); PG8_BAR; PG8_SCHED;
            PG8_STAGE(PG8_SB(0, 1), b2 + hstep, voffB);
            PG8_WAIT_V(6); PG8_BAR; PG8_MMA(1, 1, At, B1); PG8_BAR;
            PG8_LDB(B0, 1, 0); PG8_SCHED; PG8_LDA(At, 1, 0); PG8_STAGE(PG8_SA(0, 1), a2 + hstep, voffA);
            PG8_WAIT_L(8); PG8_BAR; PG8_WAIT_L(0); PG8_MMA(0, 0, At, B0); PG8_BAR; PG8_SCHED;
            PG8_LDB(B1, 1, 1); PG8_STAGE(PG8_SB(1, 0), b3, voffB);
            PG8_BAR; PG8_WAIT_L(0); PG8_MMA(0, 1, At, B1); PG8_BAR;
            PG8_LDA(At, 1, 1); PG8_STAGE(PG8_SA(1, 0), a3, voffA);
            PG8_BAR; PG8_WAIT_L(0); PG8_MMA(1, 0, At, B0); PG8_BAR; PG8_SCHED;
            PG8_STAGE(PG8_SB(1, 1), b3 + hstep, voffB);
            PG8_WAIT_V(6); PG8_BAR; PG8_MMA(1, 1, At, B1); PG8_BAR;
            }
        }
        if constexpr (ALIGN_EPI) { if (wr == 0) PG8_BAR; }
        if constexpr (!Epi::AFTER_DRAIN) { E(acc, cur, wr, wc, fr, fq); S.done(cur); }
        if (!has_next) break;
#pragma unroll
        for (int a = 0; a < 2; ++a)
#pragma unroll
            for (int b = 0; b < 2; ++b)
#pragma unroll
                for (int m = 0; m < 4; ++m)
#pragma unroll
                    for (int n = 0; n < 2; ++n) acc[a][b][m][n] = (f32x4){0.f, 0.f, 0.f, 0.f};
        cur = nxt; cA = nA; cB = nB; ++ui;
        if constexpr (ALIGN_EPI) { if (wr == 1) PG8_BAR; }
    }
    PG8_WAIT_V(0);
    if constexpr (!ALIGN_EPI) { if (wr == 0) PG8_BAR; }
    PG8_BAR;
    if constexpr (Epi::AFTER_DRAIN) { E.fused(acc, cur, wr, wc, fr, fq, lds, wid, lane); S.done(cur); }
#undef PG8_SA
#undef PG8_SB
#undef PG8_STAGE
#undef PG8_LDA
#undef PG8_LDB
#undef PG8_MMA
#undef PG8_WAIT_V
#undef PG8_WAIT_L
#undef PG8_BAR
#undef PG8_SCHED
}
}
#ifndef PG8_SP2
#define PG8_SP2 true
#endif
namespace pg8 {
constexpr int TP_ROWS = 16384, T_ROWS = 16896;
constexpr float EPS_F = 1e-6f;
__device__ __forceinline__ float sigmoid_f(float x) { return __builtin_amdgcn_rcpf(1.0f + __expf(-x)); }
__device__ __forceinline__ float gelu_tanh_f(float x) { const float u = 0.7978845608028654f * (x + 0.044715f * x * x * x); return x * __builtin_amdgcn_rcpf(1.0f + __expf(-2.0f * u)); }
__device__ __forceinline__ float logsigmoid_f(float x) { return fminf(x, 0.f) - __logf(1.0f + __expf(-fabsf(x))); }
__device__ __forceinline__ u32x4 pack8(const f32x4& a, const f32x4& b) { u32x4 w; w.x = cvt_pk_bf16(a[0], a[1]); w.y = cvt_pk_bf16(a[2], a[3]); w.z = cvt_pk_bf16(b[0], b[1]); w.w = cvt_pk_bf16(b[2], b[3]); return w; }
__device__ __forceinline__ void unpack8(const u32x4& w, f32x4& a, f32x4& b) {
    a = (f32x4){__uint_as_float(w.x << 16), __uint_as_float(w.x & 0xffff0000u), __uint_as_float(w.y << 16), __uint_as_float(w.y & 0xffff0000u)};
    b = (f32x4){__uint_as_float(w.z << 16), __uint_as_float(w.z & 0xffff0000u), __uint_as_float(w.w << 16), __uint_as_float(w.w & 0xffff0000u)}; }
__device__ __forceinline__ float ssq4(const float* ssq, int row) { return rsqrtf(((ssq[row] + ssq[T_ROWS + row]) + (ssq[2 * T_ROWS + row] + ssq[3 * T_ROWS + row])) * (1.0f / 1024.0f) + EPS_F); }

template <class E> __device__ __forceinline__ void drive_epi(const E& e, const f32x4 (&acc)[2][2][4][2], const Unit& u, int wr, int wc, int fr, int fq, float (&sums)[8]) {
    const int row0 = u.pm * BM + wr * 64 + fr, col0 = u.pn * BM + wc * 32 + 8 * fq;
    float rs[8]; f32x4 cb0[2], cb1[2];
#pragma unroll
    for (int g = 0; g < 8; ++g) rs[g] = e.row_scale(row0 + (g >> 2) * HALF + (g & 3) * 16);
#pragma unroll
    for (int bj = 0; bj < 2; ++bj) e.col8(col0 + bj * HALF, cb0[bj], cb1[bj]);
#pragma unroll
    for (int hf = 0; hf < 2; ++hf) {
        u32x4 pre[4][2];
        if (E::HAS_PRE) {
#pragma unroll
            for (int m = 0; m < 4; ++m)
#pragma unroll
                for (int bj = 0; bj < 2; ++bj) pre[m][bj] = e.pre8(row0 + hf * HALF + m * 16, col0 + bj * HALF);
        }
#pragma unroll
        for (int m = 0; m < 4; ++m) { const int g = 4 * hf + m, row = row0 + hf * HALF + m * 16; float s = 0.f;
#pragma unroll
            for (int bj = 0; bj < 2; ++bj) e.row8(row, col0 + bj * HALF, acc[hf][bj][m][0], acc[hf][bj][m][1], rs[g], cb0[bj], cb1[bj], E::HAS_PRE ? pre[m][bj] : (u32x4){0u, 0u, 0u, 0u}, s);
            sums[g] = s; }
        if (E::HAS_PRE) asm volatile("" ::: "memory");
    }
}
struct EpiInE {
    static constexpr bool PERM = true, AFTER_DRAIN = false, HAS_PRE = false;
    bf16_t* P; const float* ssq;
    __device__ __forceinline__ float row_scale(int row) const { return ssq4(ssq, row); }
    __device__ __forceinline__ void col8(int, f32x4& b0, f32x4& b1) const { b0 = (f32x4){0.f, 0.f, 0.f, 0.f}; b1 = b0; }
    __device__ __forceinline__ u32x4 pre8(int, int) const { return (u32x4){0u, 0u, 0u, 0u}; }
    __device__ __forceinline__ void row8(int row, int col, f32x4 v0, f32x4 v1, float rs, const f32x4&, const f32x4&, const u32x4&, float&) const {
        v0 = v0 * rs; v1 = v1 * rs;
        if (col >= 1024 && col < 1536) {
#pragma unroll
            for (int e = 0; e < 4; ++e) { v0[e] = v0[e] * sigmoid_f(v0[e]); v1[e] = v1[e] * sigmoid_f(v1[e]); } }
        *(u32x4*)(P + (size_t)row * 2048 + col) = pack8(v0, v1);
    }
    __device__ __forceinline__ void operator()(const f32x4 (&acc)[2][2][4][2], const Unit& u, int wr, int wc, int fr, int fq) const { float sm[8]; drive_epi(*this, acc, u, wr, wc, fr, fq, sm); }
};
struct EpiInO {
    static constexpr bool PERM = true, AFTER_DRAIN = false, HAS_PRE = false;
    bf16_t* GATE; bf16_t* CIN; const float* ssq; float* conv_p; float* conv_s;
    __device__ __forceinline__ float row_scale(int row) const { return ssq4(ssq, row); }
    __device__ __forceinline__ void col8(int, f32x4& b0, f32x4& b1) const { b0 = (f32x4){0.f, 0.f, 0.f, 0.f}; b1 = b0; }
    __device__ __forceinline__ u32x4 pre8(int, int) const { return (u32x4){0u, 0u, 0u, 0u}; }
    __device__ __forceinline__ void row8(int row, int col, f32x4 v0, f32x4 v1, float rs, const f32x4&, const f32x4&, const u32x4&, float&) const {
        v0 = v0 * rs; v1 = v1 * rs;
        if (col < 1024) {
#pragma unroll
            for (int e = 0; e < 4; ++e) { v0[e] = gelu_tanh_f(v0[e]); v1[e] = gelu_tanh_f(v1[e]); }
            *(u32x4*)(GATE + (size_t)row * 1024 + col) = pack8(v0, v1);
        } else {
            const int cc = col - 1024;
            *(u32x4*)(CIN + (size_t)row * 1024 + cc) = pack8(v0, v1);
            float* cdst = nullptr;
            if (row < TP_ROWS) { const int t = row & 2047; if (t >= 2045) cdst = conv_p + ((size_t)(row >> 11) * 3 + (t - 2045)) * 1024; }
            else { const int r2 = row - TP_ROWS, t = r2 & 3; if (t >= 1) cdst = conv_s + ((size_t)(r2 >> 2) * 3 + (t - 1)) * 1024; }
            if (cdst) { *(f32x4*)(cdst + cc) = v0; *(f32x4*)(cdst + cc + 4) = v1; }
        }
    }
    __device__ __forceinline__ void operator()(const f32x4 (&acc)[2][2][4][2], const Unit& u, int wr, int wc, int fr, int fq) const { float sm[8]; drive_epi(*this, acc, u, wr, wc, fr, fq, sm); }
};
struct EpiRes {
    static constexpr bool PERM = true, AFTER_DRAIN = true, HAS_PRE = true;
    bf16_t* XB; float* ssq_out;
    __device__ __forceinline__ float row_scale(int) const { return 1.f; }
    __device__ __forceinline__ void col8(int, f32x4& b0, f32x4& b1) const { b0 = (f32x4){0.f, 0.f, 0.f, 0.f}; b1 = b0; }
    __device__ __forceinline__ u32x4 pre8(int row, int col) const { return *(const u32x4*)(XB + (size_t)row * 1024 + col); }
    __device__ __forceinline__ void row8(int row, int col, f32x4 v0, f32x4 v1, float, const f32x4&, const f32x4&, const u32x4& pre, float& s) const {
        f32x4 o0, o1; unpack8(pre, o0, o1); o0 = o0 + v0; o1 = o1 + v1;
        *(u32x4*)(XB + (size_t)row * 1024 + col) = pack8(o0, o1);
        s += (o0[0] * o0[0] + o0[1] * o0[1]) + (o0[2] * o0[2] + o0[3] * o0[3]) + (o1[0] * o1[0] + o1[1] * o1[1]) + (o1[2] * o1[2] + o1[3] * o1[3]);
    }
    __device__ __forceinline__ void fused(f32x4 (&acc)[2][2][4][2], const Unit& u, int wr, int wc, int fr, int fq, PG8_LAS unsigned char* lds, int wid, int lane) const {
        PG8_LAS float* part = (PG8_LAS float*)lds;
        float sm[8]; drive_epi(*this, acc, u, wr, wc, fr, fq, sm);
#pragma unroll
        for (int g = 0; g < 8; ++g) { float s = sm[g]; s += __shfl_xor(s, 16); s += __shfl_xor(s, 32);
            if (fq == 0) part[wc * 256 + (g >> 2) * HALF + wr * 64 + (g & 3) * 16 + fr] = s; }
        asm volatile("s_waitcnt lgkmcnt(0)" ::: "memory"); __builtin_amdgcn_s_barrier(); asm volatile("" ::: "memory");
        const int t = wid * 64 + lane;
        if (t < 256) ssq_out[(size_t)u.pn * T_ROWS + u.pm * BM + t] = (part[t] + part[256 + t]) + (part[512 + t] + part[768 + t]);
        asm volatile("s_waitcnt lgkmcnt(0)" ::: "memory"); __builtin_amdgcn_s_barrier(); asm volatile("" ::: "memory");
    }
    __device__ __forceinline__ void operator()(const f32x4 (&acc)[2][2][4][2], const Unit& u, int wr, int wc, int fr, int fq) const {}
};
struct EpiUp {
    static constexpr bool PERM = true, AFTER_DRAIN = false, HAS_PRE = false;
    bf16_t* H; const float* ssq;
    __device__ __forceinline__ float row_scale(int row) const { return ssq4(ssq, row); }
    __device__ __forceinline__ void col8(int, f32x4& b0, f32x4& b1) const { b0 = (f32x4){0.f, 0.f, 0.f, 0.f}; b1 = b0; }
    __device__ __forceinline__ u32x4 pre8(int, int) const { return (u32x4){0u, 0u, 0u, 0u}; }
    __device__ __forceinline__ void row8(int row, int col, f32x4 v0, f32x4 v1, float rs, const f32x4&, const f32x4&, const u32x4&, float&) const {
        v0 = v0 * rs; v1 = v1 * rs;
#pragma unroll
        for (int e = 0; e < 4; ++e) { const float a = fmaxf(v0[e], 0.f), b = fmaxf(v1[e], 0.f); v0[e] = a * a; v1[e] = b * b; }
        { const u32x4 pk_ = pack8(v0, v1); bf16_t* dp_ = H + (size_t)row * 4224 + col;
          asm volatile("global_store_dwordx4 %0, %1, off sc1\n\ts_nop 1" :: "v"(dp_), "v"(pk_) : "memory"); }
    }
    __device__ __forceinline__ void operator()(const f32x4 (&acc)[2][2][4][2], const Unit& u, int wr, int wc, int fr, int fq) const { float sm[8]; drive_epi(*this, acc, u, wr, wc, fr, fq, sm); }
};
struct EpiGlu {
    static constexpr bool PERM = true, AFTER_DRAIN = false, HAS_PRE = true;
    const bf16_t* Z1; bf16_t* MIX; const float* b_glu;
    __device__ __forceinline__ float row_scale(int) const { return 1.f; }
    __device__ __forceinline__ void col8(int col, f32x4& b0, f32x4& b1) const { b0 = *(const f32x4*)(b_glu + col); b1 = *(const f32x4*)(b_glu + col + 4); }
    __device__ __forceinline__ u32x4 pre8(int row, int col) const { return *(const u32x4*)(Z1 + (size_t)row * 512 + col); }
    __device__ __forceinline__ void row8(int row, int col, f32x4 v0, f32x4 v1, float, const f32x4& b0, const f32x4& b1, const u32x4& pre, float&) const {
        f32x4 z0, z1; unpack8(pre, z0, z1);
#pragma unroll
        for (int e = 0; e < 4; ++e) { v0[e] = z0[e] * sigmoid_f(v0[e] + b0[e]); v1[e] = z1[e] * sigmoid_f(v1[e] + b1[e]); }
        *(u32x4*)(MIX + (size_t)row * 1024 + 512 + col) = pack8(v0, v1);
    }
    __device__ __forceinline__ void operator()(const f32x4 (&acc)[2][2][4][2], const Unit& u, int wr, int wc, int fr, int fq) const { float sm[8]; drive_epi(*this, acc, u, wr, wc, fr, fq, sm); }
};
}
constexpr int NWAVES = 8;
constexpr int D = 1024, TP = 16384, TS = 512, T = TP + TS, FF = 4096;
constexpr int NIN_E = 2304, NIN_O = 2048;
constexpr float EPS = 1e-6f;
constexpr size_t MiB = 1u << 20;
constexpr size_t WS_CTL = 0, CTL_ZERO_BYTES = 2 * MiB;
constexpr size_t WS_SSQ = 277 * MiB;
constexpr size_t CTL_S5AB = 1 * MiB;
constexpr size_t CTL_S5BRE = 1 * MiB + 64 * 1024;
constexpr size_t CTL_S5BIM = CTL_S5BRE + 256 * 1024;
constexpr size_t WS_W = 2 * MiB;
constexpr size_t W_INE = 0, W_GLU = 9437184, W_OUTE = 10485760, W_INO = 14680064, W_G = 23068672, W_OUTO = 24117248, W_UP = 28311552, W_DN = 61865984, W_END = 96468992;
constexpr size_t WS_WA = 94 * MiB;
constexpr int LD_FF = 4224;
constexpr size_t WS_XB = 95 * MiB, WS_R = 128 * MiB;
constexpr size_t R_H = 0, R_P = 0, R_LA = 66 * MiB, R_Z1 = 82 * MiB + MiB / 2, R_MIX = 99 * MiB, R_ORAW = 132 * MiB;
constexpr size_t R_CIN = 0, R_LOGA = 0, R_XC = 33 * MiB, R_BB = 66 * MiB;
constexpr size_t WS_END = WS_SSQ + (size_t)9 * 4 * T * 4;
static_assert(WS_R + 148 * MiB + MiB / 2 <= WS_SSQ, "ws map");
static_assert(WS_W + W_END <= WS_XB && WS_XB + (size_t)T * D * 2 <= WS_R, "ws map");
constexpr size_t OUT_YP = 0, OUT_YS = 16777216, OUT_GLAP = 17301504, OUT_REP = 17825792, OUT_IMP = 17858560, OUT_LRUP = 17891328, OUT_CONVP = 17907712,
                 OUT_GLAS = 17956864, OUT_RES = 26345472, OUT_IMS = 26869760, OUT_LRUS = 27394048, OUT_CONVS = 27656192, OUT_END = 28442624;
constexpr int CW_TMO = 0, CW_CODE = 1, CW_BAR = 4096;
constexpr int RING_OFF = 0, RING_BYTES = 131072, LDSCTL_OFF = RING_BYTES, MISC_OFF = LDSCTL_OFF + 320, LDS_BYTES = 147456;

#define GAS __attribute__((address_space(1)))
#define LAS __attribute__((address_space(3)))
typedef unsigned short bf16;
typedef unsigned v4u __attribute__((ext_vector_type(4)));
typedef unsigned v2u __attribute__((ext_vector_type(2)));
typedef float f32x4 __attribute__((ext_vector_type(4)));
typedef short bf16x8 __attribute__((ext_vector_type(8)));
typedef GAS unsigned gu32;
#define RLX_AGENT __ATOMIC_RELAXED, __HIP_MEMORY_SCOPE_AGENT
#define LDS_WAIT() asm volatile("s_waitcnt lgkmcnt(0)" ::: "memory")
#define VM_WAIT() asm volatile("s_waitcnt vmcnt(0)" ::: "memory")
__device__ __forceinline__ unsigned f2bf(float f) { unsigned u = __builtin_bit_cast(unsigned, f); return (u + 0x7fffu + ((u >> 16) & 1u)) >> 16; }
__device__ __forceinline__ unsigned pk2(float lo, float hi) { return f2bf(lo) | (f2bf(hi) << 16); }
__device__ __forceinline__ float bflo(unsigned w) { return __uint_as_float(w << 16); }
__device__ __forceinline__ float bfhi(unsigned w) { return __uint_as_float(w & 0xffff0000u); }
__device__ __forceinline__ float bf2f(bf16 h) { return __uint_as_float((unsigned)h << 16); }
__device__ __forceinline__ float sigmoid_f(float x) { return __builtin_amdgcn_rcpf(1.0f + __expf(-x)); }
__device__ __forceinline__ float gelu_tanh_f(float x) { const float u = 0.7978845608028654f * (x + 0.044715f * x * x * x); return x * __builtin_amdgcn_rcpf(1.0f + __expf(-2.0f * u)); }
__device__ __forceinline__ float wave_sum(float v) {
#pragma unroll
    for (int o = 1; o < 64; o <<= 1) v += __shfl_xor(v, o);
    return v;
}
#define XB_TMO      128
#define XB_XCNT(j)  (256  + 64 * (j))
#define XB_XSUB(j)  (1280 + 64 * (j))
#define XB_XGEN(j)  (2304 + 64 * (j))
#define XB_TOP      3328
#define XB_TOPGEN   3392
#define XCD_BAR_WORDS 3456
#define XB_SPIN_CAP (1u << 18)

__device__ __forceinline__ unsigned xb_ld(unsigned* p)              { return __hip_atomic_load(p, __ATOMIC_RELAXED, __HIP_MEMORY_SCOPE_AGENT); }
__device__ __forceinline__ unsigned xb_add(unsigned* p, unsigned v) { return __hip_atomic_fetch_add(p, v, __ATOMIC_RELAXED, __HIP_MEMORY_SCOPE_AGENT); }
__device__ __forceinline__ unsigned xb_xcc_id() { return (unsigned)__builtin_amdgcn_s_getreg((3 << 11) | 20) & 0xFu; }
#define XB_SPIN(cond, bar) do { unsigned _sp = 0; while (cond) { __builtin_amdgcn_s_sleep(1); \
    if ((++_sp & 255u) == 0u) { if (xb_ld(&(bar)[XB_TMO])) break; if (_sp > XB_SPIN_CAP) { atomicAdd(&(bar)[XB_TMO], 1u); break; } } } } while (0)

struct XcdBarrier {
    unsigned* bar; unsigned x;
    volatile LAS unsigned* st;
};

__device__ __forceinline__ XcdBarrier xcd_barrier_post(unsigned* bar, volatile LAS unsigned* st, int tid) {
    XcdBarrier b; b.bar = bar; b.x = xb_xcc_id(); b.st = st;
    if (tid == 0) (void)xb_add(&bar[XB_XCNT(b.x)], 1u);
    return b;
}
__device__ __forceinline__ void xcd_barrier_complete(unsigned* bar, unsigned x, unsigned& nloc, unsigned& nx) {
    const unsigned G = gridDim.x * gridDim.y * gridDim.z;
    unsigned sum, cnt, mine, sp = 0u;
    for (;;) {
        sum = 0u; cnt = 0u; mine = 0u;
#pragma unroll
        for (unsigned j = 0; j < 16; ++j) { const unsigned c = xb_ld(&bar[XB_XCNT(j)]); sum += c; cnt += (c > 0u) ? 1u : 0u; mine = (j == x) ? c : mine; }
        if (sum == G) break;
        __builtin_amdgcn_s_sleep(1);
        if ((++sp & 255u) == 0u) { if (xb_ld(&bar[XB_TMO])) break; if (sp > XB_SPIN_CAP) { atomicAdd(&bar[XB_TMO], 1u); break; } }
    }
    nloc = mine > 0u ? mine : 1u; nx = cnt > 0u ? cnt : 1u;
}

__device__ __forceinline__ void xcd_barrier(const XcdBarrier& b, int tid) {
    asm volatile("s_waitcnt vmcnt(0)" ::: "memory");
    __syncthreads();
    if (tid == 0) {
        unsigned* bar = b.bar;
        __builtin_amdgcn_s_waitcnt(0);
        unsigned nloc = b.st[0], nx = b.st[1];
        if (nloc == 0u) { xcd_barrier_complete(bar, b.x, nloc, nx); b.st[0] = nloc; b.st[1] = nx; }
        const unsigned old = xb_add(&bar[XB_XSUB(b.x)], 1u);
        const unsigned gen = old / nloc;
        if (old + 1u == (gen + 1u) * nloc) {
            __builtin_amdgcn_fence(__ATOMIC_RELEASE, "agent");
            asm volatile("s_waitcnt vmcnt(0)" ::: "memory");
            const unsigned og = xb_add(&bar[XB_TOP], 1u);
            const unsigned tg = og / nx;
            if (og + 1u == (tg + 1u) * nx) xb_add(&bar[XB_TOPGEN], 1u);
            else XB_SPIN(xb_ld(&bar[XB_TOPGEN]) == tg, bar);
            __builtin_amdgcn_fence(__ATOMIC_ACQUIRE, "agent");
            xb_add(&bar[XB_XGEN(b.x)], 1u);
            asm volatile("s_waitcnt vmcnt(0)" ::: "memory");
        } else {
            XB_SPIN(xb_ld(&bar[XB_XGEN(b.x)]) == gen, bar);
            __builtin_amdgcn_fence(__ATOMIC_ACQUIRE, "agent");
            asm volatile("s_waitcnt vmcnt(0)" ::: "memory");
        }
    }
    __syncthreads();
}
struct Args { const float* in[37]; float* out; unsigned char* ws; int ph_lo, ph_hi, li, pad; };
template <class T> __device__ __forceinline__ T* as_global(T* p) { const unsigned long long u = (unsigned long long)p; return (T*)(GAS T*)u; }
struct InPtrs { const float* const* p; __device__ __forceinline__ const float* operator[](int i) const { return as_global(p[i]); } };
struct Ctx { InPtrs in; float* out; unsigned char* ws; LAS unsigned char* lds; int tid, lane, wave, vcu, G, gw, NGW, var; };

__device__ __forceinline__ void tr_item(const float* W, int ldw, int K, const float* gain, bf16* WT, LAS float* scr, int kb, int nb, int lane, int ldo) {
    const int k0 = 64 * kb, n0 = 32 * nb;
    f32x4 v[8];
#pragma unroll
    for (int i = 0; i < 8; ++i) v[i] = __builtin_nontemporal_load((const f32x4*)(W + (size_t)(k0 + 8 * i + (lane >> 3)) * ldw + n0 + 4 * (lane & 7)));
#pragma unroll
    for (int i = 0; i < 8; ++i) { const int kk = 8 * i + (lane >> 3); f32x4 x = v[i]; if (gain) x = x * gain[k0 + kk];
        LAS float* d = scr + kk * 33 + 4 * (lane & 7); d[0] = x[0]; d[1] = x[1]; d[2] = x[2]; d[3] = x[3]; }
    LDS_WAIT(); asm volatile("" ::: "memory");
    const int c = lane & 7;
#pragma unroll
    for (int j = 0; j < 4; ++j) { const int n = (lane >> 3) + 8 * j; const LAS float* s = scr + (8 * c) * 33 + n;
        v4u o; o.x = pk2(s[0 * 33], s[1 * 33]); o.y = pk2(s[2 * 33], s[3 * 33]); o.z = pk2(s[4 * 33], s[5 * 33]); o.w = pk2(s[6 * 33], s[7 * 33]);
        __builtin_nontemporal_store(o, (GAS v4u*)(WT + (size_t)(n0 + n) * ldo + k0 + 8 * c)); }
    LDS_WAIT(); asm volatile("" ::: "memory");
}
__device__ __forceinline__ void tr_job(const Ctx& c, int& base, const float* W, int ldw, int ncols, int K, const float* gain, bf16* WT, LAS float* scr, int ldo = 0) {
    if (ldo == 0) ldo = K;
    const int nblk = ncols / 32, nitems = (K / 64) * nblk;
    int first = (c.gw - base) % c.NGW; if (first < 0) first += c.NGW;
    for (int it = first; it < nitems; it += c.NGW) tr_item(W, ldw, K, gain, WT, scr, it / nblk, it % nblk, c.lane, ldo);
    base = (base + nitems) % c.NGW;
}
__device__ __forceinline__ void sincos_d(double x, double& s, double& c) {
    const double j = __builtin_rint(x * 0.63661977236758134308);
    double r = __builtin_fma(-j, 1.57079632673412561417e+00, x); r = __builtin_fma(-j, 6.07710050650619224932e-11, r);
    const double z = r * r;
    const double sp = r + r * z * (-1.66666666666666307295e-1 + z * (8.33333333332211858878e-3 + z * (-1.98412698295895385996e-4 + z * (2.75573136213857245213e-6 + z * (-2.50507477628578072866e-8 + z * 1.58962301576546568060e-10)))));
    const double cp = 1.0 - 0.5 * z + z * z * (4.16666666666665929218e-2 + z * (-1.38888888888730564116e-3 + z * (2.48015872888517045348e-5 + z * (-2.75573141792967388112e-7 + z * (2.08757008419747316778e-9 + z * -1.13585365213876817300e-11)))));
    const int q = ((int)j) & 3;
    s = (q == 0) ? sp : (q == 1) ? cp : (q == 2) ? -sp : -cp;
    c = (q == 0) ? cp : (q == 1) ? -sp : (q == 2) ? -cp : sp;
}
__device__ __forceinline__ void p0_weights_rest(const Ctx& c) {
    LAS float* scr = (LAS float*)(c.lds + RING_OFF + c.wave * 16384);
    const InPtrs in = c.in; unsigned char* ws = c.ws;
    bf16* Wb = (bf16*)(ws + WS_W);
    int base = 0;
    for (int e = 0; e < 2; ++e) {
        if (e == 1) { const float* w = in[8] + (size_t)e * 1024 * 2064; const float* g = in[7] + e * 1024; bf16* dst = (bf16*)((unsigned char*)Wb + W_INE) + (size_t)e * NIN_E * 1024;
            tr_job(c, base, w, 2064, 1536, 1024, g, dst, scr);
            tr_job(c, base, w + 1552, 2064, 512, 1024, g, dst + (size_t)1536 * 1024, scr); }
        tr_job(c, base, in[20] + (size_t)e * 512 * 512, 512, 512, 512, nullptr, (bf16*)((unsigned char*)Wb + W_GLU) + (size_t)e * 512 * 512, scr);
        tr_job(c, base, in[22] + (size_t)e * 1024 * 1024, 1024, 1024, 1024, nullptr, (bf16*)((unsigned char*)Wb + W_OUTE) + (size_t)e * 1024 * 1024, scr);
    }
    for (int o = 0; o < 2; ++o) {
        tr_job(c, base, in[24] + (size_t)o * 1024 * 2048, 2048, 2048, 1024, in[23] + o * 1024, (bf16*)((unsigned char*)Wb + W_INO) + (size_t)o * 2048 * 1024, scr);
        tr_job(c, base, in[32] + (size_t)o * 1024 * 1024, 1024, 1024, 1024, nullptr, (bf16*)((unsigned char*)Wb + W_OUTO) + (size_t)o * 1024 * 1024, scr);
        for (int n = 0; n < 8; ++n) {
            bf16* dst = (bf16*)((unsigned char*)Wb + W_G) + ((size_t)o * 8 + n) * 256 * 128;
            tr_job(c, base, in[27] + ((size_t)o * 8 + n) * 128 * 128, 128, 128, 128, nullptr, dst, scr);
            tr_job(c, base, in[29] + ((size_t)o * 8 + n) * 128 * 128, 128, 128, 128, nullptr, dst + 128 * 128, scr);
        }
    }
    for (int l = 0; l < 4; ++l) {
        tr_job(c, base, in[34] + (size_t)l * 1024 * 4096, 4096, 4096, 1024, in[33] + l * 1024, (bf16*)((unsigned char*)Wb + W_UP) + (size_t)l * 4096 * 1024, scr);
        tr_job(c, base, in[35] + (size_t)l * 4096 * 1024, 1024, 1024, 4096, nullptr, (bf16*)((unsigned char*)Wb + W_DN) + (size_t)l * 1024 * LD_FF, scr, LD_FF);
    }
    __syncthreads();
}
__device__ __forceinline__ void p0_prologue(const Ctx& c) {
    LAS float* scr = (LAS float*)(c.lds + RING_OFF + c.wave * 16384);
    const InPtrs in = c.in; unsigned char* ws = c.ws;
    bf16* Wb = (bf16*)(ws + WS_W);
    int base = 0;
    { const float* w = in[8]; const float* g = in[7]; bf16* dst = (bf16*)((unsigned char*)Wb + W_INE);
      tr_job(c, base, w, 2064, 1536, 1024, g, dst, scr);
      tr_job(c, base, w + 1552, 2064, 512, 1024, g, dst + (size_t)1536 * 1024, scr); }
    const int gtid = c.vcu * (NWAVES * 64) + c.tid, NT = c.G * NWAVES * 64;
    for (int i = gtid; i < 2 * 16 * 128; i += NT) {
        const int e = i >> 11, j = (i >> 7) & 15, k0 = (i & 127) * 8; const float* w = in[8] + (size_t)e * 1024 * 2064 + 1536 + j; const float* g = in[7] + e * 1024;
        float o[8];
#pragma unroll
        for (int kk = 0; kk < 8; ++kk) o[kk] = w[(size_t)(k0 + kk) * 2064] * g[k0 + kk];
        v4u pk; pk.x = pk2(o[0], o[1]); pk.y = pk2(o[2], o[3]); pk.z = pk2(o[4], o[5]); pk.w = pk2(o[6], o[7]);
        *(v4u*)((bf16*)(ws + WS_WA) + ((size_t)e * 16 + j) * 1024 + k0) = pk;
    }
    for (int i = gtid; i < 2 * 256 * 2; i += NT) {
        const int e = i >> 9, n = (i >> 1) & 255, j0 = (i & 1) * 8; const float* a2 = in[9] + (size_t)e * 16 * 256 + n;
        float o[8];
#pragma unroll
        for (int jj = 0; jj < 8; ++jj) o[jj] = a2[(size_t)(j0 + jj) * 256];
        v4u pk; pk.x = pk2(o[0], o[1]); pk.y = pk2(o[2], o[3]); pk.z = pk2(o[4], o[5]); pk.w = pk2(o[6], o[7]);
        *(v4u*)((bf16*)(ws + WS_WA) + 2 * 16 * 1024 + ((size_t)e * 256 + n) * 16 + j0) = pk;
    }
    for (int i = gtid; i < 2 * 32 * 64; i += NT) {
        const double dt = exp((double)in[14][i >> 6]);
        const double are = (double)in[12][i], aim = (double)in[13][i];
        const double zr = dt * are, zi = dt * aim; double sn, cs; sincos_d(zi, sn, cs);
        const double mag = exp(zr), abre = mag * cs, abim = mag * sn;
        double sh, ch; sincos_d(0.5 * zi, sh, ch);
        const double m1re = expm1(zr) * cs - 2.0 * sh * sh, m1im = abim;
        const double den = are * are + aim * aim;
        const double cre = (m1re * are + m1im * aim) / den, cim = (m1im * are - m1re * aim) / den;
        float* AB = (float*)(ws + CTL_S5AB); AB[2 * i] = (float)abre; AB[2 * i + 1] = (float)abim;
        float* BRE = (float*)(ws + CTL_S5BRE) + (size_t)i * 16; float* BIM = (float*)(ws + CTL_S5BIM) + (size_t)i * 16;
        const float* bre = in[15] + (size_t)i * 16; const float* bim = in[16] + (size_t)i * 16;
#pragma unroll
        for (int q = 0; q < 16; ++q) { const double br = bre[q], bi = bim[q]; BRE[q] = (float)(cre * br - cim * bi); BIM[q] = (float)(cre * bi + cim * br); }
    }
    bf16* XB = (bf16*)(ws + WS_XB); float* ssq0 = (float*)(ws + WS_SSQ);
    for (int m = c.gw; m < T; m += c.NGW) {
        const float* xr = (m < TP) ? in[0] + (size_t)m * D : in[1] + (size_t)(m - TP) * D;
        const GAS f32x4* x4 = (const GAS f32x4*)xr + c.lane; f32x4 v[4]; float s = 0.f;
#pragma unroll
        for (int j = 0; j < 4; ++j) { v[j] = __builtin_nontemporal_load(x4 + 64 * j); s += (v[j].x * v[j].x + v[j].y * v[j].y) + (v[j].z * v[j].z + v[j].w * v[j].w); }
        s = wave_sum(s);
        GAS v2u* o8 = (GAS v2u*)(XB + (size_t)m * D) + c.lane;
#pragma unroll
        for (int j = 0; j < 4; ++j) { v2u w; w.x = pk2(v[j].x, v[j].y); w.y = pk2(v[j].z, v[j].w); o8[64 * j] = w; }
        if (c.lane < 4) ssq0[(size_t)c.lane * T + m] = (c.lane == 0) ? s : 0.f;
    }
}
__device__ __forceinline__ void gla_naive_block(const Ctx& c, int e, int item0, bool sample) {
    unsigned char* ws = c.ws;
    const bf16* P = (const bf16*)(ws + WS_R + R_P); const float* LA = (const float*)(ws + WS_R + R_LA); bf16* ORAW = (bf16*)(ws + WS_R + R_ORAW);
    const int sub = c.tid >> 7, st = c.tid & 127, item = item0 + sub, b = item >> 2, h = item & 3;
    const int row0 = sample ? TP + b * 4 : b * 2048, n = sample ? 4 : 2048;
    float S[64];
    if (sample) { const float* s0 = c.in[2] + (((size_t)e * 128 + b) * 4 + h) * 8192;
#pragma unroll
        for (int d = 0; d < 64; ++d) S[d] = s0[d * 128 + st]; }
    else {
#pragma unroll
        for (int d = 0; d < 64; ++d) S[d] = 0.f; }
    LAS float* lq = (LAS float*)(c.lds + RING_OFF) + sub * 5120; LAS float* lk = lq + 1024; LAS float* la = lq + 2048; LAS float* lv = lq + 3072;
    for (int t0 = 0; t0 < n; t0 += 16) {
        const int nt = (n - t0) < 16 ? (n - t0) : 16;
        __syncthreads();
#pragma unroll
        for (int i = 0; i < 8; ++i) { const int idx = st + 128 * i, tt = idx >> 6, d = idx & 63;
            if (tt < nt) { const size_t row = (size_t)(row0 + t0 + tt);
                lq[idx] = bf2f(P[row * 2048 + h * 64 + d]); lk[idx] = bf2f(P[row * 2048 + 256 + h * 64 + d]); la[idx] = __expf(LA[row * 256 + h * 64 + d]); } }
#pragma unroll
        for (int tt = 0; tt < 16; ++tt) if (tt < nt) lv[tt * 128 + st] = bf2f(P[(size_t)(row0 + t0 + tt) * 2048 + 512 + h * 128 + st]);
        __syncthreads();
#pragma unroll 1
        for (int tt = 0; tt < nt; ++tt) {
            const float v = lv[tt * 128 + st]; float o = 0.f;
#pragma unroll
            for (int d4 = 0; d4 < 16; ++d4) { const f32x4 a4 = *(const LAS f32x4*)(la + tt * 64 + 4 * d4), k4 = *(const LAS f32x4*)(lk + tt * 64 + 4 * d4), q4 = *(const LAS f32x4*)(lq + tt * 64 + 4 * d4);
#pragma unroll
                for (int i = 0; i < 4; ++i) { S[4 * d4 + i] = a4[i] * S[4 * d4 + i] + k4[i] * v; o += q4[i] * S[4 * d4 + i]; } }
            ORAW[(size_t)(row0 + t0 + tt) * 512 + h * 128 + st] = (bf16)f2bf(o * 0.125f);
        }
    }
    float* dst = c.out + (sample ? OUT_GLAS + (((size_t)e * 128 + b) * 4 + h) * 8192 : OUT_GLAP + (((size_t)e * 8 + b) * 4 + h) * 8192);
#pragma unroll
    for (int d = 0; d < 64; ++d) dst[d * 128 + st] = S[d];
}
__device__ __forceinline__ void s5_naive_wave(const Ctx& c, int e, int item, bool sample, LAS float* wl) {
    unsigned char* ws = c.ws; const int lane = c.lane;
    const bf16* P = (const bf16*)(ws + WS_R + R_P); bf16* Z1 = (bf16*)(ws + WS_R + R_Z1);
    const int b = item >> 5, g = item & 31, row0 = sample ? TP + b * 4 : b * 2048, n = sample ? 4 : 2048;
    const int idx = (e * 32 + g) * 64 + lane;
    const float* AB = (const float*)(ws + CTL_S5AB); const float ar = AB[2 * idx], ai = AB[2 * idx + 1];
    float bre[16], bim[16];
    { const f32x4* r4 = (const f32x4*)((const float*)(ws + CTL_S5BRE) + (size_t)idx * 16); const f32x4* i4 = (const f32x4*)((const float*)(ws + CTL_S5BIM) + (size_t)idx * 16);
#pragma unroll
      for (int q = 0; q < 4; ++q) { const f32x4 a = r4[q], bb = i4[q];
#pragma unroll
          for (int j = 0; j < 4; ++j) { bre[4 * q + j] = a[j]; bim[4 * q + j] = bb[j]; } } }
    float hre = 0.f, him = 0.f;
    if (sample) { hre = c.in[3][(((size_t)e * 128 + b) * 32 + g) * 64 + lane]; him = c.in[4][(((size_t)e * 128 + b) * 32 + g) * 64 + lane]; }
    LAS float* lcre = wl; LAS float* lcim = wl + 1024; LAS float* lu = wl + 2048; LAS float* hs = wl + 2176;
    { const float* cr = c.in[17] + (size_t)(e * 32 + g) * 1024; const float* ci = c.in[18] + (size_t)(e * 32 + g) * 1024;
#pragma unroll
      for (int i = 0; i < 16; ++i) { lcre[i * 64 + lane] = cr[i * 64 + lane]; lcim[i * 64 + lane] = ci[i * 64 + lane]; } }
    const int ott = lane >> 3, oc0 = 2 * (lane & 7);
    const float dsk0 = c.in[19][(e * 32 + g) * 16 + oc0], dsk1 = c.in[19][(e * 32 + g) * 16 + oc0 + 1];
    for (int t0 = 0; t0 < n; t0 += 8) {
        const int nt = (n - t0) < 8 ? (n - t0) : 8;
#pragma unroll
        for (int i = 0; i < 2; ++i) { const int ix = lane + 64 * i, tt = ix >> 4, cc = ix & 15;
            lu[ix] = (tt < nt) ? bf2f(P[(size_t)(row0 + t0 + tt) * 2048 + 1536 + g * 16 + cc]) : 0.f; }
        LDS_WAIT(); asm volatile("" ::: "memory");
#pragma unroll
        for (int tt = 0; tt < 8; ++tt) {
            if (tt < nt) {
                float bur = 0.f, bui = 0.f;
#pragma unroll
                for (int q = 0; q < 4; ++q) { const f32x4 u4 = *(const LAS f32x4*)(lu + tt * 16 + 4 * q);
#pragma unroll
                    for (int j = 0; j < 4; ++j) { bur += u4[j] * bre[4 * q + j]; bui += u4[j] * bim[4 * q + j]; } }
                const float nre = ar * hre - ai * him + bur, nim = ar * him + ai * hre + bui; hre = nre; him = nim;
                hs[tt * 128 + lane] = hre; hs[tt * 128 + 64 + lane] = him;
            }
        }
        LDS_WAIT(); asm volatile("" ::: "memory");
        if (ott < nt) {
            float y0 = 0.f, y1 = 0.f;
#pragma unroll
            for (int p4 = 0; p4 < 16; ++p4) {
                const f32x4 hr = *(const LAS f32x4*)(hs + ott * 128 + 4 * p4), hi = *(const LAS f32x4*)(hs + ott * 128 + 64 + 4 * p4);
                const f32x4 c0r = *(const LAS f32x4*)(lcre + oc0 * 64 + 4 * p4), c0i = *(const LAS f32x4*)(lcim + oc0 * 64 + 4 * p4);
                const f32x4 c1r = *(const LAS f32x4*)(lcre + (oc0 + 1) * 64 + 4 * p4), c1i = *(const LAS f32x4*)(lcim + (oc0 + 1) * 64 + 4 * p4);
#pragma unroll
                for (int j = 0; j < 4; ++j) { y0 += hr[j] * c0r[j] - hi[j] * c0i[j]; y1 += hr[j] * c1r[j] - hi[j] * c1i[j]; }
            }
            y0 += dsk0 * lu[ott * 16 + oc0]; y1 += dsk1 * lu[ott * 16 + oc0 + 1];
            *(unsigned*)(Z1 + (size_t)(row0 + t0 + ott) * 512 + g * 16 + oc0) = pk2(gelu_tanh_f(y0), gelu_tanh_f(y1));
        }
        LDS_WAIT(); asm volatile("" ::: "memory");
    }
    float* dre = c.out + (sample ? OUT_RES + (((size_t)e * 128 + b) * 32 + g) * 64 : OUT_REP + (((size_t)e * 8 + b) * 32 + g) * 64);
    float* dim = c.out + (sample ? OUT_IMS + (((size_t)e * 128 + b) * 32 + g) * 64 : OUT_IMP + (((size_t)e * 8 + b) * 32 + g) * 64);
    dre[lane] = hre; dim[lane] = him;
}
__device__ __forceinline__ void gla_post(const Ctx& c, int e) {
    unsigned char* ws = c.ws; const int lane = c.lane;
    const bf16* P = (const bf16*)(ws + WS_R + R_P); const bf16* ORAW = (const bf16*)(ws + WS_R + R_ORAW); bf16* MIX = (bf16*)(ws + WS_R + R_MIX);
    const float* gn = c.in[11] + e * 512;
    for (int wi = TP * 4 + c.gw; wi < T * 4; wi += c.NGW) {
        const int row = wi >> 2, h = wi & 3;
        const unsigned ow = *(const unsigned*)(ORAW + (size_t)row * 512 + h * 128 + 2 * lane);
        const float o0 = bflo(ow), o1 = bfhi(ow);
        const float ss = wave_sum(o0 * o0 + o1 * o1), rs = rsqrtf(ss * (1.0f / 128.0f) + EPS);
        const unsigned gw = *(const unsigned*)(P + (size_t)row * 2048 + 1024 + h * 128 + 2 * lane);
        *(unsigned*)(MIX + (size_t)row * 1024 + h * 128 + 2 * lane) = pk2(o0 * rs * gn[h * 128 + 2 * lane] * bflo(gw), o1 * rs * gn[h * 128 + 2 * lane + 1] * bfhi(gw));
    }
}
__device__ __forceinline__ void final_norm(const Ctx& c) {
    const float* nf = c.in[36]; const bf16* XB = (const bf16*)(c.ws + WS_XB);
    for (int m = c.gw; m < T; m += c.NGW) {
        const v4u* x8 = (const v4u*)(XB + (size_t)m * D) + c.lane; float v[16]; float s = 0.f;
#pragma unroll
        for (int j = 0; j < 2; ++j) { const v4u w = x8[64 * j];
#pragma unroll
            for (int q = 0; q < 4; ++q) { v[8 * j + 2 * q] = bflo(w[q]); v[8 * j + 2 * q + 1] = bfhi(w[q]); } }
#pragma unroll
        for (int i = 0; i < 16; ++i) s += v[i] * v[i];
        const float rs = rsqrtf(wave_sum(s) * (1.0f / 1024.0f) + EPS);
#pragma unroll
        for (int j = 0; j < 2; ++j) { const int col = 512 * j + 8 * c.lane; const f32x4 g0 = *(const f32x4*)(nf + col), g1 = *(const f32x4*)(nf + col + 4);
            f32x4 o0, o1;
#pragma unroll
            for (int q = 0; q < 4; ++q) { o0[q] = v[8 * j + q] * rs * g0[q]; o1[q] = v[8 * j + 4 + q] * rs * g1[q]; }
            *(f32x4*)(c.out + (size_t)m * D + col) = o0; *(f32x4*)(c.out + (size_t)m * D + col + 4) = o1; }
    }
}
typedef float f32x16 __attribute__((ext_vector_type(16)));
typedef short s16x4 __attribute__((ext_vector_type(4)));
typedef float f32x2_t __attribute__((ext_vector_type(2)));
typedef __bf16 bf16x2_t __attribute__((ext_vector_type(2)));
#define MFMA32(a, b, c) __builtin_amdgcn_mfma_f32_32x32x16_bf16((a), (b), (c), 0, 0, 0)
__device__ __forceinline__ unsigned cvtpk(float lo, float hi) { f32x2_t v = {lo, hi}; bf16x2_t b = __builtin_convertvector(v, bf16x2_t); return __builtin_bit_cast(unsigned, b); }
template <int S_> __device__ __forceinline__ bf16x8 pack_step(const f32x16& x) {
    v4u p; p.x = cvtpk(x[8 * S_], x[8 * S_ + 1]); p.y = cvtpk(x[8 * S_ + 2], x[8 * S_ + 3]); p.z = cvtpk(x[8 * S_ + 4], x[8 * S_ + 5]); p.w = cvtpk(x[8 * S_ + 6], x[8 * S_ + 7]);
    return __builtin_bit_cast(bf16x8, p);
}
__device__ __forceinline__ s16x4 trr(const LAS unsigned char* p) { return __builtin_bit_cast(s16x4, __builtin_amdgcn_ds_read_tr16_b64_v4i16((LAS s16x4*)p)); }
__device__ __forceinline__ bf16x8 cat8(s16x4 lo, s16x4 hi) { return __builtin_shufflevector(lo, hi, 0, 1, 2, 3, 4, 5, 6, 7); }
__device__ __forceinline__ bf16x8 cat8u(v2u lo, v2u hi) { v4u w; w.x = lo.x; w.y = lo.y; w.z = hi.x; w.w = hi.y; return __builtin_bit_cast(bf16x8, w); }
constexpr int GL_PQ = 144, GL_PV = 320, GL_PSG = 272;
constexpr int GL_QS = 0, GL_KS = 32 * GL_PQ, GL_V = 2 * 32 * GL_PQ, GL_SG = GL_V + 32 * GL_PV, GL_EL = GL_SG + 32 * GL_PSG, GL_BUF = GL_EL + 256;
constexpr int GL_TOT = 2 * GL_BUF, GL_PART = GL_TOT + 2048, GL_END = GL_PART + 512;
static_assert(GL_BUF % 16 == 0 && GL_END <= RING_BYTES, "GLA LDS map");

__device__ __forceinline__ void gla_fast_block(const Ctx& c, int e, int item) {
    unsigned char* ws = c.ws;
    const bf16* P = (const bf16*)(ws + WS_R + R_P); const float* LA = (const float*)(ws + WS_R + R_LA); bf16* MIX = (bf16*)(ws + WS_R + R_MIX);
    const int b = item >> 2, hh = item & 3, row0 = b * 2048;
    const int lane = c.lane, r32 = lane & 31, h = lane >> 5, wv = c.wave;
    LAS unsigned char* L = c.lds + RING_OFF;
    const int i16 = lane & 15, tq = i16 >> 2, tp = i16 & 3, blk = (lane >> 4) & 1;
    const bool consumer = wv < 4;
    if (consumer) {
        const int et = wv & 3;
        f32x16 S0, S1, O;
#pragma unroll
        for (int r = 0; r < 16; ++r) { S0[r] = 0.f; S1[r] = 0.f; }
        float gh[16];
#pragma unroll
        for (int r = 0; r < 16; ++r) gh[r] = c.in[11][e * 512 + hh * 128 + 32 * et + (r & 3) + 8 * (r >> 2) + 4 * h];
        __syncthreads(); __syncthreads();
        for (int n = 0; n < 64; ++n) {
            const int bo = (n & 1) * GL_BUF;
            float rs = 0.f;
            const LAS unsigned char* Qs = L + bo + GL_QS; const LAS unsigned char* Ks = L + bo + GL_KS; const LAS unsigned char* Vi = L + bo + GL_V;
            f32x16 X;
#pragma unroll
            for (int r = 0; r < 16; ++r) X[r] = 0.f;
#pragma unroll
            for (int s = 0; s < 4; ++s) { const bf16x8 ka = *(const LAS bf16x8*)(Ks + r32 * GL_PQ + 32 * s + 16 * h), qb = *(const LAS bf16x8*)(Qs + r32 * GL_PQ + 32 * s + 16 * h); X = MFMA32(ka, qb, X); }
#pragma unroll
            for (int r = 0; r < 16; ++r) { const int j = (r & 3) + 8 * (r >> 2) + 4 * h; X[r] = (j <= r32) ? X[r] : 0.f; }
            const bf16x8 px0 = pack_step<0>(X), px1 = pack_step<1>(X);
#pragma unroll
            for (int r = 0; r < 16; ++r) O[r] = 0.f;
            { const LAS unsigned char* vb = Vi + (4 * h + tq) * GL_PV + (32 * et + 16 * blk + 4 * tp) * 2;
              const bf16x8 a0 = cat8(trr(vb), trr(vb + 8 * GL_PV)), a1 = cat8(trr(vb + 16 * GL_PV), trr(vb + 24 * GL_PV));
              O = MFMA32(a0, px0, O); O = MFMA32(a1, px1, O); }
            { const LAS unsigned char* qp = Qs + r32 * GL_PQ + 8 * h;
              const bf16x8 sa0 = pack_step<0>(S0), sa1 = pack_step<1>(S0), sa2 = pack_step<0>(S1), sa3 = pack_step<1>(S1);
              const bf16x8 b0 = cat8u(*(const LAS v2u*)(qp), *(const LAS v2u*)(qp + 16)), b1 = cat8u(*(const LAS v2u*)(qp + 32), *(const LAS v2u*)(qp + 48));
              const bf16x8 b2 = cat8u(*(const LAS v2u*)(qp + 64), *(const LAS v2u*)(qp + 80)), b3 = cat8u(*(const LAS v2u*)(qp + 96), *(const LAS v2u*)(qp + 112));
              O = MFMA32(sa0, b0, O); O = MFMA32(sa1, b1, O); O = MFMA32(sa2, b2, O); O = MFMA32(sa3, b3, O); }
            { const LAS unsigned char* kb = Ks + (8 * h + tq) * GL_PQ + (16 * blk + 4 * tp) * 2; const LAS unsigned char* vb = Vi + (8 * h + tq) * GL_PV + (32 * et + 16 * blk + 4 * tp) * 2;
              const bf16x8 v0 = cat8(trr(vb), trr(vb + 4 * GL_PV)), v1 = cat8(trr(vb + 16 * GL_PV), trr(vb + 20 * GL_PV));
              const bf16x8 k00 = cat8(trr(kb), trr(kb + 4 * GL_PQ)), k01 = cat8(trr(kb + 16 * GL_PQ), trr(kb + 20 * GL_PQ));
              const bf16x8 k10 = cat8(trr(kb + 64), trr(kb + 64 + 4 * GL_PQ)), k11 = cat8(trr(kb + 64 + 16 * GL_PQ), trr(kb + 64 + 20 * GL_PQ));
              S0 = MFMA32(k00, v0, S0); S0 = MFMA32(k01, v1, S0); S1 = MFMA32(k10, v0, S1); S1 = MFMA32(k11, v1, S1);
              const LAS float* el = (const LAS float*)(L + bo + GL_EL);
#pragma unroll
              for (int g4 = 0; g4 < 4; ++g4) { const f32x4 f0 = *(const LAS f32x4*)(el + 8 * g4 + 4 * h), f1 = *(const LAS f32x4*)(el + 32 + 8 * g4 + 4 * h);
#pragma unroll
                  for (int q = 0; q < 4; ++q) { S0[4 * g4 + q] *= f0[q]; S1[4 * g4 + q] *= f1[q]; } } }
            float ss = 0.f;
#pragma unroll
            for (int r = 0; r < 16; ++r) ss += O[r] * O[r];
            ss += __shfl_xor(ss, 32);
            if (h == 0) *(LAS float*)(L + GL_PART + (et * 32 + r32) * 4) = ss;
            __syncthreads();
            const LAS float* part = (const LAS float*)(L + GL_PART);
            const float tot = (part[r32] + part[32 + r32]) + (part[64 + r32] + part[96 + r32]);
            rs = rsqrtf(tot * (1.0f / 128.0f) + EPS);
            const LAS unsigned char* sgp = L + bo + GL_SG + r32 * GL_PSG + (32 * et + 4 * h) * 2;
            bf16* dst = MIX + (size_t)(row0 + 32 * n + r32) * 1024 + hh * 128 + 32 * et + 4 * h;
#pragma unroll
            for (int g4 = 0; g4 < 4; ++g4) { const v2u sg = *(const LAS v2u*)(sgp + 16 * g4);
                v2u ov; ov.x = cvtpk(O[4 * g4] * rs * gh[4 * g4] * bflo(sg.x), O[4 * g4 + 1] * rs * gh[4 * g4 + 1] * bfhi(sg.x));
                ov.y = cvtpk(O[4 * g4 + 2] * rs * gh[4 * g4 + 2] * bflo(sg.y), O[4 * g4 + 3] * rs * gh[4 * g4 + 3] * bfhi(sg.y));
                *(v2u*)(dst + 8 * g4) = ov; }
            __syncthreads();
        }
        float* dst = c.out + OUT_GLAP + (((size_t)e * 8 + b) * 4 + hh) * 8192 + 32 * et + r32;
#pragma unroll
        for (int r = 0; r < 16; ++r) { const int d = (r & 3) + 8 * (r >> 2) + 4 * h; dst[(size_t)d * 128] = S0[r]; dst[(size_t)(32 + d) * 128] = S1[r]; }
    } else {
        const int pt = c.tid - 256, dp = pt & 31, jq = (pt >> 5) & 7;
        f32x2_t la2[4][4]; unsigned q2[4][4], k2[4][4]; v4u vraw[4][2], graw[4][2];
        float cs0[4], cs1[4];
#define GLA_LOAD(chunk, RS) do { const size_t rb_ = (size_t)(row0 + 32 * (chunk)); \
        _Pragma("unroll") for (int j_ = 0; j_ < 4; ++j_) { const size_t rw_ = rb_ + 4 * jq + j_; \
            la2[RS][j_] = *(const f32x2_t*)(LA + rw_ * 256 + hh * 64 + 2 * dp); q2[RS][j_] = *(const unsigned*)(P + rw_ * 2048 + hh * 64 + 2 * dp); k2[RS][j_] = *(const unsigned*)(P + rw_ * 2048 + 256 + hh * 64 + 2 * dp); } \
        _Pragma("unroll") for (int x_ = 0; x_ < 2; ++x_) { const int pc_ = pt + 256 * x_, j_ = pc_ >> 4, e8_ = pc_ & 15; \
            vraw[RS][x_] = *(const v4u*)(P + (rb_ + j_) * 2048 + 512 + hh * 128 + 8 * e8_); graw[RS][x_] = *(const v4u*)(P + (rb_ + j_) * 2048 + 1024 + hh * 128 + 8 * e8_); } } while (0)
#define GLA_PROD1(bufo, RS) do { \
        _Pragma("unroll") for (int x_ = 0; x_ < 2; ++x_) { const int pc_ = pt + 256 * x_, j_ = pc_ >> 4, e8_ = pc_ & 15; \
            *(LAS v4u*)(L + (bufo) + GL_V + j_ * GL_PV + 16 * e8_) = vraw[RS][x_]; *(LAS v4u*)(L + (bufo) + GL_SG + j_ * GL_PSG + 16 * e8_) = graw[RS][x_]; } \
        cs0[0] = la2[RS][0].x; cs1[0] = la2[RS][0].y; \
        _Pragma("unroll") for (int j_ = 1; j_ < 4; ++j_) { cs0[j_] = cs0[j_ - 1] + la2[RS][j_].x; cs1[j_] = cs1[j_ - 1] + la2[RS][j_].y; } \
        *(LAS f32x2_t*)(L + GL_TOT + (jq * 64 + 2 * dp) * 4) = (f32x2_t){cs0[3], cs1[3]}; } while (0)
#define GLA_PROD2(bufo, RS) do { float p0_ = 0.f, p1_ = 0.f, t0_ = 0.f, t1_ = 0.f; \
        _Pragma("unroll") for (int g_ = 0; g_ < 8; ++g_) { const f32x2_t tv_ = *(const LAS f32x2_t*)(L + GL_TOT + (g_ * 64 + 2 * dp) * 4); if (g_ < jq) { p0_ += tv_.x; p1_ += tv_.y; } t0_ += tv_.x; t1_ += tv_.y; } \
        _Pragma("unroll") for (int j_ = 0; j_ < 4; ++j_) { const float c0_ = p0_ + cs0[j_], c1_ = p1_ + cs1[j_]; \
            const float q0_ = bflo(q2[RS][j_]) * __expf(c0_) * 0.125f, q1_ = bfhi(q2[RS][j_]) * __expf(c1_) * 0.125f, k0_ = bflo(k2[RS][j_]) * __expf(-c0_), k1_ = bfhi(k2[RS][j_]) * __expf(-c1_); \
            *(LAS unsigned*)(L + (bufo) + GL_QS + (4 * jq + j_) * GL_PQ + 4 * dp) = cvtpk(q0_, q1_); *(LAS unsigned*)(L + (bufo) + GL_KS + (4 * jq + j_) * GL_PQ + 4 * dp) = cvtpk(k0_, k1_); } \
        if (jq == 0) *(LAS f32x2_t*)(L + (bufo) + GL_EL + 8 * dp) = (f32x2_t){__expf(t0_), __expf(t1_)}; } while (0)

        GLA_LOAD(0, 0); GLA_LOAD(1, 1); GLA_LOAD(2, 2); GLA_LOAD(3, 3); GLA_PROD1(0, 0);
        __syncthreads();
        GLA_PROD2(0, 0);
        __syncthreads();
#define GLA_PITER(n, PAR) do { const int bn = GL_BUF - ((n) & 1) * GL_BUF; \
            if ((n) < 60) GLA_LOAD((n) + 4, PAR); \
            if ((n) < 63) GLA_PROD1(bn, (PAR + 1) & 3); \
            __syncthreads(); \
            if ((n) < 63) GLA_PROD2(bn, (PAR + 1) & 3); \
            __syncthreads(); } while (0)
        for (int nn = 0; nn < 64; nn += 4) { GLA_PITER(nn, 0); GLA_PITER(nn + 1, 1); GLA_PITER(nn + 2, 2); GLA_PITER(nn + 3, 3); }
#undef GLA_PITER
#undef GLA_LOAD
#undef GLA_PROD1
#undef GLA_PROD2
    }
}
constexpr int S5_PBU = 144, S5_PH = 72;
__device__ __forceinline__ float fma_s(float a, float b, float c) { float r; asm("v_fma_f32 %0, %1, %2, %3" : "=v"(r) : "v"(a), "v"(b), "v"(c)); return r; }
constexpr int S5P_ITEM_LDS = 2 * (128 * S5_PBU + 128 * S5_PH);
__device__ __forceinline__ void s5_pipe_block(const Ctx& c, int e, int item0) {
    unsigned char* ws = c.ws; const int lane = c.lane, r32 = lane & 31, h = lane >> 5, wv = c.wave;
    const bf16* P = (const bf16*)(ws + WS_R + R_P); bf16* Z1 = (bf16*)(ws + WS_R + R_Z1);
    const int slot = wv / 3, role = (wv < 6) ? wv - 3 * slot : 3, item = item0 + (slot & 1);
    const int b = item >> 5, g = item & 31, row0 = b * 2048, eg = e * 32 + g;
    LAS unsigned char* BU0 = c.lds + RING_OFF + (slot & 1) * S5P_ITEM_LDS; LAS unsigned char* HB0 = BU0 + 2 * 128 * S5_PBU;
    bf16x8 Bf[4], Cf[8]; float dsk[8]; float ar = 0.f, ai = 0.f, nai = 0.f, hre = 0.f, him = 0.f;
#pragma unroll
    for (int nt = 0; nt < 4; ++nt) Bf[nt] = (bf16x8){0, 0, 0, 0, 0, 0, 0, 0};
#pragma unroll
    for (int s8 = 0; s8 < 8; ++s8) { Cf[s8] = (bf16x8){0, 0, 0, 0, 0, 0, 0, 0}; dsk[s8] = 0.f; }
    if (role == 0) {
#pragma unroll
        for (int nt = 0; nt < 4; ++nt) { const int n = 32 * nt + r32; const float* src = (const float*)(ws + (n < 64 ? CTL_S5BRE : CTL_S5BIM)) + ((size_t)eg * 64 + (n & 63)) * 16 + 8 * h;
            const f32x4 x0 = *(const f32x4*)src, x1 = *(const f32x4*)(src + 4); v4u w; w.x = cvtpk(x0[0], x0[1]); w.y = cvtpk(x0[2], x0[3]); w.z = cvtpk(x1[0], x1[1]); w.w = cvtpk(x1[2], x1[3]); Bf[nt] = __builtin_bit_cast(bf16x8, w); }
    } else if (role == 1) {
        const float* AB = (const float*)(ws + CTL_S5AB); ar = AB[2 * (eg * 64 + lane)]; ai = AB[2 * (eg * 64 + lane) + 1]; nai = -ai;
    } else if (role == 2) {
#pragma unroll
        for (int s8 = 0; s8 < 8; ++s8) { const int n0 = 16 * s8 + 8 * h; v4u w = {0u, 0u, 0u, 0u};
            if (r32 < 16) { const float* src = (n0 < 64 ? c.in[17] : c.in[18]) + ((size_t)eg * 16 + r32) * 64 + (n0 & 63); const float sg = (n0 < 64) ? 1.f : -1.f;
                const f32x4 x0 = *(const f32x4*)src * sg, x1 = *(const f32x4*)(src + 4) * sg; w.x = cvtpk(x0[0], x0[1]); w.y = cvtpk(x0[2], x0[3]); w.z = cvtpk(x1[0], x1[1]); w.w = cvtpk(x1[2], x1[3]); }
            Cf[s8] = __builtin_bit_cast(bf16x8, w); }
#pragma unroll
        for (int r = 0; r < 8; ++r) dsk[r] = c.in[19][eg * 16 + (r & 3) + 8 * (r >> 2) + 4 * h];
    }
    const bf16* up = P + (size_t)row0 * 2048 + 1536 + g * 16 + (size_t)r32 * 2048;
    v4u ucur = {0u, 0u, 0u, 0u}; v2u ua = {0u, 0u}, ub = {0u, 0u};
    if (role == 0) ucur = *(const v4u*)(up + 8 * h);
    for (int step = 0; step < 66; ++step) {
        if (role == 0 && step < 64) {
            const int n = step; LAS unsigned char* BU = BU0 + (n & 1) * 128 * S5_PBU;
            const v4u unext = (n < 63) ? *(const v4u*)(up + 8 * h + (size_t)(n + 1) * 32 * 2048) : ucur;
            const bf16x8 uf = __builtin_bit_cast(bf16x8, ucur);
#pragma unroll
            for (int nt = 0; nt < 4; ++nt) { f32x16 z;
#pragma unroll
                for (int r = 0; r < 16; ++r) z[r] = 0.f;
                const f32x16 d = MFMA32(uf, Bf[nt], z);
#pragma unroll
                for (int q = 0; q < 4; ++q) *(LAS f32x4*)(BU + (32 * nt + r32) * S5_PBU + (8 * q + 4 * h) * 4) = (f32x4){d[4 * q], d[4 * q + 1], d[4 * q + 2], d[4 * q + 3]}; }
            ucur = unext;
        } else if (role == 1 && step >= 1 && step < 65) {
            const int n = step - 1; const LAS unsigned char* BU = BU0 + (n & 1) * 128 * S5_PBU; LAS unsigned char* HB = HB0 + (n & 1) * 128 * S5_PH;
            f32x4 br4[8], bi4[8];
#pragma unroll
            for (int k = 0; k < 8; ++k) { br4[k] = *(const LAS f32x4*)(BU + lane * S5_PBU + 16 * k); bi4[k] = *(const LAS f32x4*)(BU + (64 + lane) * S5_PBU + 16 * k); }
            asm volatile("s_waitcnt lgkmcnt(0)" ::: "memory");
#pragma unroll
            for (int t = 0; t < 32; t += 2) {
                const float a0 = fma_s(ar, hre, br4[t >> 2][t & 3]), a1 = fma_s(ar, him, bi4[t >> 2][t & 3]); const float re0 = fma_s(nai, him, a0), im0 = fma_s(ai, hre, a1);
                const float b0 = fma_s(ar, re0, br4[t >> 2][(t & 3) + 1]), b1 = fma_s(ar, im0, bi4[t >> 2][(t & 3) + 1]); const float re1 = fma_s(nai, im0, b0), im1 = fma_s(ai, re0, b1);
                hre = re1; him = im1;
                *(LAS unsigned*)(HB + lane * S5_PH + 2 * t) = cvtpk(re0, re1); *(LAS unsigned*)(HB + (64 + lane) * S5_PH + 2 * t) = cvtpk(im0, im1); }
        } else if (role == 2) {
            if (step >= 2) {
                const int n = step - 2; const LAS unsigned char* HB = HB0 + (n & 1) * 128 * S5_PH;
                f32x16 y;
#pragma unroll
                for (int r = 0; r < 16; ++r) y[r] = 0.f;
#pragma unroll
                for (int s8 = 0; s8 < 8; ++s8) { const LAS unsigned char* hp = HB + (16 * s8 + 8 * h + ((lane & 15) >> 2)) * S5_PH + (16 * ((lane >> 4) & 1) + 4 * (lane & 3)) * 2;
                    const bf16x8 hb = cat8(trr(hp), trr(hp + 4 * S5_PH)); y = MFMA32(Cf[s8], hb, y); }
                const float u0 = bflo(ua.x), u1 = bfhi(ua.x), u2 = bflo(ua.y), u3 = bfhi(ua.y), u4 = bflo(ub.x), u5 = bfhi(ub.x), u6 = bflo(ub.y), u7 = bfhi(ub.y);
                v2u o0, o1;
                o0.x = cvtpk(gelu_tanh_f(y[0] + dsk[0] * u0), gelu_tanh_f(y[1] + dsk[1] * u1)); o0.y = cvtpk(gelu_tanh_f(y[2] + dsk[2] * u2), gelu_tanh_f(y[3] + dsk[3] * u3));
                o1.x = cvtpk(gelu_tanh_f(y[4] + dsk[4] * u4), gelu_tanh_f(y[5] + dsk[5] * u5)); o1.y = cvtpk(gelu_tanh_f(y[6] + dsk[6] * u6), gelu_tanh_f(y[7] + dsk[7] * u7));
                bf16* zp = Z1 + (size_t)(row0 + 32 * n + r32) * 512 + g * 16 + 4 * h;
                *(v2u*)zp = o0; *(v2u*)(zp + 8) = o1;
            }
            if (step >= 1 && step < 65) { const bf16* q = up + 4 * h + (size_t)(step - 1) * 32 * 2048; ua = *(const v2u*)q; ub = *(const v2u*)(q + 8); }
        }
        __syncthreads();
    }
    if (role == 1) { c.out[OUT_REP + ((size_t)(e * 8 + b) * 32 + g) * 64 + lane] = hre; c.out[OUT_IMP + ((size_t)(e * 8 + b) * 32 + g) * 64 + lane] = him; }
}
__device__ __forceinline__ void even_mixer_v2(const Ctx& c, int e) {
    const int bid = (c.vcu & 31) * 8 + (c.vcu >> 5);
    if (bid < 32) { gla_fast_block(c, e, bid); }
    else if (bid < 160) {
        s5_pipe_block(c, e, (bid - 32) * 2);
    }
    else { for (int bi = bid - 160; bi < 128; bi += 96) { gla_naive_block(c, e, bi * 4, true); __syncthreads(); }
           for (int it = (bid - 160) * 8 + c.wave; it < 4096; it += 96 * 8) s5_naive_wave(c, e, it, true, (LAS float*)(c.lds + RING_OFF) + c.wave * 3200); }
}
typedef float f32x16s __attribute__((ext_vector_type(16)));
__device__ __forceinline__ float sq8(const v4u& w) { float s = 0.f;
#pragma unroll
    for (int q = 0; q < 4; ++q) { const float a = bflo(w[q]), b = bfhi(w[q]); s += a * a + b * b; }
    return s; }
template <int TN, bool NORM_A, class Epi> __device__ __forceinline__ void sgemm2(const Ctx& c, const bf16* A, const bf16* Bt, int N, int K, const Epi& E, int first_tile, int tile_stride, int ld = 0) {
    if (ld == 0) ld = K;
    constexpr int ROWS = 64 + TN, NP = ROWS * 16 / 512, PITCH = 272, BUFB = ROWS * PITCH, NSUB = TN / 32, KPARTS = 4 / NSUB, KSTEPS = 8 / KPARTS;
    const int lane = c.lane, r32 = lane & 31, h = lane >> 5, wv = c.wave, tid = c.tid;
    LAS unsigned char* L = c.lds + RING_OFF;
    const int wm = wv & 1, wn = (NSUB == 2) ? ((wv >> 1) & 1) : 0, kp = (NSUB == 2) ? (wv >> 2) : (wv >> 1);
    const int ntiles = 8 * (N / TN), nch = K / 128;
    for (int tile = first_tile; tile < ntiles; tile += tile_stride) {
        const int rb = tile & 7, cb = tile >> 3;
        const unsigned char* src[NP]; int dst[NP];
#pragma unroll
        for (int i = 0; i < NP; ++i) { const int p = tid + 512 * i, row = p >> 4, c16 = p & 15;
            src[i] = (const unsigned char*)((row < 64) ? A + (size_t)(64 * rb + row) * ld : Bt + (size_t)(TN * cb + row - 64) * ld) + 16 * c16; dst[i] = row * PITCH + 16 * c16; }
        v4u ra[NP], rb_[NP], rc_[NP], rd_[NP];
#pragma unroll
        for (int i = 0; i < NP; ++i) { ra[i] = *(const v4u*)(src[i]); rb_[i] = *(const v4u*)(src[i] + 256); rc_[i] = *(const v4u*)(src[i] + 512); rd_[i] = *(const v4u*)(src[i] + 768); }
#pragma unroll
        for (int i = 0; i < NP; ++i) *(LAS v4u*)(L + dst[i]) = ra[i];
        float ssa0 = 0.f, ssa1 = 0.f;
        if (NORM_A) { ssa0 = sq8(ra[0]); ssa1 = sq8(ra[1]); }
        f32x16s acc;
#pragma unroll
        for (int r = 0; r < 16; ++r) acc[r] = 0.f;
        __syncthreads();
#define SG_STEP(ch, RCUR, RNEXT) do { \
            if ((ch) + 4 < nch) { _Pragma("unroll") for (int i = 0; i < NP; ++i) RCUR[i] = *(const v4u*)(src[i] + (size_t)((ch) + 4) * 256); } \
            { const LAS unsigned char* bufp = L + ((ch) & 1) * BUFB; \
              _Pragma("unroll") for (int s = 0; s < KSTEPS; ++s) { const int ks = kp * KSTEPS + s; \
                  const bf16x8 fa = *(const LAS bf16x8*)(bufp + (32 * wm + r32) * PITCH + 32 * ks + 16 * h), fb = *(const LAS bf16x8*)(bufp + (64 + 32 * wn + r32) * PITCH + 32 * ks + 16 * h); \
                  acc = __builtin_amdgcn_mfma_f32_32x32x16_bf16(fa, fb, acc, 0, 0, 0); } } \
            if ((ch) + 1 < nch) { _Pragma("unroll") for (int i = 0; i < NP; ++i) *(LAS v4u*)(L + (((ch) + 1) & 1) * BUFB + dst[i]) = RNEXT[i]; if (NORM_A) { ssa0 += sq8(RNEXT[0]); ssa1 += sq8(RNEXT[1]); } } \
            __syncthreads(); } while (0)
        for (int ch = 0; ch < nch; ch += 4) { SG_STEP(ch, ra, rb_); SG_STEP(ch + 1, rb_, rc_); SG_STEP(ch + 2, rc_, rd_); SG_STEP(ch + 3, rd_, ra); }
#undef SG_STEP
        LAS float* red = (LAS float*)L;
#pragma unroll
        for (int r = 0; r < 16; ++r) red[wv * 1024 + ((r & 3) + 8 * (r >> 2) + 4 * h) * 32 + r32] = acc[r];
        if (NORM_A) {
#pragma unroll
            for (int o = 1; o < 16; o <<= 1) { ssa0 += __shfl_xor(ssa0, o); ssa1 += __shfl_xor(ssa1, o); }
            if ((tid & 15) == 0) { red[8192 + (tid >> 4)] = ssa0; red[8192 + 32 + (tid >> 4)] = ssa1; } }
        __syncthreads();
        if (tid < 64 * (TN / 8)) {
            const int row = tid / (TN / 8), cg = tid % (TN / 8), sm = row >> 5, sn = (8 * cg) >> 5, rr = row & 31, cc = (8 * cg) & 31;
            f32x4 v0 = {0.f, 0.f, 0.f, 0.f}, v1 = {0.f, 0.f, 0.f, 0.f};
#pragma unroll
            for (int q = 0; q < KPARTS; ++q) { const int w = (NSUB == 2) ? (sm + 2 * sn + 4 * q) : (sm + 2 * q);
                v0 = v0 + *(const LAS f32x4*)(red + w * 1024 + rr * 32 + cc); v1 = v1 + *(const LAS f32x4*)(red + w * 1024 + rr * 32 + cc + 4); }
            const int grow = pg8::TP_ROWS + 64 * rb + row; float s = 0.f;
            const float rs = NORM_A ? rsqrtf(red[8192 + row] * (1.0f / 1024.0f) + pg8::EPS_F) : E.row_scale(grow);
            f32x4 cb0, cb1; E.col8(TN * cb + 8 * cg, cb0, cb1);
            const pg8::u32x4 pre = Epi::HAS_PRE ? E.pre8(grow, TN * cb + 8 * cg) : (pg8::u32x4){0u, 0u, 0u, 0u};
            E.row8(grow, TN * cb + 8 * cg, v0, v1, rs, cb0, cb1, pre, s);
        }
        __syncthreads();
    }
}
constexpr int LR_PX = 272, LR_PAB = 264, LR_WAVE = 32 * LR_PX;
constexpr int LR_COMP = 8 * LR_WAVE;
static_assert(32 * LR_PAB <= LR_WAVE && LR_COMP + 4096 + 16384 <= RING_BYTES, "LRU LDS map");
__device__ __forceinline__ void lru_fused(const Ctx& c, int o) {
    unsigned char* ws = c.ws; const int lane = c.lane, r32 = lane & 31, h = lane >> 5, wv = c.wave;
    const bf16* CIN = (const bf16*)(ws + WS_R + R_CIN); const bf16* GT = (const bf16*)(ws + WS_R + R_XC); bf16* HG = (bf16*)(ws + WS_R + R_MIX);
    const int id = c.vcu, b = id >> 5, n = (id >> 2) & 7, cs = id & 3;
    const int chg = 128 * n + 32 * cs + r32;
    LAS unsigned char* XS = c.lds + RING_OFF + wv * LR_WAVE;
    LAS unsigned char* COMP = c.lds + RING_OFF + LR_COMP;
    const bf16* Wg = (const bf16*)(ws + WS_W + W_G) + ((size_t)o * 8 + n) * 256 * 128;
    LAS unsigned char* WF = c.lds + RING_OFF + LR_COMP + 4096;
#pragma unroll
    for (int i = 0; i < 2; ++i) { const int en = c.tid + 512 * i, rw = en >> 9, sk = (en >> 6) & 7, ln = en & 63;
        *(LAS v4u*)(WF + en * 16) = *(const v4u*)(Wg + (size_t)(rw * 128 + 32 * cs + (ln & 31)) * 128 + 16 * sk + 8 * (ln >> 5)); }
    __syncthreads();
    const float brc = c.in[28][o * 1024 + chg], bic = c.in[30][o * 1024 + chg];
    const float sp8 = 8.0f * log1pf(__expf(-c.in[31][o * 1024 + chg]));
    const int c8 = lane & 15, tq = lane >> 4, cch = 128 * n + 8 * c8;
    const float* cw = c.in[25] + (size_t)o * 4 * 1024 + cch; const float* cb = c.in[26] + o * 1024 + cch;
    float hc = 0.f;
    const int ntile = 8 + ((wv < 2) ? 1 : 0);
    for (int tt = 0; tt < 9; ++tt) {
        const bool sample = tt == 8;
        const bool active = tt < ntile;
        const int st = 2 * b + wv;
        const size_t rowb = sample ? (size_t)TP + 32 * st : (size_t)b * 2048 + 256 * tt + 32 * wv;
        float Aw = 1.f, Bw = 0.f, Ao = 1.f, Bo = 0.f;
        unsigned short gt[16];
        if (active) {
            { const size_t orow_ = rowb + 16 * h;
#pragma unroll
              for (int i = 0; i < 16; ++i) gt[i] = GT[(orow_ + i) * 1024 + chg]; }
            { float w0[8], w1[8], w2[8], w3[8], bs[8];
#pragma unroll
              for (int q = 0; q < 2; ++q) { const f32x4 a0 = *(const f32x4*)(cw + 4 * q), a1 = *(const f32x4*)(cw + 1024 + 4 * q), a2 = *(const f32x4*)(cw + 2048 + 4 * q), a3 = *(const f32x4*)(cw + 3072 + 4 * q), bb = *(const f32x4*)(cb + 4 * q);
#pragma unroll
                  for (int i = 0; i < 4; ++i) { w0[4 * q + i] = a0[i]; w1[4 * q + i] = a1[i]; w2[4 * q + i] = a2[i]; w3[4 * q + i] = a3[i]; bs[4 * q + i] = bb[i]; } }
              if (!sample) {
                  v4u xr[11];
#pragma unroll
                  for (int i = 0; i < 11; ++i) { const int tl = 8 * tq + i - 3; xr[i] = (v4u){0u, 0u, 0u, 0u};
                      if (256 * tt + 32 * wv + tl >= 0) xr[i] = *(const v4u*)(CIN + (size_t)((long)rowb + tl) * 1024 + cch); }
#pragma unroll
                  for (int i = 0; i < 8; ++i) { float y[8];
#pragma unroll
                      for (int q = 0; q < 4; ++q) {
                          y[2 * q] = bs[2 * q] + w0[2 * q] * bflo(xr[i][q]) + w1[2 * q] * bflo(xr[i + 1][q]) + w2[2 * q] * bflo(xr[i + 2][q]) + w3[2 * q] * bflo(xr[i + 3][q]);
                          y[2 * q + 1] = bs[2 * q + 1] + w0[2 * q + 1] * bfhi(xr[i][q]) + w1[2 * q + 1] * bfhi(xr[i + 1][q]) + w2[2 * q + 1] * bfhi(xr[i + 2][q]) + w3[2 * q + 1] * bfhi(xr[i + 3][q]); }
                      v4u ov; ov.x = cvtpk(y[0], y[1]); ov.y = cvtpk(y[2], y[3]); ov.z = cvtpk(y[4], y[5]); ov.w = cvtpk(y[6], y[7]);
                      *(LAS v4u*)(XS + (8 * tq + i) * LR_PX + 16 * c8) = ov; }
              } else {
#pragma unroll 1
                  for (int i = 0; i < 8; ++i) {
                      const int bt = 8 * st + 2 * tq + (i >> 2), stp = i & 3; const float* sc = c.in[6] + ((size_t)o * 128 + bt) * 3 * 1024 + cch;
                      float y[8];
#pragma unroll
                      for (int q = 0; q < 8; ++q) y[q] = bs[q];
#pragma unroll
                      for (int j = 0; j < 4; ++j) { const int sj = stp - 3 + j; float x[8];
                          if (sj >= 0) { const v4u x4 = *(const v4u*)(CIN + (rowb + 8 * tq + i - 3 + j) * 1024 + cch);
#pragma unroll
                              for (int q = 0; q < 4; ++q) { x[2 * q] = bflo(x4[q]); x[2 * q + 1] = bfhi(x4[q]); } }
                          else { const f32x4 s0 = *(const f32x4*)(sc + (size_t)(sj + 3) * 1024), s1 = *(const f32x4*)(sc + (size_t)(sj + 3) * 1024 + 4);
#pragma unroll
                              for (int q = 0; q < 4; ++q) { x[q] = s0[q]; x[4 + q] = s1[q]; } }
#pragma unroll
                          for (int q = 0; q < 8; ++q) y[q] += ((j == 0) ? w0[q] : (j == 1) ? w1[q] : (j == 2) ? w2[q] : w3[q]) * x[q]; }
                      v4u ov; ov.x = cvtpk(y[0], y[1]); ov.y = cvtpk(y[2], y[3]); ov.z = cvtpk(y[4], y[5]); ov.w = cvtpk(y[6], y[7]);
                      *(LAS v4u*)(XS + (8 * tq + i) * LR_PX + 16 * c8) = ov; }
              }
            }
            f32x16 accr, acci;
#pragma unroll
            for (int r = 0; r < 16; ++r) { accr[r] = 0.f; acci[r] = 0.f; }
#pragma unroll
            for (int s = 0; s < 8; ++s) { const bf16x8 xa = *(const LAS bf16x8*)(XS + r32 * LR_PX + 32 * s + 16 * h); accr = MFMA32(xa, *(const LAS bf16x8*)(WF + (s * 64 + lane) * 16), accr); acci = MFMA32(xa, *(const LAS bf16x8*)(WF + ((8 + s) * 64 + lane) * 16), acci); }
            float xv[16];
#pragma unroll
            for (int r = 0; r < 16; ++r) xv[r] = bf2f(*(const LAS bf16*)(XS + ((r & 3) + 8 * (r >> 2) + 4 * h) * LR_PX + (32 * cs + r32) * 2));
            asm volatile("s_waitcnt lgkmcnt(0)" ::: "memory");
#pragma unroll
            for (int r = 0; r < 16; ++r) {
                const float rg = sigmoid_f(accr[r] + brc), ig = sigmoid_f(acci[r] + bic);
                const float la = -rg * sp8, a = __expf(la);
                const float bq = __builtin_amdgcn_sqrtf(fmaxf(1.0f - a * a, 0.f)) * ig * xv[r];
                *(LAS f32x2_t*)(XS + ((r & 3) + 8 * (r >> 2) + 4 * h) * LR_PAB + 8 * r32) = (f32x2_t){a, bq};
            }
            asm volatile("s_waitcnt lgkmcnt(0)" ::: "memory");
            if (!sample) {
                float A = 1.f, B = 0.f;
#pragma unroll
                for (int i = 0; i < 16; ++i) { const f32x2_t ab = *(const LAS f32x2_t*)(XS + (16 * h + i) * LR_PAB + 8 * r32); A *= ab.x; B = ab.x * B + ab.y; }
                Ao = __shfl_xor(A, 32); Bo = __shfl_xor(B, 32);
                Aw = A * Ao; Bw = h ? (A * Bo + B) : (Ao * B + Bo);
                if (h == 0) *(LAS f32x2_t*)(COMP + ((tt & 1) * 256 + wv * 32 + r32) * 8) = (f32x2_t){Aw, Bw};
            }
        }
        __syncthreads();
        if (active) {
            float hin;
            if (!sample) {
                float hrun = hc; hin = hc;
#pragma unroll
                for (int w = 0; w < 8; ++w) { const f32x2_t cp = *(const LAS f32x2_t*)(COMP + ((tt & 1) * 256 + w * 32 + r32) * 8); if (w == wv) hin = hrun; hrun = cp.x * hrun + cp.y; }
                hc = hrun;
                if (h) hin = Ao * hin + Bo;
            } else hin = 0.f;
            const size_t orow = rowb + 16 * h;
            float hh = hin;
#pragma unroll
            for (int i = 0; i < 16; ++i) {
                if (sample && (i & 3) == 0) hh = c.in[5][((size_t)o * 128 + 8 * st + 4 * h + (i >> 2)) * 1024 + chg];
                const f32x2_t ab = *(const LAS f32x2_t*)(XS + (16 * h + i) * LR_PAB + 8 * r32);
                hh = ab.x * hh + ab.y;
                HG[(orow + i) * 1024 + chg] = (bf16)cvtpk(bf2f(gt[i]) * hh, 0.f);
                if (sample && (i & 3) == 3) c.out[OUT_LRUS + ((size_t)o * 128 + 8 * st + 4 * h + (i >> 2)) * 1024 + chg] = hh;
            }
            asm volatile("s_waitcnt lgkmcnt(0)" ::: "memory");
        }
    }
    if (wv == 0 && h == 0) c.out[OUT_LRUP + ((size_t)o * 8 + b) * 1024 + chg] = hc;
}
typedef float f32x4g __attribute__((ext_vector_type(4)));
__device__ __forceinline__ void gate_job(const Ctx& c, int e, const float* ssq, int first_tile, int tile_stride) {
    unsigned char* ws = c.ws; const int lane = c.lane, wv = c.wave, l15 = lane & 15, quad = lane >> 4, r32 = lane & 31, h = lane >> 5;
    const bf16* XB = (const bf16*)(ws + WS_XB); float* LA = (float*)(ws + WS_R + R_LA);
    const bf16* WaT = (const bf16*)(ws + WS_WA) + (size_t)e * 16 * 1024;
    const bf16* A2T = (const bf16*)(ws + WS_WA) + 2 * 16 * 1024 + (size_t)e * 256 * 16;
    const float* b_a2 = c.in[10] + e * 256;
    LAS float* part = (LAS float*)(c.lds + RING_OFF);
    LAS bf16* alr = (LAS bf16*)(c.lds + RING_OFF + 32768);
    LAS float* pss = (LAS float*)(c.lds + RING_OFF + 32768 + 2048);
    for (int tile = first_tile; tile < T / 64; tile += tile_stride) {
        const int rowb = 64 * tile;
        bf16x8 bw[4];
#pragma unroll
        for (int s = 0; s < 4; ++s) bw[s] = *(const bf16x8*)(WaT + (size_t)l15 * 1024 + 128 * wv + 32 * s + 8 * quad);
        f32x4g acc[4];
#pragma unroll
        for (int mt = 0; mt < 4; ++mt) { acc[mt] = (f32x4g){0.f, 0.f, 0.f, 0.f};
            bf16x8 xa[4];
#pragma unroll
            for (int s = 0; s < 4; ++s) xa[s] = *(const bf16x8*)(XB + (size_t)(rowb + 16 * mt + l15) * 1024 + 128 * wv + 32 * s + 8 * quad);
#pragma unroll
            for (int s = 0; s < 4; ++s) acc[mt] = __builtin_amdgcn_mfma_f32_16x16x32_bf16(bw[s], xa[s], acc[mt], 0, 0, 0);
            float sq = 0.f;
#pragma unroll
            for (int s = 0; s < 4; ++s) { const v4u w4 = __builtin_bit_cast(v4u, xa[s]);
#pragma unroll
                for (int q = 0; q < 4; ++q) { const float a = bflo(w4[q]), b = bfhi(w4[q]); sq += a * a + b * b; } }
            sq += __shfl_xor(sq, 16); sq += __shfl_xor(sq, 32);
            if (quad == 0) pss[wv * 64 + 16 * mt + l15] = sq; }
#pragma unroll
        for (int mt = 0; mt < 4; ++mt)
#pragma unroll
            for (int q = 0; q < 4; ++q) part[wv * 1024 + (16 * mt + l15) * 16 + 4 * quad + q] = acc[mt][q];
        __syncthreads();
#pragma unroll
        for (int i = 0; i < 2; ++i) { const int idx = c.tid + 512 * i, row = idx >> 4; float s = 0.f;
#pragma unroll
            for (int w = 0; w < 8; ++w) s += part[w * 1024 + idx];
            float sq = 0.f;
#pragma unroll
            for (int w = 0; w < 8; ++w) sq += pss[w * 64 + row];
            const float rs = rsqrtf(sq * (1.0f / 1024.0f) + EPS);
            alr[idx] = (bf16)f2bf(s * rs); }
        __syncthreads();
        { const int rh = wv & 1;
          v4u aw = *(const LAS v4u*)(alr + (32 * rh + r32) * 16 + 8 * h); const bf16x8 af = __builtin_bit_cast(bf16x8, aw);
#pragma unroll
          for (int ct = 0; ct < 2; ++ct) { const int n = 32 * (2 * (wv >> 1) + ct) + r32;
              const bf16x8 bf = *(const bf16x8*)(A2T + (size_t)n * 16 + 8 * h);
              f32x16 z;
#pragma unroll
              for (int r = 0; r < 16; ++r) z[r] = 0.f;
              const f32x16 d = MFMA32(af, bf, z);
              const float bn = b_a2[n];
#pragma unroll
              for (int r = 0; r < 16; ++r) { const int row = rowb + 32 * rh + (r & 3) + 8 * (r >> 2) + 4 * h;
                  LA[(size_t)row * 256 + n] = pg8::logsigmoid_f(d[r] + bn) * 0.0625f; } } }
        __syncthreads();
    }
}
#ifndef REP_PROL
#define REP_PROL 1
#endif
#ifndef REP_IN
#define REP_IN 1
#endif
#ifndef REP_EMIX
#define REP_EMIX 1
#endif
#ifndef REP_GLU
#define REP_GLU 1
#endif
#ifndef REP_CONV
#define REP_CONV 1
#endif
#ifndef REP_GATES
#define REP_GATES 1
#endif
#ifndef REP_UP
#define REP_UP 1
#endif
#ifndef REP_LRU
#define REP_LRU 1
#endif
constexpr int N_PHASES = 24;
__global__ void __launch_bounds__(NWAVES * 64, 2) mk_fwd(Args args) {
    extern __shared__ __attribute__((aligned(16))) unsigned char lds_raw[];
    const int wave_s_ = __builtin_amdgcn_readfirstlane((int)threadIdx.x >> 6);
#define TID_NOW(var) int var; { int l_; asm volatile("v_mbcnt_lo_u32_b32 %0, -1, 0\n\tv_mbcnt_hi_u32_b32 %0, -1, %0" : "=v"(l_)); var = (wave_s_ << 6) | l_; }
    const int lo = args.ph_lo, hi = args.ph_hi;
    {
        LAS unsigned char* l0 = (LAS unsigned char*)lds_raw;
        TID_NOW(t0_)
        for (int u = t0_; u < (LDS_BYTES - LDSCTL_OFF) / 4; u += NWAVES * 64) ((LAS unsigned*)(l0 + LDSCTL_OFF))[u] = 0u;
        __syncthreads();
    }
    XcdBarrier bar; bar.bar = (unsigned*)(args.ws + WS_CTL) + CW_BAR + args.li * XCD_BAR_WORDS; bar.x = 0; bar.st = nullptr;
    TID_NOW(t0b_)
    if (hi - lo > 1) bar = xcd_barrier_post((unsigned*)(args.ws + WS_CTL) + CW_BAR + args.li * XCD_BAR_WORDS, (volatile LAS unsigned*)((LAS unsigned char*)lds_raw + MISC_OFF) + 8, t0b_);
    int pc = 0;
#define PHASE_BEGINR(R) { int pc_ = pc; asm volatile("" : "+s"(pc_)); if (pc_ >= lo && pc_ < hi) { for (int rep_ = 0; rep_ < (R); ++rep_) { if (rep_) __syncthreads(); unsigned char* wsr_ = args.ws; asm volatile("" : "+s"(wsr_)); unsigned char* ws = as_global(wsr_); float* outr_ = args.out; asm volatile("" : "+s"(outr_)); float* out_ = as_global(outr_); \
    TID_NOW(t_) int bx = blockIdx.x; asm volatile("" : "+s"(bx)); int G_ = gridDim.x; asm volatile("" : "+s"(G_)); \
    Ctx c; c.var = args.pad; c.in.p = args.in; c.out = out_; c.ws = ws; c.lds = (LAS unsigned char*)lds_raw; c.tid = t_; c.lane = c.tid & 63; c.wave = __builtin_amdgcn_readfirstlane(c.tid >> 6); \
    c.G = G_; c.vcu = (c.G % 8 == 0) ? (bx % 8) * (c.G / 8) + bx / 8 : bx; c.gw = c.vcu * NWAVES + c.wave; c.NGW = c.G * NWAVES; \
    PG8_LAS unsigned char* ring = (PG8_LAS unsigned char*)(c.lds + RING_OFF); (void)ring; \
    bf16* XB = (bf16*)(ws + WS_XB); float* X = c.out; float* ssq = (float*)(ws + WS_SSQ); bf16* MIX = (bf16*)(ws + WS_R + R_MIX); (void)XB; (void)X; (void)ssq; (void)MIX;
#define PHASE_BEGIN PHASE_BEGINR(1)
#define PHASE_END   } if (pc_ + 1 < hi) { TID_NOW(tb_) xcd_barrier(bar, tb_); } } } ++pc;

    PHASE_BEGINR(REP_PROL) p0_prologue(c); PHASE_END

    for (int l = 0; l < 4; ++l) {
        const int hf = l >> 1;
        if ((l & 1) == 0) {
            PHASE_BEGINR(REP_IN)
                const bf16* wt = (const bf16*)(ws + WS_W + W_INE) + (size_t)hf * NIN_E * 1024; pg8::Gemm g{XB, wt, TP, 2048, 1024, 1024}; pg8::StaticOrder S; S.init(TP, 2048, c.G, bx);
                pg8::EpiInE E{(bf16*)(ws + WS_R + R_P), ssq + (size_t)(2 * l) * 4 * T};
                if (bx & 1) { if (l == 0) p0_weights_rest(c); gate_job(c, hf, ssq + (size_t)(2 * l) * 4 * T, bx, c.G); sgemm2<64, true>(c, XB + (size_t)TP * 1024, wt, 2048, 1024, E, bx, c.G); pg8::gemm_phase<pg8::EpiInE, pg8::StaticOrder, true, true>(ring, g, S, E, c.tid); }
                else { pg8::gemm_phase<pg8::EpiInE, pg8::StaticOrder, true, true>(ring, g, S, E, c.tid); sgemm2<64, true>(c, XB + (size_t)TP * 1024, wt, 2048, 1024, E, bx, c.G); gate_job(c, hf, ssq + (size_t)(2 * l) * 4 * T, bx, c.G); if (l == 0) p0_weights_rest(c); }
            PHASE_END
            PHASE_BEGINR(REP_EMIX) even_mixer_v2(c, hf); PHASE_END
            PHASE_BEGINR(REP_GLU)
                gla_post(c, hf);
                bf16* Z1 = (bf16*)(ws + WS_R + R_Z1); const bf16* wt = (const bf16*)(ws + WS_W + W_GLU) + (size_t)hf * 512 * 512; pg8::Gemm g{Z1, wt, TP, 512, 512, 512}; pg8::StaticOrder S; S.init(TP, 512, c.G, bx);
                pg8::EpiGlu E{Z1, MIX, c.in[21] + hf * 512};
                if (bx & 1) { sgemm2<32, false>(c, Z1 + (size_t)TP * 512, wt, 512, 512, E, bx >= 128 ? bx - 128 : (1 << 30), c.G - 128); pg8::gemm_phase<pg8::EpiGlu, pg8::StaticOrder, true, true>(ring, g, S, E, c.tid); }
                else { pg8::gemm_phase<pg8::EpiGlu, pg8::StaticOrder, true, true>(ring, g, S, E, c.tid); sgemm2<32, false>(c, Z1 + (size_t)TP * 512, wt, 512, 512, E, bx >= 128 ? bx - 128 : (1 << 30), c.G - 128); }
            PHASE_END
        } else {
            PHASE_BEGINR(REP_IN)
                const bf16* wt = (const bf16*)(ws + WS_W + W_INO) + (size_t)hf * NIN_O * 1024; pg8::Gemm g{XB, wt, TP, NIN_O, 1024, 1024}; pg8::StaticOrder S; S.init(TP, NIN_O, c.G, bx);
                pg8::EpiInO E{(bf16*)(ws + WS_R + R_XC), (bf16*)(ws + WS_R + R_CIN), ssq + (size_t)(2 * l) * 4 * T, c.out + OUT_CONVP + (size_t)hf * 8 * 3 * 1024, c.out + OUT_CONVS + (size_t)hf * 128 * 3 * 1024};
                if (bx & 1) { sgemm2<64, true>(c, XB + (size_t)TP * 1024, wt, NIN_O, 1024, E, bx, c.G); pg8::gemm_phase<pg8::EpiInO, pg8::StaticOrder, true, true>(ring, g, S, E, c.tid); }
                else { pg8::gemm_phase<pg8::EpiInO, pg8::StaticOrder, true, true>(ring, g, S, E, c.tid); sgemm2<64, true>(c, XB + (size_t)TP * 1024, wt, NIN_O, 1024, E, bx, c.G); }
            PHASE_END
            PHASE_BEGINR(REP_LRU) lru_fused(c, hf); PHASE_END
        }
        PHASE_BEGIN
            const bf16* wo = (l & 1) ? (const bf16*)(ws + WS_W + W_OUTO) + (size_t)hf * 1024 * 1024 : (const bf16*)(ws + WS_W + W_OUTE) + (size_t)hf * 1024 * 1024;
            pg8::Gemm g{MIX, wo, TP, 1024, 1024, 1024}; pg8::StaticOrder S; S.init(TP, 1024, c.G, bx);
            pg8::EpiRes E{XB, ssq + (size_t)(2 * l + 1) * 4 * T};
            if (bx & 1) { sgemm2<32, false>(c, MIX + (size_t)TP * 1024, wo, 1024, 1024, E, bx, c.G); pg8::gemm_phase<pg8::EpiRes, pg8::StaticOrder, false, true>(ring, g, S, E, c.tid); }
            else { pg8::gemm_phase<pg8::EpiRes, pg8::StaticOrder, false, true>(ring, g, S, E, c.tid); sgemm2<32, false>(c, MIX + (size_t)TP * 1024, wo, 1024, 1024, E, bx, c.G); }
        PHASE_END
        PHASE_BEGINR(REP_UP)
            const bf16* wt = (const bf16*)(ws + WS_W + W_UP) + (size_t)l * 4096 * 1024; pg8::Gemm g{XB, wt, TP, FF, 1024, 1024}; pg8::StaticOrder S; S.init(TP, FF, c.G, bx);
            pg8::EpiUp E{(bf16*)(ws + WS_R + R_H), ssq + (size_t)(2 * l + 1) * 4 * T};
            if (bx & 1) { sgemm2<64, true>(c, XB + (size_t)TP * 1024, wt, FF, 1024, E, bx, c.G); pg8::gemm_phase<pg8::EpiUp, pg8::StaticOrder, true, true>(ring, g, S, E, c.tid); }
            else { pg8::gemm_phase<pg8::EpiUp, pg8::StaticOrder, true, true>(ring, g, S, E, c.tid); sgemm2<64, true>(c, XB + (size_t)TP * 1024, wt, FF, 1024, E, bx, c.G); }
        PHASE_END
        PHASE_BEGIN
            const bf16* wt = (const bf16*)(ws + WS_W + W_DN) + (size_t)l * 1024 * LD_FF; pg8::Gemm g{(bf16*)(ws + WS_R + R_H), wt, TP, 1024, FF, LD_FF}; pg8::StaticOrder S; S.init(TP, 1024, c.G, bx);
            pg8::EpiRes E{XB, ssq + (size_t)(2 * l + 2) * 4 * T};
            if (bx & 1) { sgemm2<32, false>(c, (const bf16*)(ws + WS_R + R_H) + (size_t)TP * LD_FF, wt, 1024, FF, E, bx, c.G, LD_FF); pg8::gemm_phase<pg8::EpiRes, pg8::StaticOrder, false, true>(ring, g, S, E, c.tid); }
            else { pg8::gemm_phase<pg8::EpiRes, pg8::StaticOrder, false, true>(ring, g, S, E, c.tid); sgemm2<32, false>(c, (const bf16*)(ws + WS_R + R_H) + (size_t)TP * LD_FF, wt, 1024, FF, E, bx, c.G, LD_FF); }
        PHASE_END
    }
    PHASE_BEGINR(1) final_norm(c); PHASE_END
#undef PHASE_BEGIN
#undef PHASE_BEGINR
#undef PHASE_END
}

#ifndef MK_N_LAUNCHES
#define MK_N_LAUNCHES 1
#endif
extern "C" void kernel_launch(void* const* d_in, const int* in_sizes, int n_in, void* d_out, int out_size, void* d_ws, size_t ws_size, hipStream_t stream) {
    static int grid = 0;
    if (grid == 0) {
        if (n_in != 37 || out_size != (int)OUT_END || ws_size < WS_END) { fprintf(stderr, "kernel_launch: shape mismatch (n_in %d out %d ws %zu)\n", n_in, out_size, ws_size); grid = -1; return; }
        int dev = 0, cus = 0;
        if (hipGetDevice(&dev) != hipSuccess || hipDeviceGetAttribute(&cus, hipDeviceAttributeMultiprocessorCount, dev) != hipSuccess) { grid = -1; return; }
        if (hipFuncSetAttribute((const void*)mk_fwd, hipFuncAttributeMaxDynamicSharedMemorySize, LDS_BYTES) != hipSuccess) { fprintf(stderr, "kernel_launch: hipFuncSetAttribute failed\n"); grid = -1; return; }
        int per_cu = 0;
        if (hipOccupancyMaxActiveBlocksPerMultiprocessor(&per_cu, (const void*)mk_fwd, NWAVES * 64, LDS_BYTES) != hipSuccess || per_cu < 1) fprintf(stderr, "kernel_launch: occupancy query says %d\n", per_cu);
        (void)hipGetLastError();
        grid = cus;
        if (grid != 256) fprintf(stderr, "kernel_launch: %d CUs; this kernel's static work split assumes 256\n", grid);
    }
    if (grid < 0) return;
    if (hipMemsetAsync((char*)d_ws + WS_CTL, 0, CTL_ZERO_BYTES, stream) != hipSuccess) return;
    Args a{};
    for (int i = 0; i < 37; ++i) a.in[i] = (const float*)d_in[i];
    a.out = (float*)d_out; a.ws = (unsigned char*)d_ws;
    if (MK_N_LAUNCHES == 1) { a.ph_lo = 0; a.ph_hi = N_PHASES; hipLaunchKernelGGL(mk_fwd, dim3(grid), dim3(NWAVES * 64), LDS_BYTES, stream, a); }
    else { for (int p = 0; p < N_PHASES; ++p) { a.ph_lo = p; a.ph_hi = p + 1; hipLaunchKernelGGL(mk_fwd, dim3(grid), dim3(NWAVES * 64), LDS_BYTES, stream, a); } }
}
```

```cpp
#include <hip/hip_runtime.h>
#include <cstdio>
#include <cstdint>
namespace pg8 {
#define PG8_LAS __attribute__((address_space(3)))
typedef unsigned short bf16_t;
typedef short bf16x8 __attribute__((ext_vector_type(8)));
typedef float f32x4 __attribute__((ext_vector_type(4)));
typedef unsigned u32x4 __attribute__((ext_vector_type(4)));
constexpr int BM = 256, BK = 64, HALF = 128, HTB = HALF * BK * 2  , STAGE_BYTES = 8 * HTB, NXCD = 8, WGM = 8;

__host__ __device__ __forceinline__ int lds_byte(int r, int c) { const int st = (r >> 4) * 2 + (c >> 5), rr = r & 15, cc = c & 31, ob = rr * 64 + cc * 2; return st * 1024 + (ob ^ (((ob >> 9) & 1) << 5)); }
__host__ __device__ __forceinline__ void stage_rc(int b, int& R, int& C) { const int st = b / 1024, sb = b % 1024, swz = sb ^ (((sb >> 9) & 1) << 5); R = (st >> 1) * 16 + swz / 64; C = (st & 1) * 32 + (swz % 64) / 2; }
__host__ __device__ __forceinline__ int perm32(int rho) { const int n = rho >> 4, i = rho & 15; return 8 * (i >> 2) + 4 * n + (i & 3); }

struct Unit { int pm, pn; };
struct Gemm { const bf16_t* A; const bf16_t* Bt; int M, N, K, ld; };

struct StaticOrder {
    int nM, nN, nwg, G, c;
    __host__ __device__ void init(int M, int N, int G_, int c_) { nM = M / BM; nN = N / BM; nwg = nM * nN; G = G_; c = c_; }
    __host__ __device__ bool next(int i, Unit& u) const {
        const long L = (long)i * G + c; if (L >= nwg) return false;
        int wgid = (int)L; { const int q = nwg / NXCD, r = nwg % NXCD, xcd = wgid % NXCD, off = wgid / NXCD; wgid = (xcd < r ? xcd * (q + 1) : r * (q + 1) + (xcd - r) * q) + off; }
        const int nig = WGM * nN, gid = wgid / nig, fm = gid * WGM, gsz = (nM - fm) < WGM ? (nM - fm) : WGM;
        u.pm = fm + ((wgid % nig) % gsz); u.pn = (wgid % nig) / gsz; return true;
    }
    __device__ __forceinline__ void a_ready(const Unit&) const {}
    __device__ __forceinline__ void done(const Unit&) const {}
};

__device__ __forceinline__ unsigned cvt_pk_bf16(float lo, float hi) { unsigned r; asm volatile("v_cvt_pk_bf16_f32 %0, %1, %2" : "=v"(r) : "v"(lo), "v"(hi)); return r; }
template <class Epi, class Sched, bool ALIGN_EPI = false, bool SP2 = false>
__device__ __forceinline__ void gemm_phase(PG8_LAS unsigned char* lds, const Gemm g, const Sched& S, const Epi& E, int tid_in) {
    int tid_ = tid_in; asm volatile("" : "+v"(tid_));
    const int tid = tid_, wid = __builtin_amdgcn_readfirstlane(tid >> 6), lane = tid & 63, wr = wid >> 2, wc = wid & 3, fr = lane & 15, fq = lane >> 4;
    const int K = g.K, nt = K / BK, LD = g.ld;
    unsigned voffA[2], voffB[2];
#pragma unroll
    for (int i = 0; i < 2; ++i) { int R, C; stage_rc(tid * 16 + i * 8192, R, C); const int Rb = Epi::PERM ? ((R & ~31) + perm32(R & 31)) : R;
        voffA[i] = (unsigned)(R * LD + C) * 2u; voffB[i] = (unsigned)(Rb * LD + C) * 2u; }
    const size_t kstep = (size_t)(BK * 2);
    const size_t hstep = (size_t)HALF * LD * 2;
    const size_t tstep = 2 * hstep;
    const unsigned ldsw = (unsigned)wid * 1024u;
    const int aoff = lds_byte(wr * 64 + fr, fq * 8), boff = lds_byte(wc * 32 + fr, fq * 8);
#define PG8_SA(b, h) (((b) * 2 + (h)) * HTB)
#define PG8_SB(b, h) ((4 + (b) * 2 + (h)) * HTB)
#define PG8_STAGE(bufoff, gbase, voff) do { _Pragma("unroll") for (int _i = 0; _i < 2; ++_i) \
        __builtin_amdgcn_global_load_lds((const unsigned*)((const char*)(gbase) + (voff)[_i]), (PG8_LAS unsigned*)(lds + (bufoff) + ldsw + _i * 8192), 16, 0, 0); } while (0)
#define PG8_LDA(dst, b, h) do { _Pragma("unroll") for (int m = 0; m < 4; ++m) _Pragma("unroll") for (int k = 0; k < 2; ++k) dst[m][k] = *(const PG8_LAS bf16x8*)(lds + PG8_SA(b, h) + aoff + m * 2048 + k * 1024); } while (0)
#define PG8_LDB(dst, b, h) do { _Pragma("unroll") for (int n = 0; n < 2; ++n) _Pragma("unroll") for (int k = 0; k < 2; ++k) dst[n][k] = *(const PG8_LAS bf16x8*)(lds + PG8_SB(b, h) + boff + n * 2048 + k * 1024); } while (0)
#define PG8_MMA(ai, bj, At, Bt) do { __builtin_amdgcn_s_setprio(1); _Pragma("unroll") for (int m = 0; m < 4; ++m) _Pragma("unroll") for (int n = 0; n < 2; ++n) _Pragma("unroll") for (int k = 0; k < 2; ++k) \
        acc[ai][bj][m][n] = __builtin_amdgcn_mfma_f32_16x16x32_bf16(Bt[n][k], At[m][k], acc[ai][bj][m][n], 0, 0, 0); __builtin_amdgcn_s_setprio(0); } while (0)
#define PG8_WAIT_V(n) asm volatile("s_waitcnt vmcnt(" #n ")" ::: "memory")
#define PG8_WAIT_L(n) asm volatile("s_waitcnt lgkmcnt(" #n ")" ::: "memory")
#define PG8_BAR __builtin_amdgcn_s_barrier()
#define PG8_SCHED __builtin_amdgcn_sched_barrier(0)
    Unit cur, nxt; int ui = 0;
    if (!S.next(0, cur)) return;
    f32x4 acc[2][2][4][2];
#pragma unroll
    for (int a = 0; a < 2; ++a)
#pragma unroll
        for (int b = 0; b < 2; ++b)
#pragma unroll
            for (int m = 0; m < 4; ++m)
#pragma unroll
                for (int n = 0; n < 2; ++n) acc[a][b][m][n] = (f32x4){0.f, 0.f, 0.f, 0.f};
    bf16x8 At[4][2], B0[2][2], B1[2][2];
    const char* cA = (const char*)g.A + (size_t)cur.pm * tstep; const char* cB = (const char*)g.Bt + (size_t)cur.pn * tstep;
    S.a_ready(cur);
    if constexpr (SP2) {
        PG8_STAGE(PG8_SB(0, 0), cB, voffB); PG8_STAGE(PG8_SB(0, 1), cB + hstep, voffB); PG8_STAGE(PG8_SA(0, 0), cA, voffA); PG8_STAGE(PG8_SA(0, 1), cA + hstep, voffA);
        if (wr == 1) PG8_BAR;
        PG8_WAIT_V(2); PG8_BAR;
        PG8_STAGE(PG8_SB(1, 0), cB + kstep, voffB); PG8_STAGE(PG8_SA(1, 0), cA + kstep, voffA); PG8_STAGE(PG8_SB(1, 1), cB + hstep + kstep, voffB);
        PG8_WAIT_V(6); PG8_BAR;
    } else {
        PG8_STAGE(PG8_SB(0, 0), cB, voffB); PG8_STAGE(PG8_SA(0, 0), cA, voffA); PG8_STAGE(PG8_SB(0, 1), cB + hstep, voffB); PG8_STAGE(PG8_SA(0, 1), cA + hstep, voffA);
        if (wr == 1) PG8_BAR;
        PG8_WAIT_V(4); PG8_BAR;
        PG8_STAGE(PG8_SB(1, 0), cB + kstep, voffB); PG8_STAGE(PG8_SA(1, 0), cA + kstep, voffA); PG8_STAGE(PG8_SB(1, 1), cB + hstep + kstep, voffB);
        PG8_WAIT_V(6); PG8_BAR;
    }
    for (;;) {
        const bool has_next = S.next(ui + 1, nxt);
        const char* nA = has_next ? (const char*)g.A + (size_t)nxt.pm * tstep : cA; const char* nB = has_next ? (const char*)g.Bt + (size_t)nxt.pn * tstep : cB;
        for (int t = 0; t < nt; t += 2) {
            const bool last = (t == nt - 2);
            const char* a1 = cA + (size_t)(t + 1) * kstep;
            const char* a2 = last ? nA : cA + (size_t)(t + 2) * kstep; const char* b2 = last ? nB : cB + (size_t)(t + 2) * kstep;
            const char* a3 = a2 + kstep; const char* b3 = b2 + kstep;
            if (last && has_next) S.a_ready(nxt);
            if constexpr (SP2) {
            PG8_LDB(B0, 0, 0); PG8_LDB(B1, 0, 1); PG8_SCHED; PG8_LDA(At, 0, 0); PG8_STAGE(PG8_SA(1, 1), a1 + hstep, voffA);
            PG8_WAIT_V(8); PG8_WAIT_L(0); PG8_BAR; PG8_MMA(0, 0, At, B0); PG8_MMA(0, 1, At, B1); PG8_BAR; PG8_SCHED;
            PG8_LDA(At, 0, 1); PG8_STAGE(PG8_SB(0, 0), b2, voffB); PG8_STAGE(PG8_SB(0, 1), b2 + hstep, voffB); PG8_STAGE(PG8_SA(0, 0), a2, voffA);
            PG8_WAIT_V(8); PG8_WAIT_L(0); PG8_BAR; PG8_MMA(1, 0, At, B0); PG8_MMA(1, 1, At, B1); PG8_BAR; PG8_SCHED;
            PG8_LDB(B0, 1, 0); PG8_LDB(B1, 1, 1); PG8_SCHED; PG8_LDA(At, 1, 0); PG8_STAGE(PG8_SA(0, 1), a2 + hstep, voffA);
            PG8_WAIT_V(8); PG8_WAIT_L(0); PG8_BAR; PG8_MMA(0, 0, At, B0); PG8_MMA(0, 1, At, B1); PG8_BAR; PG8_SCHED;
            PG8_LDA(At, 1, 1); PG8_STAGE(PG8_SB(1, 0), b3, voffB); PG8_STAGE(PG8_SB(1, 1), b3 + hstep, voffB); PG8_STAGE(PG8_SA(1, 0), a3, voffA);
            PG8_WAIT_V(8); PG8_WAIT_L(0); PG8_BAR; PG8_MMA(1, 0, At, B0); PG8_MMA(1, 1, At, B1); PG8_BAR; PG8_SCHED;
            } else {
            PG8_LDB(B0, 0, 0); PG8_SCHED; PG8_LDA(At, 0, 0); PG8_STAGE(PG8_SA(1, 1), a1 + hstep, voffA);
            PG8_WAIT_L(8); PG8_BAR; PG8_WAIT_L(0); PG8_MMA(0, 0, At, B0); PG8_BAR; PG8_SCHED;
            PG8_LDB(B1, 0, 1); PG8_STAGE(PG8_SB(0, 0), b2, voffB);
            PG8_BAR; PG8_WAIT_L(0); PG8_MMA(0, 1, At, B1); PG8_BAR;
            PG8_LDA(At, 0, 1); PG8_STAGE(PG8_SA(0, 0), a2, voffA);
            PG8_BAR; PG8_WAIT_L(0); PG8_MMA(1, 0, At, B0); PG8_BAR; PG8_SCHED;
            PG8_STAGE(PG8_SB(0, 1), b2 + hstep, voffB);
            PG8_WAIT_V(6); PG8_BAR; PG8_MMA(1, 1, At, B1); PG8_BAR;
            PG8_LDB(B0, 1, 0); PG8_SCHED; PG8_LDA(At, 1, 0); PG8_STAGE(PG8_SA(0, 1), a2 + hstep, voffA);
            PG8_WAIT_L(8); PG8_BAR; PG8_WAIT_L(0); PG8_MMA(0, 0, At, B0); PG8_BAR; PG8_SCHED;
            PG8_LDB(B1, 1, 1); PG8_STAGE(PG8_SB(1, 0), b3, voffB);
            PG8_BAR; PG8_WAIT_L(0); PG8_MMA(0, 1, At, B1); PG8_BAR;
            PG8_LDA(At, 1, 1); PG8_STAGE(PG8_SA(1, 0), a3, voffA);
            PG8_BAR; PG8_WAIT_L(0); PG8_MMA(1, 0, At, B0); PG8_BAR; PG8_SCHED;
            PG8_STAGE(PG8_SB(1, 1), b3 + hstep, voffB);
            PG8_WAIT_V(6); PG8_BAR; PG8_MMA(1, 1, At, B1); PG8_BAR;
            }
        }
        if constexpr (ALIGN_EPI) { if (wr == 0) PG8_BAR; }
        if constexpr (!Epi::AFTER_DRAIN) { E(acc, cur, wr, wc, fr, fq); S.done(cur); }
        if (!has_next) break;
#pragma unroll
        for (int a = 0; a < 2; ++a)
#pragma unroll
            for (int b = 0; b < 2; ++b)
#pragma unroll
                for (int m = 0; m < 4; ++m)
#pragma unroll
                    for (int n = 0; n < 2; ++n) acc[a][b][m][n] = (f32x4){0.f, 0.f, 0.f, 0.f};
        cur = nxt; cA = nA; cB = nB; ++ui;
        if constexpr (ALIGN_EPI) { if (wr == 1) PG8_BAR; }
    }
    PG8_WAIT_V(0);
    if constexpr (!ALIGN_EPI) { if (wr == 0) PG8_BAR; }
    PG8_BAR;
    if constexpr (Epi::AFTER_DRAIN) { E.fused(acc, cur, wr, wc, fr, fq, lds, wid, lane); S.done(cur); }
#undef PG8_SA
#undef PG8_SB
#undef PG8_STAGE
#undef PG8_LDA
#undef PG8_LDB
#undef PG8_MMA
#undef PG8_WAIT_V
#undef PG8_WAIT_L
#undef PG8_BAR
#undef PG8_SCHED
}
}
#ifndef PG8_SP2
#define PG8_SP2 true
#endif
namespace pg8 {
constexpr int TP_ROWS = 16384, T_ROWS = 16896;
constexpr float EPS_F = 1e-6f;
__device__ __forceinline__ float sigmoid_f(float x) { return __builtin_amdgcn_rcpf(1.0f + __expf(-x)); }
__device__ __forceinline__ float gelu_tanh_f(float x) { const float u = 0.7978845608028654f * (x + 0.044715f * x * x * x); return x * __builtin_amdgcn_rcpf(1.0f + __expf(-2.0f * u)); }
__device__ __forceinline__ float logsigmoid_f(float x) { return fminf(x, 0.f) - __logf(1.0f + __expf(-fabsf(x))); }
__device__ __forceinline__ u32x4 pack8(const f32x4& a, const f32x4& b) { u32x4 w; w.x = cvt_pk_bf16(a[0], a[1]); w.y = cvt_pk_bf16(a[2], a[3]); w.z = cvt_pk_bf16(b[0], b[1]); w.w = cvt_pk_bf16(b[2], b[3]); return w; }
__device__ __forceinline__ void unpack8(const u32x4& w, f32x4& a, f32x4& b) {
    a = (f32x4){__uint_as_float(w.x << 16), __uint_as_float(w.x & 0xffff0000u), __uint_as_float(w.y << 16), __uint_as_float(w.y & 0xffff0000u)};
    b = (f32x4){__uint_as_float(w.z << 16), __uint_as_float(w.z & 0xffff0000u), __uint_as_float(w.w << 16), __uint_as_float(w.w & 0xffff0000u)}; }
__device__ __forceinline__ float ssq4(const float* ssq, int row) { return rsqrtf(((ssq[row] + ssq[T_ROWS + row]) + (ssq[2 * T_ROWS + row] + ssq[3 * T_ROWS + row])) * (1.0f / 1024.0f) + EPS_F); }

template <class E> __device__ __forceinline__ void drive_epi(const E& e, const f32x4 (&acc)[2][2][4][2], const Unit& u, int wr, int wc, int fr, int fq, float (&sums)[8]) {
    const int row0 = u.pm * BM + wr * 64 + fr, col0 = u.pn * BM + wc * 32 + 8 * fq;
    float rs[8]; f32x4 cb0[2], cb1[2];
#pragma unroll
    for (int g = 0; g < 8; ++g) rs[g] = e.row_scale(row0 + (g >> 2) * HALF + (g & 3) * 16);
#pragma unroll
    for (int bj = 0; bj < 2; ++bj) e.col8(col0 + bj * HALF, cb0[bj], cb1[bj]);
#pragma unroll
    for (int hf = 0; hf < 2; ++hf) {
        u32x4 pre[4][2];
        if (E::HAS_PRE) {
#pragma unroll
            for (int m = 0; m < 4; ++m)
#pragma unroll
                for (int bj = 0; bj < 2; ++bj) pre[m][bj] = e.pre8(row0 + hf * HALF + m * 16, col0 + bj * HALF);
        }
#pragma unroll
        for (int m = 0; m < 4; ++m) { const int g = 4 * hf + m, row = row0 + hf * HALF + m * 16; float s = 0.f;
#pragma unroll
            for (int bj = 0; bj < 2; ++bj) e.row8(row, col0 + bj * HALF, acc[hf][bj][m][0], acc[hf][bj][m][1], rs[g], cb0[bj], cb1[bj], E::HAS_PRE ? pre[m][bj] : (u32x4){0u, 0u, 0u, 0u}, s);
            sums[g] = s; }
        if (E::HAS_PRE) asm volatile("" ::: "memory");
    }
}
struct EpiInE {
    static constexpr bool PERM = true, AFTER_DRAIN = false, HAS_PRE = false;
    bf16_t* P; const float* ssq;
    __device__ __forceinline__ float row_scale(int row) const { return ssq4(ssq, row); }
    __device__ __forceinline__ void col8(int, f32x4& b0, f32x4& b1) const { b0 = (f32x4){0.f, 0.f, 0.f, 0.f}; b1 = b0; }
    __device__ __forceinline__ u32x4 pre8(int, int) const { return (u32x4){0u, 0u, 0u, 0u}; }
    __device__ __forceinline__ void row8(int row, int col, f32x4 v0, f32x4 v1, float rs, const f32x4&, const f32x4&, const u32x4&, float&) const {
        v0 = v0 * rs; v1 = v1 * rs;
        if (col >= 1024 && col < 1536) {
#pragma unroll
            for (int e = 0; e < 4; ++e) { v0[e] = v0[e] * sigmoid_f(v0[e]); v1[e] = v1[e] * sigmoid_f(v1[e]); } }
        *(u32x4*)(P + (size_t)row * 2048 + col) = pack8(v0, v1);
    }
    __device__ __forceinline__ void operator()(const f32x4 (&acc)[2][2][4][2], const Unit& u, int wr, int wc, int fr, int fq) const { float sm[8]; drive_epi(*this, acc, u, wr, wc, fr, fq, sm); }
};
struct EpiInO {
    static constexpr bool PERM = true, AFTER_DRAIN = false, HAS_PRE = false;
    bf16_t* GATE; bf16_t* CIN; const float* ssq; float* conv_p; float* conv_s;
    __device__ __forceinline__ float row_scale(int row) const { return ssq4(ssq, row); }
    __device__ __forceinline__ void col8(int, f32x4& b0, f32x4& b1) const { b0 = (f32x4){0.f, 0.f, 0.f, 0.f}; b1 = b0; }
    __device__ __forceinline__ u32x4 pre8(int, int) const { return (u32x4){0u, 0u, 0u, 0u}; }
    __device__ __forceinline__ void row8(int row, int col, f32x4 v0, f32x4 v1, float rs, const f32x4&, const f32x4&, const u32x4&, float&) const {
        v0 = v0 * rs; v1 = v1 * rs;
        if (col < 1024) {
#pragma unroll
            for (int e = 0; e < 4; ++e) { v0[e] = gelu_tanh_f(v0[e]); v1[e] = gelu_tanh_f(v1[e]); }
            *(u32x4*)(GATE + (size_t)row * 1024 + col) = pack8(v0, v1);
        } else {
            const int cc = col - 1024;
            *(u32x4*)(CIN + (size_t)row * 1024 + cc) = pack8(v0, v1);
            float* cdst = nullptr;
            if (row < TP_ROWS) { const int t = row & 2047; if (t >= 2045) cdst = conv_p + ((size_t)(row >> 11) * 3 + (t - 2045)) * 1024; }
            else { const int r2 = row - TP_ROWS, t = r2 & 3; if (t >= 1) cdst = conv_s + ((size_t)(r2 >> 2) * 3 + (t - 1)) * 1024; }
            if (cdst) { *(f32x4*)(cdst + cc) = v0; *(f32x4*)(cdst + cc + 4) = v1; }
        }
    }
    __device__ __forceinline__ void operator()(const f32x4 (&acc)[2][2][4][2], const Unit& u, int wr, int wc, int fr, int fq) const { float sm[8]; drive_epi(*this, acc, u, wr, wc, fr, fq, sm); }
};
struct EpiRes {
    static constexpr bool PERM = true, AFTER_DRAIN = true, HAS_PRE = true;
    bf16_t* XB; float* ssq_out;
    __device__ __forceinline__ float row_scale(int) const { return 1.f; }
    __device__ __forceinline__ void col8(int, f32x4& b0, f32x4& b1) const { b0 = (f32x4){0.f, 0.f, 0.f, 0.f}; b1 = b0; }
    __device__ __forceinline__ u32x4 pre8(int row, int col) const { return *(const u32x4*)(XB + (size_t)row * 1024 + col); }
    __device__ __forceinline__ void row8(int row, int col, f32x4 v0, f32x4 v1, float, const f32x4&, const f32x4&, const u32x4& pre, float& s) const {
        f32x4 o0, o1; unpack8(pre, o0, o1); o0 = o0 + v0; o1 = o1 + v1;
        *(u32x4*)(XB + (size_t)row * 1024 + col) = pack8(o0, o1);
        s += (o0[0] * o0[0] + o0[1] * o0[1]) + (o0[2] * o0[2] + o0[3] * o0[3]) + (o1[0] * o1[0] + o1[1] * o1[1]) + (o1[2] * o1[2] + o1[3] * o1[3]);
    }
    __device__ __forceinline__ void fused(f32x4 (&acc)[2][2][4][2], const Unit& u, int wr, int wc, int fr, int fq, PG8_LAS unsigned char* lds, int wid, int lane) const {
        PG8_LAS float* part = (PG8_LAS float*)lds;
        float sm[8]; drive_epi(*this, acc, u, wr, wc, fr, fq, sm);
#pragma unroll
        for (int g = 0; g < 8; ++g) { float s = sm[g]; s += __shfl_xor(s, 16); s += __shfl_xor(s, 32);
            if (fq == 0) part[wc * 256 + (g >> 2) * HALF + wr * 64 + (g & 3) * 16 + fr] = s; }
        asm volatile("s_waitcnt lgkmcnt(0)" ::: "memory"); __builtin_amdgcn_s_barrier(); asm volatile("" ::: "memory");
        const int t = wid * 64 + lane;
        if (t < 256) ssq_out[(size_t)u.pn * T_ROWS + u.pm * BM + t] = (part[t] + part[256 + t]) + (part[512 + t] + part[768 + t]);
        asm volatile("s_waitcnt lgkmcnt(0)" ::: "memory"); __builtin_amdgcn_s_barrier(); asm volatile("" ::: "memory");
    }
    __device__ __forceinline__ void operator()(const f32x4 (&acc)[2][2][4][2], const Unit& u, int wr, int wc, int fr, int fq) const {}
};
struct EpiUp {
    static constexpr bool PERM = true, AFTER_DRAIN = false, HAS_PRE = false;
    bf16_t* H; const float* ssq;
    __device__ __forceinline__ float row_scale(int row) const { return ssq4(ssq, row); }
    __device__ __forceinline__ void col8(int, f32x4& b0, f32x4& b1) const { b0 = (f32x4){0.f, 0.f, 0.f, 0.f}; b1 = b0; }
    __device__ __forceinline__ u32x4 pre8(int, int) const { return (u32x4){0u, 0u, 0u, 0u}; }
    __device__ __forceinline__ void row8(int row, int col, f32x4 v0, f32x4 v1, float rs, const f32x4&, const f32x4&, const u32x4&, float&) const {
        v0 = v0 * rs; v1 = v1 * rs;
#pragma unroll
        for (int e = 0; e < 4; ++e) { const float a = fmaxf(v0[e], 0.f), b = fmaxf(v1[e], 0.f); v0[e] = a * a; v1[e] = b * b; }
        { const u32x4 pk_ = pack8(v0, v1); bf16_t* dp_ = H + (size_t)row * 4224 + col;
          asm volatile("global_store_dwordx4 %0, %1, off sc1\n\ts_nop 1" :: "v"(dp_), "v"(pk_) : "memory"); }
    }
    __device__ __forceinline__ void operator()(const f32x4 (&acc)[2][2][4][2], const Unit& u, int wr, int wc, int fr, int fq) const { float sm[8]; drive_epi(*this, acc, u, wr, wc, fr, fq, sm); }
};
struct EpiGlu {
    static constexpr bool PERM = true, AFTER_DRAIN = false, HAS_PRE = true;
    const bf16_t* Z1; bf16_t* MIX; const float* b_glu;
    __device__ __forceinline__ float row_scale(int) const { return 1.f; }
    __device__ __forceinline__ void col8(int col, f32x4& b0, f32x4& b1) const { b0 = *(const f32x4*)(b_glu + col); b1 = *(const f32x4*)(b_glu + col + 4); }
    __device__ __forceinline__ u32x4 pre8(int row, int col) const { return *(const u32x4*)(Z1 + (size_t)row * 512 + col); }
    __device__ __forceinline__ void row8(int row, int col, f32x4 v0, f32x4 v1, float, const f32x4& b0, const f32x4& b1, const u32x4& pre, float&) const {
        f32x4 z0, z1; unpack8(pre, z0, z1);
#pragma unroll
        for (int e = 0; e < 4; ++e) { v0[e] = z0[e] * sigmoid_f(v0[e] + b0[e]); v1[e] = z1[e] * sigmoid_f(v1[e] + b1[e]); }
        *(u32x4*)(MIX + (size_t)row * 1024 + 512 + col) = pack8(v0, v1);
    }
    __device__ __forceinline__ void operator()(const f32x4 (&acc)[2][2][4][2], const Unit& u, int wr, int wc, int fr, int fq) const { float sm[8]; drive_epi(*this, acc, u, wr, wc, fr, fq, sm); }
};
}
constexpr int NWAVES = 8;
constexpr int D = 1024, TP = 16384, TS = 512, T = TP + TS, FF = 4096;
constexpr int NIN_E = 2304, NIN_O = 2048;
constexpr float EPS = 1e-6f;
constexpr size_t MiB = 1u << 20;
constexpr size_t WS_CTL = 0, CTL_ZERO_BYTES = 2 * MiB;
constexpr size_t WS_SSQ = 277 * MiB;
constexpr size_t CTL_S5AB = 1 * MiB;
constexpr size_t CTL_S5BRE = 1 * MiB + 64 * 1024;
constexpr size_t CTL_S5BIM = CTL_S5BRE + 256 * 1024;
constexpr size_t WS_W = 2 * MiB;
constexpr size_t W_INE = 0, W_GLU = 9437184, W_OUTE = 10485760, W_INO = 14680064, W_G = 23068672, W_OUTO = 24117248, W_UP = 28311552, W_DN = 61865984, W_END = 96468992;
constexpr size_t WS_WA = 94 * MiB;
constexpr int LD_FF = 4224;
constexpr size_t WS_XB = 95 * MiB, WS_R = 128 * MiB;
constexpr size_t R_H = 0, R_P = 0, R_LA = 66 * MiB, R_Z1 = 82 * MiB + MiB / 2, R_MIX = 99 * MiB, R_ORAW = 132 * MiB;
constexpr size_t R_CIN = 0, R_LOGA = 0, R_XC = 33 * MiB, R_BB = 66 * MiB;
constexpr size_t WS_END = WS_SSQ + (size_t)9 * 4 * T * 4;
static_assert(WS_R + 148 * MiB + MiB / 2 <= WS_SSQ, "ws map");
static_assert(WS_W + W_END <= WS_XB && WS_XB + (size_t)T * D * 2 <= WS_R, "ws map");
constexpr size_t OUT_YP = 0, OUT_YS = 16777216, OUT_GLAP = 17301504, OUT_REP = 17825792, OUT_IMP = 17858560, OUT_LRUP = 17891328, OUT_CONVP = 17907712,
                 OUT_GLAS = 17956864, OUT_RES = 26345472, OUT_IMS = 26869760, OUT_LRUS = 27394048, OUT_CONVS = 27656192, OUT_END = 28442624;
constexpr int CW_TMO = 0, CW_CODE = 1, CW_BAR = 4096;
constexpr int RING_OFF = 0, RING_BYTES = 131072, LDSCTL_OFF = RING_BYTES, MISC_OFF = LDSCTL_OFF + 320, LDS_BYTES = 147456;

#define GAS __attribute__((address_space(1)))
#define LAS __attribute__((address_space(3)))
typedef unsigned short bf16;
typedef unsigned v4u __attribute__((ext_vector_type(4)));
typedef unsigned v2u __attribute__((ext_vector_type(2)));
typedef float f32x4 __attribute__((ext_vector_type(4)));
typedef short bf16x8 __attribute__((ext_vector_type(8)));
typedef GAS unsigned gu32;
#define RLX_AGENT __ATOMIC_RELAXED, __HIP_MEMORY_SCOPE_AGENT
#define LDS_WAIT() asm volatile("s_waitcnt lgkmcnt(0)" ::: "memory")
#define VM_WAIT() asm volatile("s_waitcnt vmcnt(0)" ::: "memory")
__device__ __forceinline__ unsigned f2bf(float f) { unsigned u = __builtin_bit_cast(unsigned, f); return (u + 0x7fffu + ((u >> 16) & 1u)) >> 16; }
__device__ __forceinline__ unsigned pk2(float lo, float hi) { return f2bf(lo) | (f2bf(hi) << 16); }
__device__ __forceinline__ float bflo(unsigned w) { return __uint_as_float(w << 16); }
__device__ __forceinline__ float bfhi(unsigned w) { return __uint_as_float(w & 0xffff0000u); }
__device__ __forceinline__ float bf2f(bf16 h) { return __uint_as_float((unsigned)h << 16); }
__device__ __forceinline__ float sigmoid_f(float x) { return __builtin_amdgcn_rcpf(1.0f + __expf(-x)); }
__device__ __forceinline__ float gelu_tanh_f(float x) { const float u = 0.7978845608028654f * (x + 0.044715f * x * x * x); return x * __builtin_amdgcn_rcpf(1.0f + __expf(-2.0f * u)); }
__device__ __forceinline__ float wave_sum(float v) {
#pragma unroll
    for (int o = 1; o < 64; o <<= 1) v += __shfl_xor(v, o);
    return v;
}
#define XB_TMO      128
#define XB_XCNT(j)  (256  + 64 * (j))
#define XB_XSUB(j)  (1280 + 64 * (j))
#define XB_XGEN(j)  (2304 + 64 * (j))
#define XB_TOP      3328
#define XB_TOPGEN   3392
#define XCD_BAR_WORDS 3456
#define XB_SPIN_CAP (1u << 18)

__device__ __forceinline__ unsigned xb_ld(unsigned* p)              { return __hip_atomic_load(p, __ATOMIC_RELAXED, __HIP_MEMORY_SCOPE_AGENT); }
__device__ __forceinline__ unsigned xb_add(unsigned* p, unsigned v) { return __hip_atomic_fetch_add(p, v, __ATOMIC_RELAXED, __HIP_MEMORY_SCOPE_AGENT); }
__device__ __forceinline__ unsigned xb_xcc_id() { return (unsigned)__builtin_amdgcn_s_getreg((3 << 11) | 20) & 0xFu; }
#define XB_SPIN(cond, bar) do { unsigned _sp = 0; while (cond) { __builtin_amdgcn_s_sleep(1); \
    if ((++_sp & 255u) == 0u) { if (xb_ld(&(bar)[XB_TMO])) break; if (_sp > XB_SPIN_CAP) { atomicAdd(&(bar)[XB_TMO], 1u); break; } } } } while (0)

struct XcdBarrier {
    unsigned* bar; unsigned x;
    volatile LAS unsigned* st;
};

__device__ __forceinline__ XcdBarrier xcd_barrier_post(unsigned* bar, volatile LAS unsigned* st, int tid) {
    XcdBarrier b; b.bar = bar; b.x = xb_xcc_id(); b.st = st;
    if (tid == 0) (void)xb_add(&bar[XB_XCNT(b.x)], 1u);
    return b;
}
__device__ __forceinline__ void xcd_barrier_complete(unsigned* bar, unsigned x, unsigned& nloc, unsigned& nx) {
    const unsigned G = gridDim.x * gridDim.y * gridDim.z;
    unsigned sum, cnt, mine, sp = 0u;
    for (;;) {
        sum = 0u; cnt = 0u; mine = 0u;
#pragma unroll
        for (unsigned j = 0; j < 16; ++j) { const unsigned c = xb_ld(&bar[XB_XCNT(j)]); sum += c; cnt += (c > 0u) ? 1u : 0u; mine = (j == x) ? c : mine; }
        if (sum == G) break;
        __builtin_amdgcn_s_sleep(1);
        if ((++sp & 255u) == 0u) { if (xb_ld(&bar[XB_TMO])) break; if (sp > XB_SPIN_CAP) { atomicAdd(&bar[XB_TMO], 1u); break; } }
    }
    nloc = mine > 0u ? mine : 1u; nx = cnt > 0u ? cnt : 1u;
}

__device__ __forceinline__ void xcd_barrier(const XcdBarrier& b, int tid) {
    asm volatile("s_waitcnt vmcnt(0)" ::: "memory");
    __syncthreads();
    if (tid == 0) {
        unsigned* bar = b.bar;
        __builtin_amdgcn_s_waitcnt(0);
        unsigned nloc = b.st[0], nx = b.st[1];
        if (nloc == 0u) { xcd_barrier_complete(bar, b.x, nloc, nx); b.st[0] = nloc; b.st[1] = nx; }
        const unsigned old = xb_add(&bar[XB_XSUB(b.x)], 1u);
        const unsigned gen = old / nloc;
        if (old + 1u == (gen + 1u) * nloc) {
            __builtin_amdgcn_fence(__ATOMIC_RELEASE, "agent");
            asm volatile("s_waitcnt vmcnt(0)" ::: "memory");
            const unsigned og = xb_add(&bar[XB_TOP], 1u);
            const unsigned tg = og / nx;
            if (og + 1u == (tg + 1u) * nx) xb_add(&bar[XB_TOPGEN], 1u);
            else XB_SPIN(xb_ld(&bar[XB_TOPGEN]) == tg, bar);
            __builtin_amdgcn_fence(__ATOMIC_ACQUIRE, "agent");
            xb_add(&bar[XB_XGEN(b.x)], 1u);
            asm volatile("s_waitcnt vmcnt(0)" ::: "memory");
        } else {
            XB_SPIN(xb_ld(&bar[XB_XGEN(b.x)]) == gen, bar);
            __builtin_amdgcn_fence(__ATOMIC_ACQUIRE, "agent");
            asm volatile("s_waitcnt vmcnt(0)" ::: "memory");
        }
    }
    __syncthreads();
}
struct Args { const float* in[37]; float* out; unsigned char* ws; int ph_lo, ph_hi, li, pad; };
template <class T> __device__ __forceinline__ T* as_global(T* p) { const unsigned long long u = (unsigned long long)p; return (T*)(GAS T*)u; }
struct InPtrs { const float* const* p; __device__ __forceinline__ const float* operator[](int i) const { return as_global(p[i]); } };
struct Ctx { InPtrs in; float* out; unsigned char* ws; LAS unsigned char* lds; int tid, lane, wave, vcu, G, gw, NGW, var; };

__device__ __forceinline__ void tr_item(const float* W, int ldw, int K, const float* gain, bf16* WT, LAS float* scr, int kb, int nb, int lane, int ldo) {
    const int k0 = 64 * kb, n0 = 32 * nb;
    f32x4 v[8];
#pragma unroll
    for (int i = 0; i < 8; ++i) v[i] = __builtin_nontemporal_load((const f32x4*)(W + (size_t)(k0 + 8 * i + (lane >> 3)) * ldw + n0 + 4 * (lane & 7)));
#pragma unroll
    for (int i = 0; i < 8; ++i) { const int kk = 8 * i + (lane >> 3); f32x4 x = v[i]; if (gain) x = x * gain[k0 + kk];
        LAS float* d = scr + kk * 33 + 4 * (lane & 7); d[0] = x[0]; d[1] = x[1]; d[2] = x[2]; d[3] = x[3]; }
    LDS_WAIT(); asm volatile("" ::: "memory");
    const int c = lane & 7;
#pragma unroll
    for (int j = 0; j < 4; ++j) { const int n = (lane >> 3) + 8 * j; const LAS float* s = scr + (8 * c) * 33 + n;
        v4u o; o.x = pk2(s[0 * 33], s[1 * 33]); o.y = pk2(s[2 * 33], s[3 * 33]); o.z = pk2(s[4 * 33], s[5 * 33]); o.w = pk2(s[6 * 33], s[7 * 33]);
        __builtin_nontemporal_store(o, (GAS v4u*)(WT + (size_t)(n0 + n) * ldo + k0 + 8 * c)); }
    LDS_WAIT(); asm volatile("" ::: "memory");
}
__device__ __forceinline__ void tr_job(const Ctx& c, int& base, const float* W, int ldw, int ncols, int K, const float* gain, bf16* WT, LAS float* scr, int ldo = 0) {
    if (ldo == 0) ldo = K;
    const int nblk = ncols / 32, nitems = (K / 64) * nblk;
    int first = (c.gw - base) % c.NGW; if (first < 0) first += c.NGW;
    for (int it = first; it < nitems; it += c.NGW) tr_item(W, ldw, K, gain, WT, scr, it / nblk, it % nblk, c.lane, ldo);
    base = (base + nitems) % c.NGW;
}
__device__ __forceinline__ void sincos_d(double x, double& s, double& c) {
    const double j = __builtin_rint(x * 0.63661977236758134308);
    double r = __builtin_fma(-j, 1.57079632673412561417e+00, x); r = __builtin_fma(-j, 6.07710050650619224932e-11, r);
    const double z = r * r;
    const double sp = r + r * z * (-1.66666666666666307295e-1 + z * (8.33333333332211858878e-3 + z * (-1.98412698295895385996e-4 + z * (2.75573136213857245213e-6 + z * (-2.50507477628578072866e-8 + z * 1.58962301576546568060e-10)))));
    const double cp = 1.0 - 0.5 * z + z * z * (4.16666666666665929218e-2 + z * (-1.38888888888730564116e-3 + z * (2.48015872888517045348e-5 + z * (-2.75573141792967388112e-7 + z * (2.08757008419747316778e-9 + z * -1.13585365213876817300e-11)))));
    const int q = ((int)j) & 3;
    s = (q == 0) ? sp : (q == 1) ? cp : (q == 2) ? -sp : -cp;
    c = (q == 0) ? cp : (q == 1) ? -sp : (q == 2) ? -cp : sp;
}
__device__ __forceinline__ void p0_weights_rest(const Ctx& c) {
    LAS float* scr = (LAS float*)(c.lds + RING_OFF + c.wave * 16384);
    const InPtrs in = c.in; unsigned char* ws = c.ws;
    bf16* Wb = (bf16*)(ws + WS_W);
    int base = 0;
    for (int e = 0; e < 2; ++e) {
        if (e == 1) { const float* w = in[8] + (size_t)e * 1024 * 2064; const float* g = in[7] + e * 1024; bf16* dst = (bf16*)((unsigned char*)Wb + W_INE) + (size_t)e * NIN_E * 1024;
            tr_job(c, base, w, 2064, 1536, 1024, g, dst, scr);
            tr_job(c, base, w + 1552, 2064, 512, 1024, g, dst + (size_t)1536 * 1024, scr); }
        tr_job(c, base, in[20] + (size_t)e * 512 * 512, 512, 512, 512, nullptr, (bf16*)((unsigned char*)Wb + W_GLU) + (size_t)e * 512 * 512, scr);
        tr_job(c, base, in[22] + (size_t)e * 1024 * 1024, 1024, 1024, 1024, nullptr, (bf16*)((unsigned char*)Wb + W_OUTE) + (size_t)e * 1024 * 1024, scr);
    }
    for (int o = 0; o < 2; ++o) {
        tr_job(c, base, in[24] + (size_t)o * 1024 * 2048, 2048, 2048, 1024, in[23] + o * 1024, (bf16*)((unsigned char*)Wb + W_INO) + (size_t)o * 2048 * 1024, scr);
        tr_job(c, base, in[32] + (size_t)o * 1024 * 1024, 1024, 1024, 1024, nullptr, (bf16*)((unsigned char*)Wb + W_OUTO) + (size_t)o * 1024 * 1024, scr);
        for (int n = 0; n < 8; ++n) {
            bf16* dst = (bf16*)((unsigned char*)Wb + W_G) + ((size_t)o * 8 + n) * 256 * 128;
            tr_job(c, base, in[27] + ((size_t)o * 8 + n) * 128 * 128, 128, 128, 128, nullptr, dst, scr);
            tr_job(c, base, in[29] + ((size_t)o * 8 + n) * 128 * 128, 128, 128, 128, nullptr, dst + 128 * 128, scr);
        }
    }
    for (int l = 0; l < 4; ++l) {
        tr_job(c, base, in[34] + (size_t)l * 1024 * 4096, 4096, 4096, 1024, in[33] + l * 1024, (bf16*)((unsigned char*)Wb + W_UP) + (size_t)l * 4096 * 1024, scr);
        tr_job(c, base, in[35] + (size_t)l * 4096 * 1024, 1024, 1024, 4096, nullptr, (bf16*)((unsigned char*)Wb + W_DN) + (size_t)l * 1024 * LD_FF, scr, LD_FF);
    }
    __syncthreads();
}
__device__ __forceinline__ void p0_prologue(const Ctx& c) {
    LAS float* scr = (LAS float*)(c.lds + RING_OFF + c.wave * 16384);
    const InPtrs in = c.in; unsigned char* ws = c.ws;
    bf16* Wb = (bf16*)(ws + WS_W);
    int base = 0;
    { const float* w = in[8]; const float* g = in[7]; bf16* dst = (bf16*)((unsigned char*)Wb + W_INE);
      tr_job(c, base, w, 2064, 1536, 1024, g, dst, scr);
      tr_job(c, base, w + 1552, 2064, 512, 1024, g, dst + (size_t)1536 * 1024, scr); }
    const int gtid = c.vcu * (NWAVES * 64) + c.tid, NT = c.G * NWAVES * 64;
    for (int i = gtid; i < 2 * 16 * 128; i += NT) {
        const int e = i >> 11, j = (i >> 7) & 15, k0 = (i & 127) * 8; const float* w = in[8] + (size_t)e * 1024 * 2064 + 1536 + j; const float* g = in[7] + e * 1024;
        float o[8];
#pragma unroll
        for (int kk = 0; kk < 8; ++kk) o[kk] = w[(size_t)(k0 + kk) * 2064] * g[k0 + kk];
        v4u pk; pk.x = pk2(o[0], o[1]); pk.y = pk2(o[2], o[3]); pk.z = pk2(o[4], o[5]); pk.w = pk2(o[6], o[7]);
        *(v4u*)((bf16*)(ws + WS_WA) + ((size_t)e * 16 + j) * 1024 + k0) = pk;
    }
    for (int i = gtid; i < 2 * 256 * 2; i += NT) {
        const int e = i >> 9, n = (i >> 1) & 255, j0 = (i & 1) * 8; const float* a2 = in[9] + (size_t)e * 16 * 256 + n;
        float o[8];
#pragma unroll
        for (int jj = 0; jj < 8; ++jj) o[jj] = a2[(size_t)(j0 + jj) * 256];
        v4u pk; pk.x = pk2(o[0], o[1]); pk.y = pk2(o[2], o[3]); pk.z = pk2(o[4], o[5]); pk.w = pk2(o[6], o[7]);
        *(v4u*)((bf16*)(ws + WS_WA) + 2 * 16 * 1024 + ((size_t)e * 256 + n) * 16 + j0) = pk;
    }
    for (int i = gtid; i < 2 * 32 * 64; i += NT) {
        const double dt = exp((double)in[14][i >> 6]);
        const double are = (double)in[12][i], aim = (double)in[13][i];
        const double zr = dt * are, zi = dt * aim; double sn, cs; sincos_d(zi, sn, cs);
        const double mag = exp(zr), abre = mag * cs, abim = mag * sn;
        double sh, ch; sincos_d(0.5 * zi, sh, ch);
        const double m1re = expm1(zr) * cs - 2.0 * sh * sh, m1im = abim;
        const double den = are * are + aim * aim;
        const double cre = (m1re * are + m1im * aim) / den, cim = (m1im * are - m1re * aim) / den;
        float* AB = (float*)(ws + CTL_S5AB); AB[2 * i] = (float)abre; AB[2 * i + 1] = (float)abim;
        float* BRE = (float*)(ws + CTL_S5BRE) + (size_t)i * 16; float* BIM = (float*)(ws + CTL_S5BIM) + (size_t)i * 16;
        const float* bre = in[15] + (size_t)i * 16; const float* bim = in[16] + (size_t)i * 16;
#pragma unroll
        for (int q = 0; q < 16; ++q) { const double br = bre[q], bi = bim[q]; BRE[q] = (float)(cre * br - cim * bi); BIM[q] = (float)(cre * bi + cim * br); }
    }
    bf16* XB = (bf16*)(ws + WS_XB); float* ssq0 = (float*)(ws + WS_SSQ);
    for (int m = c.gw; m < T; m += c.NGW) {
        const float* xr = (m < TP) ? in[0] + (size_t)m * D : in[1] + (size_t)(m - TP) * D;
        const GAS f32x4* x4 = (const GAS f32x4*)xr + c.lane; f32x4 v[4]; float s = 0.f;
#pragma unroll
        for (int j = 0; j < 4; ++j) { v[j] = __builtin_nontemporal_load(x4 + 64 * j); s += (v[j].x * v[j].x + v[j].y * v[j].y) + (v[j].z * v[j].z + v[j].w * v[j].w); }
        s = wave_sum(s);
        GAS v2u* o8 = (GAS v2u*)(XB + (size_t)m * D) + c.lane;
#pragma unroll
        for (int j = 0; j < 4; ++j) { v2u w; w.x = pk2(v[j].x, v[j].y); w.y = pk2(v[j].z, v[j].w); o8[64 * j] = w; }
        if (c.lane < 4) ssq0[(size_t)c.lane * T + m] = (c.lane == 0) ? s : 0.f;
    }
}
__device__ __forceinline__ void gla_naive_block(const Ctx& c, int e, int item0, bool sample) {
    unsigned char* ws = c.ws;
    const bf16* P = (const bf16*)(ws + WS_R + R_P); const float* LA = (const float*)(ws + WS_R + R_LA); bf16* ORAW = (bf16*)(ws + WS_R + R_ORAW);
    const int sub = c.tid >> 7, st = c.tid & 127, item = item0 + sub, b = item >> 2, h = item & 3;
    const int row0 = sample ? TP + b * 4 : b * 2048, n = sample ? 4 : 2048;
    float S[64];
    if (sample) { const float* s0 = c.in[2] + (((size_t)e * 128 + b) * 4 + h) * 8192;
#pragma unroll
        for (int d = 0; d < 64; ++d) S[d] = s0[d * 128 + st]; }
    else {
#pragma unroll
        for (int d = 0; d < 64; ++d) S[d] = 0.f; }
    LAS float* lq = (LAS float*)(c.lds + RING_OFF) + sub * 5120; LAS float* lk = lq + 1024; LAS float* la = lq + 2048; LAS float* lv = lq + 3072;
    for (int t0 = 0; t0 < n; t0 += 16) {
        const int nt = (n - t0) < 16 ? (n - t0) : 16;
        __syncthreads();
#pragma unroll
        for (int i = 0; i < 8; ++i) { const int idx = st + 128 * i, tt = idx >> 6, d = idx & 63;
            if (tt < nt) { const size_t row = (size_t)(row0 + t0 + tt);
                lq[idx] = bf2f(P[row * 2048 + h * 64 + d]); lk[idx] = bf2f(P[row * 2048 + 256 + h * 64 + d]); la[idx] = __expf(LA[row * 256 + h * 64 + d]); } }
#pragma unroll
        for (int tt = 0; tt < 16; ++tt) if (tt < nt) lv[tt * 128 + st] = bf2f(P[(size_t)(row0 + t0 + tt) * 2048 + 512 + h * 128 + st]);
        __syncthreads();
#pragma unroll 1
        for (int tt = 0; tt < nt; ++tt) {
            const float v = lv[tt * 128 + st]; float o = 0.f;
#pragma unroll
            for (int d4 = 0; d4 < 16; ++d4) { const f32x4 a4 = *(const LAS f32x4*)(la + tt * 64 + 4 * d4), k4 = *(const LAS f32x4*)(lk + tt * 64 + 4 * d4), q4 = *(const LAS f32x4*)(lq + tt * 64 + 4 * d4);
#pragma unroll
                for (int i = 0; i < 4; ++i) { S[4 * d4 + i] = a4[i] * S[4 * d4 + i] + k4[i] * v; o += q4[i] * S[4 * d4 + i]; } }
            ORAW[(size_t)(row0 + t0 + tt) * 512 + h * 128 + st] = (bf16)f2bf(o * 0.125f);
        }
    }
    float* dst = c.out + (sample ? OUT_GLAS + (((size_t)e * 128 + b) * 4 + h) * 8192 : OUT_GLAP + (((size_t)e * 8 + b) * 4 + h) * 8192);
#pragma unroll
    for (int d = 0; d < 64; ++d) dst[d * 128 + st] = S[d];
}
__device__ __forceinline__ void s5_naive_wave(const Ctx& c, int e, int item, bool sample, LAS float* wl) {
    unsigned char* ws = c.ws; const int lane = c.lane;
    const bf16* P = (const bf16*)(ws + WS_R + R_P); bf16* Z1 = (bf16*)(ws + WS_R + R_Z1);
    const int b = item >> 5, g = item & 31, row0 = sample ? TP + b * 4 : b * 2048, n = sample ? 4 : 2048;
    const int idx = (e * 32 + g) * 64 + lane;
    const float* AB = (const float*)(ws + CTL_S5AB); const float ar = AB[2 * idx], ai = AB[2 * idx + 1];
    float bre[16], bim[16];
    { const f32x4* r4 = (const f32x4*)((const float*)(ws + CTL_S5BRE) + (size_t)idx * 16); const f32x4* i4 = (const f32x4*)((const float*)(ws + CTL_S5BIM) + (size_t)idx * 16);
#pragma unroll
      for (int q = 0; q < 4; ++q) { const f32x4 a = r4[q], bb = i4[q];
#pragma unroll
          for (int j = 0; j < 4; ++j) { bre[4 * q + j] = a[j]; bim[4 * q + j] = bb[j]; } } }
    float hre = 0.f, him = 0.f;
    if (sample) { hre = c.in[3][(((size_t)e * 128 + b) * 32 + g) * 64 + lane]; him = c.in[4][(((size_t)e * 128 + b) * 32 + g) * 64 + lane]; }
    LAS float* lcre = wl; LAS float* lcim = wl + 1024; LAS float* lu = wl + 2048; LAS float* hs = wl + 2176;
    { const float* cr = c.in[17] + (size_t)(e * 32 + g) * 1024; const float* ci = c.in[18] + (size_t)(e * 32 + g) * 1024;
#pragma unroll
      for (int i = 0; i < 16; ++i) { lcre[i * 64 + lane] = cr[i * 64 + lane]; lcim[i * 64 + lane] = ci[i * 64 + lane]; } }
    const int ott = lane >> 3, oc0 = 2 * (lane & 7);
    const float dsk0 = c.in[19][(e * 32 + g) * 16 + oc0], dsk1 = c.in[19][(e * 32 + g) * 16 + oc0 + 1];
    for (int t0 = 0; t0 < n; t0 += 8) {
        const int nt = (n - t0) < 8 ? (n - t0) : 8;
#pragma unroll
        for (int i = 0; i < 2; ++i) { const int ix = lane + 64 * i, tt = ix >> 4, cc = ix & 15;
            lu[ix] = (tt < nt) ? bf2f(P[(size_t)(row0 + t0 + tt) * 2048 + 1536 + g * 16 + cc]) : 0.f; }
        LDS_WAIT(); asm volatile("" ::: "memory");
#pragma unroll
        for (int tt = 0; tt < 8; ++tt) {
            if (tt < nt) {
                float bur = 0.f, bui = 0.f;
#pragma unroll
                for (int q = 0; q < 4; ++q) { const f32x4 u4 = *(const LAS f32x4*)(lu + tt * 16 + 4 * q);
#pragma unroll
                    for (int j = 0; j < 4; ++j) { bur += u4[j] * bre[4 * q + j]; bui += u4[j] * bim[4 * q + j]; } }
                const float nre = ar * hre - ai * him + bur, nim = ar * him + ai * hre + bui; hre = nre; him = nim;
                hs[tt * 128 + lane] = hre; hs[tt * 128 + 64 + lane] = him;
            }
        }
        LDS_WAIT(); asm volatile("" ::: "memory");
        if (ott < nt) {
            float y0 = 0.f, y1 = 0.f;
#pragma unroll
            for (int p4 = 0; p4 < 16; ++p4) {
                const f32x4 hr = *(const LAS f32x4*)(hs + ott * 128 + 4 * p4), hi = *(const LAS f32x4*)(hs + ott * 128 + 64 + 4 * p4);
                const f32x4 c0r = *(const LAS f32x4*)(lcre + oc0 * 64 + 4 * p4), c0i = *(const LAS f32x4*)(lcim + oc0 * 64 + 4 * p4);
                const f32x4 c1r = *(const LAS f32x4*)(lcre + (oc0 + 1) * 64 + 4 * p4), c1i = *(const LAS f32x4*)(lcim + (oc0 + 1) * 64 + 4 * p4);
#pragma unroll
                for (int j = 0; j < 4; ++j) { y0 += hr[j] * c0r[j] - hi[j] * c0i[j]; y1 += hr[j] * c1r[j] - hi[j] * c1i[j]; }
            }
            y0 += dsk0 * lu[ott * 16 + oc0]; y1 += dsk1 * lu[ott * 16 + oc0 + 1];
            *(unsigned*)(Z1 + (size_t)(row0 + t0 + ott) * 512 + g * 16 + oc0) = pk2(gelu_tanh_f(y0), gelu_tanh_f(y1));
        }
        LDS_WAIT(); asm volatile("" ::: "memory");
    }
    float* dre = c.out + (sample ? OUT_RES + (((size_t)e * 128 + b) * 32 + g) * 64 : OUT_REP + (((size_t)e * 8 + b) * 32 + g) * 64);
    float* dim = c.out + (sample ? OUT_IMS + (((size_t)e * 128 + b) * 32 + g) * 64 : OUT_IMP + (((size_t)e * 8 + b) * 32 + g) * 64);
    dre[lane] = hre; dim[lane] = him;
}
__device__ __forceinline__ void gla_post(const Ctx& c, int e) {
    unsigned char* ws = c.ws; const int lane = c.lane;
    const bf16* P = (const bf16*)(ws + WS_R + R_P); const bf16* ORAW = (const bf16*)(ws + WS_R + R_ORAW); bf16* MIX = (bf16*)(ws + WS_R + R_MIX);
    const float* gn = c.in[11] + e * 512;
    for (int wi = TP * 4 + c.gw; wi < T * 4; wi += c.NGW) {
        const int row = wi >> 2, h = wi & 3;
        const unsigned ow = *(const unsigned*)(ORAW + (size_t)row * 512 + h * 128 + 2 * lane);
        const float o0 = bflo(ow), o1 = bfhi(ow);
        const float ss = wave_sum(o0 * o0 + o1 * o1), rs = rsqrtf(ss * (1.0f / 128.0f) + EPS);
        const unsigned gw = *(const unsigned*)(P + (size_t)row * 2048 + 1024 + h * 128 + 2 * lane);
        *(unsigned*)(MIX + (size_t)row * 1024 + h * 128 + 2 * lane) = pk2(o0 * rs * gn[h * 128 + 2 * lane] * bflo(gw), o1 * rs * gn[h * 128 + 2 * lane + 1] * bfhi(gw));
    }
}
__device__ __forceinline__ void final_norm(const Ctx& c) {
    const float* nf = c.in[36]; const bf16* XB = (const bf16*)(c.ws + WS_XB);
    for (int m = c.gw; m < T; m += c.NGW) {
        const v4u* x8 = (const v4u*)(XB + (size_t)m * D) + c.lane; float v[16]; float s = 0.f;
#pragma unroll
        for (int j = 0; j < 2; ++j) { const v4u w = x8[64 * j];
#pragma unroll
            for (int q = 0; q < 4; ++q) { v[8 * j + 2 * q] = bflo(w[q]); v[8 * j + 2 * q + 1] = bfhi(w[q]); } }
#pragma unroll
        for (int i = 0; i < 16; ++i) s += v[i] * v[i];
        const float rs = rsqrtf(wave_sum(s) * (1.0f / 1024.0f) + EPS);
#pragma unroll
        for (int j = 0; j < 2; ++j) { const int col = 512 * j + 8 * c.lane; const f32x4 g0 = *(const f32x4*)(nf + col), g1 = *(const f32x4*)(nf + col + 4);
            f32x4 o0, o1;
#pragma unroll
            for (int q = 0; q < 4; ++q) { o0[q] = v[8 * j + q] * rs * g0[q]; o1[q] = v[8 * j + 4 + q] * rs * g1[q]; }
            *(f32x4*)(c.out + (size_t)m * D + col) = o0; *(f32x4*)(c.out + (size_t)m * D + col + 4) = o1; }
    }
}
typedef float f32x16 __attribute__((ext_vector_type(16)));
typedef short s16x4 __attribute__((ext_vector_type(4)));
typedef float f32x2_t __attribute__((ext_vector_type(2)));
typedef __bf16 bf16x2_t __attribute__((ext_vector_type(2)));
#define MFMA32(a, b, c) __builtin_amdgcn_mfma_f32_32x32x16_bf16((a), (b), (c), 0, 0, 0)
__device__ __forceinline__ unsigned cvtpk(float lo, float hi) { f32x2_t v = {lo, hi}; bf16x2_t b = __builtin_convertvector(v, bf16x2_t); return __builtin_bit_cast(unsigned, b); }
template <int S_> __device__ __forceinline__ bf16x8 pack_step(const f32x16& x) {
    v4u p; p.x = cvtpk(x[8 * S_], x[8 * S_ + 1]); p.y = cvtpk(x[8 * S_ + 2], x[8 * S_ + 3]); p.z = cvtpk(x[8 * S_ + 4], x[8 * S_ + 5]); p.w = cvtpk(x[8 * S_ + 6], x[8 * S_ + 7]);
    return __builtin_bit_cast(bf16x8, p);
}
__device__ __forceinline__ s16x4 trr(const LAS unsigned char* p) { return __builtin_bit_cast(s16x4, __builtin_amdgcn_ds_read_tr16_b64_v4i16((LAS s16x4*)p)); }
__device__ __forceinline__ bf16x8 cat8(s16x4 lo, s16x4 hi) { return __builtin_shufflevector(lo, hi, 0, 1, 2, 3, 4, 5, 6, 7); }
__device__ __forceinline__ bf16x8 cat8u(v2u lo, v2u hi) { v4u w; w.x = lo.x; w.y = lo.y; w.z = hi.x; w.w = hi.y; return __builtin_bit_cast(bf16x8, w); }
constexpr int GL_PQ = 144, GL_PV = 320, GL_PSG = 272;
constexpr int GL_QS = 0, GL_KS = 32 * GL_PQ, GL_V = 2 * 32 * GL_PQ, GL_SG = GL_V + 32 * GL_PV, GL_EL = GL_SG + 32 * GL_PSG, GL_BUF = GL_EL + 256;
constexpr int GL_TOT = 3 * GL_BUF, GL_PART = GL_TOT + 2 * 2048, GL_END = GL_PART + 2 * 512;
static_assert(GL_BUF % 16 == 0 && GL_END <= RING_BYTES, "GLA LDS map");

__device__ __forceinline__ void gla_fast_block(const Ctx& c, int e, int item) {
    unsigned char* ws = c.ws;
    const bf16* P = (const bf16*)(ws + WS_R + R_P); const float* LA = (const float*)(ws + WS_R + R_LA); bf16* MIX = (bf16*)(ws + WS_R + R_MIX);
    const int b = item >> 2, hh = item & 3, row0 = b * 2048;
    const int lane = c.lane, r32 = lane & 31, h = lane >> 5, wv = c.wave;
    LAS unsigned char* L = c.lds + RING_OFF;
    const int i16 = lane & 15, tq = i16 >> 2, tp = i16 & 3, blk = (lane >> 4) & 1;
    const bool consumer = wv < 4;
    if (consumer) {
        const int et = wv & 3;
        f32x16 S0, S1, O;
#pragma unroll
        for (int r = 0; r < 16; ++r) { S0[r] = 0.f; S1[r] = 0.f; O[r] = 0.f; }
        float gh[16];
#pragma unroll
        for (int r = 0; r < 16; ++r) gh[r] = c.in[11][e * 512 + hh * 128 + 32 * et + (r & 3) + 8 * (r >> 2) + 4 * h];
        v2u sgr[4] = {{0u, 0u}, {0u, 0u}, {0u, 0u}, {0u, 0u}};
        __syncthreads(); __syncthreads();
        for (int n = 0; n <= 64; ++n) {
            if (n > 0) {
                const LAS float* part = (const LAS float*)(L + GL_PART + ((n - 1) & 1) * 512);
                const float tot = (part[r32] + part[32 + r32]) + (part[64 + r32] + part[96 + r32]);
                const float rs = rsqrtf(tot * (1.0f / 128.0f) + EPS);
                bf16* dst = MIX + (size_t)(row0 + 32 * (n - 1) + r32) * 1024 + hh * 128 + 32 * et + 4 * h;
#pragma unroll
                for (int g4 = 0; g4 < 4; ++g4) { const v2u sg = sgr[g4];
                    v2u ov; ov.x = cvtpk(O[4 * g4] * rs * gh[4 * g4] * bflo(sg.x), O[4 * g4 + 1] * rs * gh[4 * g4 + 1] * bfhi(sg.x));
                    ov.y = cvtpk(O[4 * g4 + 2] * rs * gh[4 * g4 + 2] * bflo(sg.y), O[4 * g4 + 3] * rs * gh[4 * g4 + 3] * bfhi(sg.y));
                    *(v2u*)(dst + 8 * g4) = ov; }
            }
            if (n < 64) {
                const int bo = (n % 3) * GL_BUF;
                const LAS unsigned char* Qs = L + bo + GL_QS; const LAS unsigned char* Ks = L + bo + GL_KS; const LAS unsigned char* Vi = L + bo + GL_V;
                f32x16 X;
#pragma unroll
                for (int r = 0; r < 16; ++r) X[r] = 0.f;
#pragma unroll
                for (int s = 0; s < 4; ++s) { const bf16x8 ka = *(const LAS bf16x8*)(Ks + r32 * GL_PQ + 32 * s + 16 * h), qb = *(const LAS bf16x8*)(Qs + r32 * GL_PQ + 32 * s + 16 * h); X = MFMA32(ka, qb, X); }
#pragma unroll
                for (int r = 0; r < 16; ++r) { const int j = (r & 3) + 8 * (r >> 2) + 4 * h; X[r] = (j <= r32) ? X[r] : 0.f; }
                const bf16x8 px0 = pack_step<0>(X), px1 = pack_step<1>(X);
#pragma unroll
                for (int r = 0; r < 16; ++r) O[r] = 0.f;
                { const LAS unsigned char* vb = Vi + (4 * h + tq) * GL_PV + (32 * et + 16 * blk + 4 * tp) * 2;
                  const bf16x8 a0 = cat8(trr(vb), trr(vb + 8 * GL_PV)), a1 = cat8(trr(vb + 16 * GL_PV), trr(vb + 24 * GL_PV));
                  O = MFMA32(a0, px0, O); O = MFMA32(a1, px1, O); }
                { const LAS unsigned char* qp = Qs + r32 * GL_PQ + 8 * h;
                  const bf16x8 sa0 = pack_step<0>(S0), sa1 = pack_step<1>(S0), sa2 = pack_step<0>(S1), sa3 = pack_step<1>(S1);
                  const bf16x8 b0 = cat8u(*(const LAS v2u*)(qp), *(const LAS v2u*)(qp + 16)), b1 = cat8u(*(const LAS v2u*)(qp + 32), *(const LAS v2u*)(qp + 48));
                  const bf16x8 b2 = cat8u(*(const LAS v2u*)(qp + 64), *(const LAS v2u*)(qp + 80)), b3 = cat8u(*(const LAS v2u*)(qp + 96), *(const LAS v2u*)(qp + 112));
                  O = MFMA32(sa0, b0, O); O = MFMA32(sa1, b1, O); O = MFMA32(sa2, b2, O); O = MFMA32(sa3, b3, O); }
                { const LAS unsigned char* kb = Ks + (8 * h + tq) * GL_PQ + (16 * blk + 4 * tp) * 2; const LAS unsigned char* vb = Vi + (8 * h + tq) * GL_PV + (32 * et + 16 * blk + 4 * tp) * 2;
                  const bf16x8 v0 = cat8(trr(vb), trr(vb + 4 * GL_PV)), v1 = cat8(trr(vb + 16 * GL_PV), trr(vb + 20 * GL_PV));
                  const bf16x8 k00 = cat8(trr(kb), trr(kb + 4 * GL_PQ)), k01 = cat8(trr(kb + 16 * GL_PQ), trr(kb + 20 * GL_PQ));
                  const bf16x8 k10 = cat8(trr(kb + 64), trr(kb + 64 + 4 * GL_PQ)), k11 = cat8(trr(kb + 64 + 16 * GL_PQ), trr(kb + 64 + 20 * GL_PQ));
                  S0 = MFMA32(k00, v0, S0); S0 = MFMA32(k01, v1, S0); S1 = MFMA32(k10, v0, S1); S1 = MFMA32(k11, v1, S1);
                  const LAS float* el = (const LAS float*)(L + bo + GL_EL);
#pragma unroll
                  for (int g4 = 0; g4 < 4; ++g4) { const f32x4 f0 = *(const LAS f32x4*)(el + 8 * g4 + 4 * h), f1 = *(const LAS f32x4*)(el + 32 + 8 * g4 + 4 * h);
#pragma unroll
                      for (int q = 0; q < 4; ++q) { S0[4 * g4 + q] *= f0[q]; S1[4 * g4 + q] *= f1[q]; } } }
                float ss = 0.f;
#pragma unroll
                for (int r = 0; r < 16; ++r) ss += O[r] * O[r];
                ss += __shfl_xor(ss, 32);
                if (h == 0) *(LAS float*)(L + GL_PART + (n & 1) * 512 + (et * 32 + r32) * 4) = ss;
                { const LAS unsigned char* sgp = L + bo + GL_SG + r32 * GL_PSG + (32 * et + 4 * h) * 2;
#pragma unroll
                  for (int g4 = 0; g4 < 4; ++g4) sgr[g4] = *(const LAS v2u*)(sgp + 16 * g4); }
                asm volatile("s_waitcnt lgkmcnt(0)" ::: "memory");
                __syncthreads();
            }
        }
        float* dst = c.out + OUT_GLAP + (((size_t)e * 8 + b) * 4 + hh) * 8192 + 32 * et + r32;
#pragma unroll
        for (int r = 0; r < 16; ++r) { const int d = (r & 3) + 8 * (r >> 2) + 4 * h; dst[(size_t)d * 128] = S0[r]; dst[(size_t)(32 + d) * 128] = S1[r]; }
    } else {
        const int pt = c.tid - 256, dp = pt & 31, jq = (pt >> 5) & 7;
        f32x2_t la2[4][4]; unsigned q2[4][4], k2[4][4]; v4u vraw[4][2], graw[4][2];
#define GLA_LOAD(chunk, RS) do { const size_t rb_ = (size_t)(row0 + 32 * (chunk)); \
        _Pragma("unroll") for (int j_ = 0; j_ < 4; ++j_) { const size_t rw_ = rb_ + 4 * jq + j_; \
            la2[RS][j_] = *(const f32x2_t*)(LA + rw_ * 256 + hh * 64 + 2 * dp); q2[RS][j_] = *(const unsigned*)(P + rw_ * 2048 + hh * 64 + 2 * dp); k2[RS][j_] = *(const unsigned*)(P + rw_ * 2048 + 256 + hh * 64 + 2 * dp); } \
        _Pragma("unroll") for (int x_ = 0; x_ < 2; ++x_) { const int pc_ = pt + 256 * x_, j_ = pc_ >> 4, e8_ = pc_ & 15; \
            vraw[RS][x_] = *(const v4u*)(P + (rb_ + j_) * 2048 + 512 + hh * 128 + 8 * e8_); graw[RS][x_] = *(const v4u*)(P + (rb_ + j_) * 2048 + 1024 + hh * 128 + 8 * e8_); } } while (0)
#define GLA_PROD1(ck, RS) do { const int bufo_ = ((ck) % 3) * GL_BUF; \
        _Pragma("unroll") for (int x_ = 0; x_ < 2; ++x_) { const int pc_ = pt + 256 * x_, j_ = pc_ >> 4, e8_ = pc_ & 15; \
            *(LAS v4u*)(L + bufo_ + GL_V + j_ * GL_PV + 16 * e8_) = vraw[RS][x_]; *(LAS v4u*)(L + bufo_ + GL_SG + j_ * GL_PSG + 16 * e8_) = graw[RS][x_]; } \
        *(LAS f32x2_t*)(L + GL_TOT + ((ck) & 1) * 2048 + (jq * 64 + 2 * dp) * 4) = (f32x2_t){(la2[RS][0].x + la2[RS][1].x) + (la2[RS][2].x + la2[RS][3].x), (la2[RS][0].y + la2[RS][1].y) + (la2[RS][2].y + la2[RS][3].y)}; } while (0)
#define GLA_PROD2(ck, RS) do { const int bufo_ = ((ck) % 3) * GL_BUF; float p0_ = 0.f, p1_ = 0.f, t0_ = 0.f, t1_ = 0.f; \
        _Pragma("unroll") for (int g_ = 0; g_ < 8; ++g_) { const f32x2_t tv_ = *(const LAS f32x2_t*)(L + GL_TOT + ((ck) & 1) * 2048 + (g_ * 64 + 2 * dp) * 4); if (g_ < jq) { p0_ += tv_.x; p1_ += tv_.y; } t0_ += tv_.x; t1_ += tv_.y; } \
        float c0_ = p0_, c1_ = p1_; \
        _Pragma("unroll") for (int j_ = 0; j_ < 4; ++j_) { c0_ += la2[RS][j_].x; c1_ += la2[RS][j_].y; \
            const float q0_ = bflo(q2[RS][j_]) * __expf(c0_) * 0.125f, q1_ = bfhi(q2[RS][j_]) * __expf(c1_) * 0.125f, k0_ = bflo(k2[RS][j_]) * __expf(-c0_), k1_ = bfhi(k2[RS][j_]) * __expf(-c1_); \
            *(LAS unsigned*)(L + bufo_ + GL_QS + (4 * jq + j_) * GL_PQ + 4 * dp) = cvtpk(q0_, q1_); *(LAS unsigned*)(L + bufo_ + GL_KS + (4 * jq + j_) * GL_PQ + 4 * dp) = cvtpk(k0_, k1_); } \
        if (jq == 0) *(LAS f32x2_t*)(L + bufo_ + GL_EL + 8 * dp) = (f32x2_t){__expf(t0_), __expf(t1_)}; } while (0)
#define GLA_PITER(n, S1, S2) do { \
            if ((n) + 2 < 64) GLA_PROD1((n) + 2, S2); \
            if ((n) + 1 < 64) GLA_PROD2((n) + 1, S1); \
            if ((n) + 5 < 64) GLA_LOAD((n) + 5, S1); \
            asm volatile("s_waitcnt lgkmcnt(0)" ::: "memory"); \
            __syncthreads(); } while (0)
        GLA_LOAD(0, 0); GLA_LOAD(1, 1); GLA_LOAD(2, 2); GLA_LOAD(3, 3);
        GLA_PROD1(0, 0); asm volatile("s_waitcnt lgkmcnt(0)" ::: "memory"); __syncthreads();
        GLA_PROD1(1, 1); GLA_PROD2(0, 0); GLA_LOAD(4, 0); asm volatile("s_waitcnt lgkmcnt(0)" ::: "memory"); __syncthreads();
        for (int nn = 0; nn < 64; nn += 4) { GLA_PITER(nn, 1, 2); GLA_PITER(nn + 1, 2, 3); GLA_PITER(nn + 2, 3, 0); GLA_PITER(nn + 3, 0, 1); }
#undef GLA_PITER
#undef GLA_LOAD
#undef GLA_PROD1
#undef GLA_PROD2
    }
}
constexpr int S5_PBU = 144, S5_PH = 72;
__device__ __forceinline__ float fma_s(float a, float b, float c) { float r; asm("v_fma_f32 %0, %1, %2, %3" : "=v"(r) : "v"(a), "v"(b), "v"(c)); return r; }
constexpr int S5P_ITEM_LDS = 2 * (128 * S5_PBU + 128 * S5_PH);
__device__ __forceinline__ void s5_pipe_block(const Ctx& c, int e, int item0) {
    unsigned char* ws = c.ws; const int lane = c.lane, r32 = lane & 31, h = lane >> 5, wv = c.wave;
    const bf16* P = (const bf16*)(ws + WS_R + R_P); bf16* Z1 = (bf16*)(ws + WS_R + R_Z1);
    const int slot = wv / 3, role = (wv < 6) ? wv - 3 * slot : 3, item = item0 + (slot & 1);
    const int b = item >> 5, g = item & 31, row0 = b * 2048, eg = e * 32 + g;
    LAS unsigned char* BU0 = c.lds + RING_OFF + (slot & 1) * S5P_ITEM_LDS; LAS unsigned char* HB0 = BU0 + 2 * 128 * S5_PBU;
    bf16x8 Bf[4], Cf[8]; float dsk[8]; float ar = 0.f, ai = 0.f, nai = 0.f, hre = 0.f, him = 0.f;
#pragma unroll
    for (int nt = 0; nt < 4; ++nt) Bf[nt] = (bf16x8){0, 0, 0, 0, 0, 0, 0, 0};
#pragma unroll
    for (int s8 = 0; s8 < 8; ++s8) { Cf[s8] = (bf16x8){0, 0, 0, 0, 0, 0, 0, 0}; dsk[s8] = 0.f; }
    if (role == 0) {
#pragma unroll
        for (int nt = 0; nt < 4; ++nt) { const int n = 32 * nt + r32; const float* src = (const float*)(ws + (n < 64 ? CTL_S5BRE : CTL_S5BIM)) + ((size_t)eg * 64 + (n & 63)) * 16 + 8 * h;
            const f32x4 x0 = *(const f32x4*)src, x1 = *(const f32x4*)(src + 4); v4u w; w.x = cvtpk(x0[0], x0[1]); w.y = cvtpk(x0[2], x0[3]); w.z = cvtpk(x1[0], x1[1]); w.w = cvtpk(x1[2], x1[3]); Bf[nt] = __builtin_bit_cast(bf16x8, w); }
    } else if (role == 1) {
        const float* AB = (const float*)(ws + CTL_S5AB); ar = AB[2 * (eg * 64 + lane)]; ai = AB[2 * (eg * 64 + lane) + 1]; nai = -ai;
    } else if (role == 2) {
#pragma unroll
        for (int s8 = 0; s8 < 8; ++s8) { const int n0 = 16 * s8 + 8 * h; v4u w = {0u, 0u, 0u, 0u};
            if (r32 < 16) { const float* src = (n0 < 64 ? c.in[17] : c.in[18]) + ((size_t)eg * 16 + r32) * 64 + (n0 & 63); const float sg = (n0 < 64) ? 1.f : -1.f;
                const f32x4 x0 = *(const f32x4*)src * sg, x1 = *(const f32x4*)(src + 4) * sg; w.x = cvtpk(x0[0], x0[1]); w.y = cvtpk(x0[2], x0[3]); w.z = cvtpk(x1[0], x1[1]); w.w = cvtpk(x1[2], x1[3]); }
            Cf[s8] = __builtin_bit_cast(bf16x8, w); }
#pragma unroll
        for (int r = 0; r < 8; ++r) dsk[r] = c.in[19][eg * 16 + (r & 3) + 8 * (r >> 2) + 4 * h];
    }
    const bf16* up = P + (size_t)row0 * 2048 + 1536 + g * 16 + (size_t)r32 * 2048;
    v4u ucur = {0u, 0u, 0u, 0u}; v2u ua = {0u, 0u}, ub = {0u, 0u};
    if (role == 0) ucur = *(const v4u*)(up + 8 * h);
    for (int step = 0; step < 66; ++step) {
        if (role == 0 && step < 64) {
            const int n = step; LAS unsigned char* BU = BU0 + (n & 1) * 128 * S5_PBU;
            const v4u unext = (n < 63) ? *(const v4u*)(up + 8 * h + (size_t)(n + 1) * 32 * 2048) : ucur;
            const bf16x8 uf = __builtin_bit_cast(bf16x8, ucur);
#pragma unroll
            for (int nt = 0; nt < 4; ++nt) { f32x16 z;
#pragma unroll
                for (int r = 0; r < 16; ++r) z[r] = 0.f;
                const f32x16 d = MFMA32(uf, Bf[nt], z);
#pragma unroll
                for (int q = 0; q < 4; ++q) *(LAS f32x4*)(BU + (32 * nt + r32) * S5_PBU + (8 * q + 4 * h) * 4) = (f32x4){d[4 * q], d[4 * q + 1], d[4 * q + 2], d[4 * q + 3]}; }
            ucur = unext;
        } else if (role == 1 && step >= 1 && step < 65) {
            const int n = step - 1; const LAS unsigned char* BU = BU0 + (n & 1) * 128 * S5_PBU; LAS unsigned char* HB = HB0 + (n & 1) * 128 * S5_PH;
            f32x4 br4[8], bi4[8];
#pragma unroll
            for (int k = 0; k < 8; ++k) { br4[k] = *(const LAS f32x4*)(BU + lane * S5_PBU + 16 * k); bi4[k] = *(const LAS f32x4*)(BU + (64 + lane) * S5_PBU + 16 * k); }
            asm volatile("s_waitcnt lgkmcnt(0)" ::: "memory");
#pragma unroll
            for (int t = 0; t < 32; t += 2) {
                const float a0 = fma_s(ar, hre, br4[t >> 2][t & 3]), a1 = fma_s(ar, him, bi4[t >> 2][t & 3]); const float re0 = fma_s(nai, him, a0), im0 = fma_s(ai, hre, a1);
                const float b0 = fma_s(ar, re0, br4[t >> 2][(t & 3) + 1]), b1 = fma_s(ar, im0, bi4[t >> 2][(t & 3) + 1]); const float re1 = fma_s(nai, im0, b0), im1 = fma_s(ai, re0, b1);
                hre = re1; him = im1;
                *(LAS unsigned*)(HB + lane * S5_PH + 2 * t) = cvtpk(re0, re1); *(LAS unsigned*)(HB + (64 + lane) * S5_PH + 2 * t) = cvtpk(im0, im1); }
        } else if (role == 2) {
            if (step >= 2) {
                const int n = step - 2; const LAS unsigned char* HB = HB0 + (n & 1) * 128 * S5_PH;
                f32x16 y;
#pragma unroll
                for (int r = 0; r < 16; ++r) y[r] = 0.f;
#pragma unroll
                for (int s8 = 0; s8 < 8; ++s8) { const LAS unsigned char* hp = HB + (16 * s8 + 8 * h + ((lane & 15) >> 2)) * S5_PH + (16 * ((lane >> 4) & 1) + 4 * (lane & 3)) * 2;
                    const bf16x8 hb = cat8(trr(hp), trr(hp + 4 * S5_PH)); y = MFMA32(Cf[s8], hb, y); }
                const float u0 = bflo(ua.x), u1 = bfhi(ua.x), u2 = bflo(ua.y), u3 = bfhi(ua.y), u4 = bflo(ub.x), u5 = bfhi(ub.x), u6 = bflo(ub.y), u7 = bfhi(ub.y);
                v2u o0, o1;
                o0.x = cvtpk(gelu_tanh_f(y[0] + dsk[0] * u0), gelu_tanh_f(y[1] + dsk[1] * u1)); o0.y = cvtpk(gelu_tanh_f(y[2] + dsk[2] * u2), gelu_tanh_f(y[3] + dsk[3] * u3));
                o1.x = cvtpk(gelu_tanh_f(y[4] + dsk[4] * u4), gelu_tanh_f(y[5] + dsk[5] * u5)); o1.y = cvtpk(gelu_tanh_f(y[6] + dsk[6] * u6), gelu_tanh_f(y[7] + dsk[7] * u7));
                bf16* zp = Z1 + (size_t)(row0 + 32 * n + r32) * 512 + g * 16 + 4 * h;
                *(v2u*)zp = o0; *(v2u*)(zp + 8) = o1;
            }
            if (step >= 1 && step < 65) { const bf16* q = up + 4 * h + (size_t)(step - 1) * 32 * 2048; ua = *(const v2u*)q; ub = *(const v2u*)(q + 8); }
        }
        __syncthreads();
    }
    if (role == 1) { c.out[OUT_REP + ((size_t)(e * 8 + b) * 32 + g) * 64 + lane] = hre; c.out[OUT_IMP + ((size_t)(e * 8 + b) * 32 + g) * 64 + lane] = him; }
}
__device__ __forceinline__ void even_mixer_v2(const Ctx& c, int e) {
    const int bid = (c.vcu & 31) * 8 + (c.vcu >> 5);
    if (bid < 32) { gla_fast_block(c, e, bid); }
    else if (bid < 160) {
        s5_pipe_block(c, e, (bid - 32) * 2);
    }
    else { for (int bi = bid - 160; bi < 128; bi += 96) { gla_naive_block(c, e, bi * 4, true); __syncthreads(); }
           for (int it = (bid - 160) * 8 + c.wave; it < 4096; it += 96 * 8) s5_naive_wave(c, e, it, true, (LAS float*)(c.lds + RING_OFF) + c.wave * 3200); }
}
typedef float f32x16s __attribute__((ext_vector_type(16)));
__device__ __forceinline__ float sq8(const v4u& w) { float s = 0.f;
#pragma unroll
    for (int q = 0; q < 4; ++q) { const float a = bflo(w[q]), b = bfhi(w[q]); s += a * a + b * b; }
    return s; }
template <int TN, bool NORM_A, class Epi> __device__ __forceinline__ void sgemm2(const Ctx& c, const bf16* A, const bf16* Bt, int N, int K, const Epi& E, int first_tile, int tile_stride, int ld = 0) {
    if (ld == 0) ld = K;
    constexpr int ROWS = 64 + TN, NP = ROWS * 16 / 512, PITCH = 272, BUFB = ROWS * PITCH, NSUB = TN / 32, KPARTS = 4 / NSUB, KSTEPS = 8 / KPARTS;
    const int lane = c.lane, r32 = lane & 31, h = lane >> 5, wv = c.wave, tid = c.tid;
    LAS unsigned char* L = c.lds + RING_OFF;
    const int wm = wv & 1, wn = (NSUB == 2) ? ((wv >> 1) & 1) : 0, kp = (NSUB == 2) ? (wv >> 2) : (wv >> 1);
    const int ntiles = 8 * (N / TN), nch = K / 128;
    for (int tile = first_tile; tile < ntiles; tile += tile_stride) {
        const int rb = tile & 7, cb = tile >> 3;
        const unsigned char* src[NP]; int dst[NP];
#pragma unroll
        for (int i = 0; i < NP; ++i) { const int p = tid + 512 * i, row = p >> 4, c16 = p & 15;
            src[i] = (const unsigned char*)((row < 64) ? A + (size_t)(64 * rb + row) * ld : Bt + (size_t)(TN * cb + row - 64) * ld) + 16 * c16; dst[i] = row * PITCH + 16 * c16; }
        v4u ra[NP], rb_[NP], rc_[NP], rd_[NP];
#pragma unroll
        for (int i = 0; i < NP; ++i) { ra[i] = *(const v4u*)(src[i]); rb_[i] = *(const v4u*)(src[i] + 256); rc_[i] = *(const v4u*)(src[i] + 512); rd_[i] = *(const v4u*)(src[i] + 768); }
#pragma unroll
        for (int i = 0; i < NP; ++i) *(LAS v4u*)(L + dst[i]) = ra[i];
        float ssa0 = 0.f, ssa1 = 0.f;
        if (NORM_A) { ssa0 = sq8(ra[0]); ssa1 = sq8(ra[1]); }
        f32x16s acc;
#pragma unroll
        for (int r = 0; r < 16; ++r) acc[r] = 0.f;
        __syncthreads();
#define SG_STEP(ch, RCUR, RNEXT) do { \
            if ((ch) + 4 < nch) { _Pragma("unroll") for (int i = 0; i < NP; ++i) RCUR[i] = *(const v4u*)(src[i] + (size_t)((ch) + 4) * 256); } \
            { const LAS unsigned char* bufp = L + ((ch) & 1) * BUFB; \
              _Pragma("unroll") for (int s = 0; s < KSTEPS; ++s) { const int ks = kp * KSTEPS + s; \
                  const bf16x8 fa = *(const LAS bf16x8*)(bufp + (32 * wm + r32) * PITCH + 32 * ks + 16 * h), fb = *(const LAS bf16x8*)(bufp + (64 + 32 * wn + r32) * PITCH + 32 * ks + 16 * h); \
                  acc = __builtin_amdgcn_mfma_f32_32x32x16_bf16(fa, fb, acc, 0, 0, 0); } } \
            if ((ch) + 1 < nch) { _Pragma("unroll") for (int i = 0; i < NP; ++i) *(LAS v4u*)(L + (((ch) + 1) & 1) * BUFB + dst[i]) = RNEXT[i]; if (NORM_A) { ssa0 += sq8(RNEXT[0]); ssa1 += sq8(RNEXT[1]); } } \
            __syncthreads(); } while (0)
        for (int ch = 0; ch < nch; ch += 4) { SG_STEP(ch, ra, rb_); SG_STEP(ch + 1, rb_, rc_); SG_STEP(ch + 2, rc_, rd_); SG_STEP(ch + 3, rd_, ra); }
#undef SG_STEP
        LAS float* red = (LAS float*)L;
#pragma unroll
        for (int r = 0; r < 16; ++r) red[wv * 1024 + ((r & 3) + 8 * (r >> 2) + 4 * h) * 32 + r32] = acc[r];
        if (NORM_A) {
#pragma unroll
            for (int o = 1; o < 16; o <<= 1) { ssa0 += __shfl_xor(ssa0, o); ssa1 += __shfl_xor(ssa1, o); }
            if ((tid & 15) == 0) { red[8192 + (tid >> 4)] = ssa0; red[8192 + 32 + (tid >> 4)] = ssa1; } }
        __syncthreads();
        if (tid < 64 * (TN / 8)) {
            const int row = tid / (TN / 8), cg = tid % (TN / 8), sm = row >> 5, sn = (8 * cg) >> 5, rr = row & 31, cc = (8 * cg) & 31;
            f32x4 v0 = {0.f, 0.f, 0.f, 0.f}, v1 = {0.f, 0.f, 0.f, 0.f};
#pragma unroll
            for (int q = 0; q < KPARTS; ++q) { const int w = (NSUB == 2) ? (sm + 2 * sn + 4 * q) : (sm + 2 * q);
                v0 = v0 + *(const LAS f32x4*)(red + w * 1024 + rr * 32 + cc); v1 = v1 + *(const LAS f32x4*)(red + w * 1024 + rr * 32 + cc + 4); }
            const int grow = pg8::TP_ROWS + 64 * rb + row; float s = 0.f;
            const float rs = NORM_A ? rsqrtf(red[8192 + row] * (1.0f / 1024.0f) + pg8::EPS_F) : E.row_scale(grow);
            f32x4 cb0, cb1; E.col8(TN * cb + 8 * cg, cb0, cb1);
            const pg8::u32x4 pre = Epi::HAS_PRE ? E.pre8(grow, TN * cb + 8 * cg) : (pg8::u32x4){0u, 0u, 0u, 0u};
            E.row8(grow, TN * cb + 8 * cg, v0, v1, rs, cb0, cb1, pre, s);
        }
        __syncthreads();
    }
}
constexpr int LR_PX = 272, LR_PAB = 264, LR_WAVE = 32 * LR_PX;
constexpr int LR_COMP = 8 * LR_WAVE;
static_assert(32 * LR_PAB <= LR_WAVE && LR_COMP + 4096 + 16384 <= RING_BYTES, "LRU LDS map");
__device__ __forceinline__ void lru_fused(const Ctx& c, int o) {
    unsigned char* ws = c.ws; const int lane = c.lane, r32 = lane & 31, h = lane >> 5, wv = c.wave;
    const bf16* CIN = (const bf16*)(ws + WS_R + R_CIN); const bf16* GT = (const bf16*)(ws + WS_R + R_XC); bf16* HG = (bf16*)(ws + WS_R + R_MIX);
    const int id = c.vcu, b = id >> 5, n = (id >> 2) & 7, cs = id & 3;
    const int chg = 128 * n + 32 * cs + r32;
    LAS unsigned char* XS = c.lds + RING_OFF + wv * LR_WAVE;
    LAS unsigned char* COMP = c.lds + RING_OFF + LR_COMP;
    const bf16* Wg = (const bf16*)(ws + WS_W + W_G) + ((size_t)o * 8 + n) * 256 * 128;
    LAS unsigned char* WF = c.lds + RING_OFF + LR_COMP + 4096;
#pragma unroll
    for (int i = 0; i < 2; ++i) { const int en = c.tid + 512 * i, rw = en >> 9, sk = (en >> 6) & 7, ln = en & 63;
        *(LAS v4u*)(WF + en * 16) = *(const v4u*)(Wg + (size_t)(rw * 128 + 32 * cs + (ln & 31)) * 128 + 16 * sk + 8 * (ln >> 5)); }
    __syncthreads();
    const float brc = c.in[28][o * 1024 + chg], bic = c.in[30][o * 1024 + chg];
    const float sp8 = 8.0f * log1pf(__expf(-c.in[31][o * 1024 + chg]));
    const int c8 = lane & 15, tq = lane >> 4, cch = 128 * n + 8 * c8;
    const float* cw = c.in[25] + (size_t)o * 4 * 1024 + cch; const float* cb = c.in[26] + o * 1024 + cch;
    float hc = 0.f;
    const int ntile = 8 + ((wv < 2) ? 1 : 0);
    for (int tt = 0; tt < 9; ++tt) {
        const bool sample = tt == 8;
        const bool active = tt < ntile;
        const int st = 2 * b + wv;
        const size_t rowb = sample ? (size_t)TP + 32 * st : (size_t)b * 2048 + 256 * tt + 32 * wv;
        float Aw = 1.f, Bw = 0.f, Ao = 1.f, Bo = 0.f;
        unsigned short gt[16];
        if (active) {
            { const size_t orow_ = rowb + 16 * h;
#pragma unroll
              for (int i = 0; i < 16; ++i) gt[i] = GT[(orow_ + i) * 1024 + chg]; }
            { float w0[8], w1[8], w2[8], w3[8], bs[8];
#pragma unroll
              for (int q = 0; q < 2; ++q) { const f32x4 a0 = *(const f32x4*)(cw + 4 * q), a1 = *(const f32x4*)(cw + 1024 + 4 * q), a2 = *(const f32x4*)(cw + 2048 + 4 * q), a3 = *(const f32x4*)(cw + 3072 + 4 * q), bb = *(const f32x4*)(cb + 4 * q);
#pragma unroll
                  for (int i = 0; i < 4; ++i) { w0[4 * q + i] = a0[i]; w1[4 * q + i] = a1[i]; w2[4 * q + i] = a2[i]; w3[4 * q + i] = a3[i]; bs[4 * q + i] = bb[i]; } }
              if (!sample) {
                  v4u xr[11];
#pragma unroll
                  for (int i = 0; i < 11; ++i) { const int tl = 8 * tq + i - 3; xr[i] = (v4u){0u, 0u, 0u, 0u};
                      if (256 * tt + 32 * wv + tl >= 0) xr[i] = *(const v4u*)(CIN + (size_t)((long)rowb + tl) * 1024 + cch); }
#pragma unroll
                  for (int i = 0; i < 8; ++i) { float y[8];
#pragma unroll
                      for (int q = 0; q < 4; ++q) {
                          y[2 * q] = bs[2 * q] + w0[2 * q] * bflo(xr[i][q]) + w1[2 * q] * bflo(xr[i + 1][q]) + w2[2 * q] * bflo(xr[i + 2][q]) + w3[2 * q] * bflo(xr[i + 3][q]);
                          y[2 * q + 1] = bs[2 * q + 1] + w0[2 * q + 1] * bfhi(xr[i][q]) + w1[2 * q + 1] * bfhi(xr[i + 1][q]) + w2[2 * q + 1] * bfhi(xr[i + 2][q]) + w3[2 * q + 1] * bfhi(xr[i + 3][q]); }
                      v4u ov; ov.x = cvtpk(y[0], y[1]); ov.y = cvtpk(y[2], y[3]); ov.z = cvtpk(y[4], y[5]); ov.w = cvtpk(y[6], y[7]);
                      *(LAS v4u*)(XS + (8 * tq + i) * LR_PX + 16 * c8) = ov; }
              } else {
#pragma unroll 1
                  for (int i = 0; i < 8; ++i) {
                      const int bt = 8 * st + 2 * tq + (i >> 2), stp = i & 3; const float* sc = c.in[6] + ((size_t)o * 128 + bt) * 3 * 1024 + cch;
                      float y[8];
#pragma unroll
                      for (int q = 0; q < 8; ++q) y[q] = bs[q];
#pragma unroll
                      for (int j = 0; j < 4; ++j) { const int sj = stp - 3 + j; float x[8];
                          if (sj >= 0) { const v4u x4 = *(const v4u*)(CIN + (rowb + 8 * tq + i - 3 + j) * 1024 + cch);
#pragma unroll
                              for (int q = 0; q < 4; ++q) { x[2 * q] = bflo(x4[q]); x[2 * q + 1] = bfhi(x4[q]); } }
                          else { const f32x4 s0 = *(const f32x4*)(sc + (size_t)(sj + 3) * 1024), s1 = *(const f32x4*)(sc + (size_t)(sj + 3) * 1024 + 4);
#pragma unroll
                              for (int q = 0; q < 4; ++q) { x[q] = s0[q]; x[4 + q] = s1[q]; } }
#pragma unroll
                          for (int q = 0; q < 8; ++q) y[q] += ((j == 0) ? w0[q] : (j == 1) ? w1[q] : (j == 2) ? w2[q] : w3[q]) * x[q]; }
                      v4u ov; ov.x = cvtpk(y[0], y[1]); ov.y = cvtpk(y[2], y[3]); ov.z = cvtpk(y[4], y[5]); ov.w = cvtpk(y[6], y[7]);
                      *(LAS v4u*)(XS + (8 * tq + i) * LR_PX + 16 * c8) = ov; }
              }
            }
            f32x16 accr, acci;
#pragma unroll
            for (int r = 0; r < 16; ++r) { accr[r] = 0.f; acci[r] = 0.f; }
#pragma unroll
            for (int s = 0; s < 8; ++s) { const bf16x8 xa = *(const LAS bf16x8*)(XS + r32 * LR_PX + 32 * s + 16 * h); accr = MFMA32(xa, *(const LAS bf16x8*)(WF + (s * 64 + lane) * 16), accr); acci = MFMA32(xa, *(const LAS bf16x8*)(WF + ((8 + s) * 64 + lane) * 16), acci); }
            float xv[16];
#pragma unroll
            for (int r = 0; r < 16; ++r) xv[r] = bf2f(*(const LAS bf16*)(XS + ((r & 3) + 8 * (r >> 2) + 4 * h) * LR_PX + (32 * cs + r32) * 2));
            asm volatile("s_waitcnt lgkmcnt(0)" ::: "memory");
#pragma unroll
            for (int r = 0; r < 16; ++r) {
                const float rg = sigmoid_f(accr[r] + brc), ig = sigmoid_f(acci[r] + bic);
                const float la = -rg * sp8, a = __expf(la);
                const float bq = __builtin_amdgcn_sqrtf(fmaxf(1.0f - a * a, 0.f)) * ig * xv[r];
                *(LAS f32x2_t*)(XS + ((r & 3) + 8 * (r >> 2) + 4 * h) * LR_PAB + 8 * r32) = (f32x2_t){a, bq};
            }
            asm volatile("s_waitcnt lgkmcnt(0)" ::: "memory");
            if (!sample) {
                float A = 1.f, B = 0.f;
#pragma unroll
                for (int i = 0; i < 16; ++i) { const f32x2_t ab = *(const LAS f32x2_t*)(XS + (16 * h + i) * LR_PAB + 8 * r32); A *= ab.x; B = ab.x * B + ab.y; }
                Ao = __shfl_xor(A, 32); Bo = __shfl_xor(B, 32);
                Aw = A * Ao; Bw = h ? (A * Bo + B) : (Ao * B + Bo);
                if (h == 0) *(LAS f32x2_t*)(COMP + ((tt & 1) * 256 + wv * 32 + r32) * 8) = (f32x2_t){Aw, Bw};
            }
        }
        __syncthreads();
        if (active) {
            float hin;
            if (!sample) {
                float hrun = hc; hin = hc;
#pragma unroll
                for (int w = 0; w < 8; ++w) { const f32x2_t cp = *(const LAS f32x2_t*)(COMP + ((tt & 1) * 256 + w * 32 + r32) * 8); if (w == wv) hin = hrun; hrun = cp.x * hrun + cp.y; }
                hc = hrun;
                if (h) hin = Ao * hin + Bo;
            } else hin = 0.f;
            const size_t orow = rowb + 16 * h;
            float hh = hin;
#pragma unroll
            for (int i = 0; i < 16; ++i) {
                if (sample && (i & 3) == 0) hh = c.in[5][((size_t)o * 128 + 8 * st + 4 * h + (i >> 2)) * 1024 + chg];
                const f32x2_t ab = *(const LAS f32x2_t*)(XS + (16 * h + i) * LR_PAB + 8 * r32);
                hh = ab.x * hh + ab.y;
                HG[(orow + i) * 1024 + chg] = (bf16)cvtpk(bf2f(gt[i]) * hh, 0.f);
                if (sample && (i & 3) == 3) c.out[OUT_LRUS + ((size_t)o * 128 + 8 * st + 4 * h + (i >> 2)) * 1024 + chg] = hh;
            }
            asm volatile("s_waitcnt lgkmcnt(0)" ::: "memory");
        }
    }
    if (wv == 0 && h == 0) c.out[OUT_LRUP + ((size_t)o * 8 + b) * 1024 + chg] = hc;
}
typedef float f32x4g __attribute__((ext_vector_type(4)));
__device__ __forceinline__ void gate_job(const Ctx& c, int e, const float* ssq, int first_tile, int tile_stride) {
    unsigned char* ws = c.ws; const int lane = c.lane, wv = c.wave, l15 = lane & 15, quad = lane >> 4, r32 = lane & 31, h = lane >> 5;
    const bf16* XB = (const bf16*)(ws + WS_XB); float* LA = (float*)(ws + WS_R + R_LA);
    const bf16* WaT = (const bf16*)(ws + WS_WA) + (size_t)e * 16 * 1024;
    const bf16* A2T = (const bf16*)(ws + WS_WA) + 2 * 16 * 1024 + (size_t)e * 256 * 16;
    const float* b_a2 = c.in[10] + e * 256;
    LAS float* part = (LAS float*)(c.lds + RING_OFF);
    LAS bf16* alr = (LAS bf16*)(c.lds + RING_OFF + 32768);
    LAS float* pss = (LAS float*)(c.lds + RING_OFF + 32768 + 2048);
    for (int tile = first_tile; tile < T / 64; tile += tile_stride) {
        const int rowb = 64 * tile;
        bf16x8 bw[4];
#pragma unroll
        for (int s = 0; s < 4; ++s) bw[s] = *(const bf16x8*)(WaT + (size_t)l15 * 1024 + 128 * wv + 32 * s + 8 * quad);
        f32x4g acc[4];
#pragma unroll
        for (int mt = 0; mt < 4; ++mt) { acc[mt] = (f32x4g){0.f, 0.f, 0.f, 0.f};
            bf16x8 xa[4];
#pragma unroll
            for (int s = 0; s < 4; ++s) xa[s] = *(const bf16x8*)(XB + (size_t)(rowb + 16 * mt + l15) * 1024 + 128 * wv + 32 * s + 8 * quad);
#pragma unroll
            for (int s = 0; s < 4; ++s) acc[mt] = __builtin_amdgcn_mfma_f32_16x16x32_bf16(bw[s], xa[s], acc[mt], 0, 0, 0);
            float sq = 0.f;
#pragma unroll
            for (int s = 0; s < 4; ++s) { const v4u w4 = __builtin_bit_cast(v4u, xa[s]);
#pragma unroll
                for (int q = 0; q < 4; ++q) { const float a = bflo(w4[q]), b = bfhi(w4[q]); sq += a * a + b * b; } }
            sq += __shfl_xor(sq, 16); sq += __shfl_xor(sq, 32);
            if (quad == 0) pss[wv * 64 + 16 * mt + l15] = sq; }
#pragma unroll
        for (int mt = 0; mt < 4; ++mt)
#pragma unroll
            for (int q = 0; q < 4; ++q) part[wv * 1024 + (16 * mt + l15) * 16 + 4 * quad + q] = acc[mt][q];
        __syncthreads();
#pragma unroll
        for (int i = 0; i < 2; ++i) { const int idx = c.tid + 512 * i, row = idx >> 4; float s = 0.f;
#pragma unroll
            for (int w = 0; w < 8; ++w) s += part[w * 1024 + idx];
            float sq = 0.f;
#pragma unroll
            for (int w = 0; w < 8; ++w) sq += pss[w * 64 + row];
            const float rs = rsqrtf(sq * (1.0f / 1024.0f) + EPS);
            alr[idx] = (bf16)f2bf(s * rs); }
        __syncthreads();
        { const int rh = wv & 1;
          v4u aw = *(const LAS v4u*)(alr + (32 * rh + r32) * 16 + 8 * h); const bf16x8 af = __builtin_bit_cast(bf16x8, aw);
#pragma unroll
          for (int ct = 0; ct < 2; ++ct) { const int n = 32 * (2 * (wv >> 1) + ct) + r32;
              const bf16x8 bf = *(const bf16x8*)(A2T + (size_t)n * 16 + 8 * h);
              f32x16 z;
#pragma unroll
              for (int r = 0; r < 16; ++r) z[r] = 0.f;
              const f32x16 d = MFMA32(af, bf, z);
              const float bn = b_a2[n];
#pragma unroll
              for (int r = 0; r < 16; ++r) { const int row = rowb + 32 * rh + (r & 3) + 8 * (r >> 2) + 4 * h;
                  LA[(size_t)row * 256 + n] = pg8::logsigmoid_f(d[r] + bn) * 0.0625f; } } }
        __syncthreads();
    }
}
#ifndef REP_PROL
#define REP_PROL 1
#endif
#ifndef REP_IN
#define REP_IN 1
#endif
#ifndef REP_EMIX
#define REP_EMIX 1
#endif
#ifndef REP_GLU
#define REP_GLU 1
#endif
#ifndef REP_CONV
#define REP_CONV 1
#endif
#ifndef REP_GATES
#define REP_GATES 1
#endif
#ifndef REP_UP
#define REP_UP 1
#endif
#ifndef REP_LRU
#define REP_LRU 1
#endif
constexpr int N_PHASES = 24;
__global__ void __launch_bounds__(NWAVES * 64, 2) mk_fwd(Args args) {
    extern __shared__ __attribute__((aligned(16))) unsigned char lds_raw[];
    const int wave_s_ = __builtin_amdgcn_readfirstlane((int)threadIdx.x >> 6);
#define TID_NOW(var) int var; { int l_; asm volatile("v_mbcnt_lo_u32_b32 %0, -1, 0\n\tv_mbcnt_hi_u32_b32 %0, -1, %0" : "=v"(l_)); var = (wave_s_ << 6) | l_; }
    const int lo = args.ph_lo, hi = args.ph_hi;
    {
        LAS unsigned char* l0 = (LAS unsigned char*)lds_raw;
        TID_NOW(t0_)
        for (int u = t0_; u < (LDS_BYTES - LDSCTL_OFF) / 4; u += NWAVES * 64) ((LAS unsigned*)(l0 + LDSCTL_OFF))[u] = 0u;
        __syncthreads();
    }
    XcdBarrier bar; bar.bar = (unsigned*)(args.ws + WS_CTL) + CW_BAR + args.li * XCD_BAR_WORDS; bar.x = 0; bar.st = nullptr;
    TID_NOW(t0b_)
    if (hi - lo > 1) bar = xcd_barrier_post((unsigned*)(args.ws + WS_CTL) + CW_BAR + args.li * XCD_BAR_WORDS, (volatile LAS unsigned*)((LAS unsigned char*)lds_raw + MISC_OFF) + 8, t0b_);
    int pc = 0;
#define PHASE_BEGINR(R) { int pc_ = pc; asm volatile("" : "+s"(pc_)); if (pc_ >= lo && pc_ < hi) { for (int rep_ = 0; rep_ < (R); ++rep_) { if (rep_) __syncthreads(); unsigned char* wsr_ = args.ws; asm volatile("" : "+s"(wsr_)); unsigned char* ws = as_global(wsr_); float* outr_ = args.out; asm volatile("" : "+s"(outr_)); float* out_ = as_global(outr_); \
    TID_NOW(t_) int bx = blockIdx.x; asm volatile("" : "+s"(bx)); int G_ = gridDim.x; asm volatile("" : "+s"(G_)); \
    Ctx c; c.var = args.pad; c.in.p = args.in; c.out = out_; c.ws = ws; c.lds = (LAS unsigned char*)lds_raw; c.tid = t_; c.lane = c.tid & 63; c.wave = __builtin_amdgcn_readfirstlane(c.tid >> 6); \
    c.G = G_; c.vcu = (c.G % 8 == 0) ? (bx % 8) * (c.G / 8) + bx / 8 : bx; c.gw = c.vcu * NWAVES + c.wave; c.NGW = c.G * NWAVES; \
    PG8_LAS unsigned char* ring = (PG8_LAS unsigned char*)(c.lds + RING_OFF); (void)ring; \
    bf16* XB = (bf16*)(ws + WS_XB); float* X = c.out; float* ssq = (float*)(ws + WS_SSQ); bf16* MIX = (bf16*)(ws + WS_R + R_MIX); (void)XB; (void)X; (void)ssq; (void)MIX;
#define PHASE_BEGIN PHASE_BEGINR(1)
#define PHASE_END   } if (pc_ + 1 < hi) { TID_NOW(tb_) xcd_barrier(bar, tb_); } } } ++pc;

    PHASE_BEGINR(REP_PROL) p0_prologue(c); PHASE_END

    for (int l = 0; l < 4; ++l) {
        const int hf = l >> 1;
        if ((l & 1) == 0) {
            PHASE_BEGINR(REP_IN)
                const bf16* wt = (const bf16*)(ws + WS_W + W_INE) + (size_t)hf * NIN_E * 1024; pg8::Gemm g{XB, wt, TP, 2048, 1024, 1024}; pg8::StaticOrder S; S.init(TP, 2048, c.G, bx);
                pg8::EpiInE E{(bf16*)(ws + WS_R + R_P), ssq + (size_t)(2 * l) * 4 * T};
                if (bx & 1) { if (l == 0) p0_weights_rest(c); gate_job(c, hf, ssq + (size_t)(2 * l) * 4 * T, bx, c.G); sgemm2<64, true>(c, XB + (size_t)TP * 1024, wt, 2048, 1024, E, bx, c.G); pg8::gemm_phase<pg8::EpiInE, pg8::StaticOrder, true, true>(ring, g, S, E, c.tid); }
                else { pg8::gemm_phase<pg8::EpiInE, pg8::StaticOrder, true, true>(ring, g, S, E, c.tid); sgemm2<64, true>(c, XB + (size_t)TP * 1024, wt, 2048, 1024, E, bx, c.G); gate_job(c, hf, ssq + (size_t)(2 * l) * 4 * T, bx, c.G); if (l == 0) p0_weights_rest(c); }
            PHASE_END
            PHASE_BEGINR(REP_EMIX) even_mixer_v2(c, hf); PHASE_END
            PHASE_BEGINR(REP_GLU)
                gla_post(c, hf);
                bf16* Z1 = (bf16*)(ws + WS_R + R_Z1); const bf16* wt = (const bf16*)(ws + WS_W + W_GLU) + (size_t)hf * 512 * 512; pg8::Gemm g{Z1, wt, TP, 512, 512, 512}; pg8::StaticOrder S; S.init(TP, 512, c.G, bx);
                pg8::EpiGlu E{Z1, MIX, c.in[21] + hf * 512};
                if (bx & 1) { sgemm2<32, false>(c, Z1 + (size_t)TP * 512, wt, 512, 512, E, bx >= 128 ? bx - 128 : (1 << 30), c.G - 128); pg8::gemm_phase<pg8::EpiGlu, pg8::StaticOrder, true, true>(ring, g, S, E, c.tid); }
                else { pg8::gemm_phase<pg8::EpiGlu, pg8::StaticOrder, true, true>(ring, g, S, E, c.tid); sgemm2<32, false>(c, Z1 + (size_t)TP * 512, wt, 512, 512, E, bx >= 128 ? bx - 128 : (1 << 30), c.G - 128); }
            PHASE_END
        } else {
            PHASE_BEGINR(REP_IN)
                const bf16* wt = (const bf16*)(ws + WS_W + W_INO) + (size_t)hf * NIN_O * 1024; pg8::Gemm g{XB, wt, TP, NIN_O, 1024, 1024}; pg8::StaticOrder S; S.init(TP, NIN_O, c.G, bx);
                pg8::EpiInO E{(bf16*)(ws + WS_R + R_XC), (bf16*)(ws + WS_R + R_CIN), ssq + (size_t)(2 * l) * 4 * T, c.out + OUT_CONVP + (size_t)hf * 8 * 3 * 1024, c.out + OUT_CONVS + (size_t)hf * 128 * 3 * 1024};
                if (bx & 1) { sgemm2<64, true>(c, XB + (size_t)TP * 1024, wt, NIN_O, 1024, E, bx, c.G); pg8::gemm_phase<pg8::EpiInO, pg8::StaticOrder, true, true>(ring, g, S, E, c.tid); }
                else { pg8::gemm_phase<pg8::EpiInO, pg8::StaticOrder, true, true>(ring, g, S, E, c.tid); sgemm2<64, true>(c, XB + (size_t)TP * 1024, wt, NIN_O, 1024, E, bx, c.G); }
            PHASE_END
            PHASE_BEGINR(REP_LRU) lru_fused(c, hf); PHASE_END
        }
        PHASE_BEGIN
            const bf16* wo = (l & 1) ? (const bf16*)(ws + WS_W + W_OUTO) + (size_t)hf * 1024 * 1024 : (const bf16*)(ws + WS_W + W_OUTE) + (size_t)hf * 1024 * 1024;
            pg8::Gemm g{MIX, wo, TP, 1024, 1024, 1024}; pg8::StaticOrder S; S.init(TP, 1024, c.G, bx);
            pg8::EpiRes E{XB, ssq + (size_t)(2 * l + 1) * 4 * T};
            if (bx & 1) { sgemm2<32, false>(c, MIX + (size_t)TP * 1024, wo, 1024, 1024, E, bx, c.G); pg8::gemm_phase<pg8::EpiRes, pg8::StaticOrder, false, true>(ring, g, S, E, c.tid); }
            else { pg8::gemm_phase<pg8::EpiRes, pg8::StaticOrder, false, true>(ring, g, S, E, c.tid); sgemm2<32, false>(c, MIX + (size_t)TP * 1024, wo, 1024, 1024, E, bx, c.G); }
        PHASE_END
        PHASE_BEGINR(REP_UP)
            const bf16* wt = (const bf16*)(ws + WS_W + W_UP) + (size_t)l * 4096 * 1024; pg8::Gemm g{XB, wt, TP, FF, 1024, 1024}; pg8::StaticOrder S; S.init(TP, FF, c.G, bx);
            pg8::EpiUp E{(bf16*)(ws + WS_R + R_H), ssq + (size_t)(2 * l + 1) * 4 * T};
            if (bx & 1) { sgemm2<64, true>(c, XB + (size_t)TP * 1024, wt, FF, 1024, E, bx, c.G); pg8::gemm_phase<pg8::EpiUp, pg8::StaticOrder, true, true>(ring, g, S, E, c.tid); }
            else { pg8::gemm_phase<pg8::EpiUp, pg8::StaticOrder, true, true>(ring, g, S, E, c.tid); sgemm2<64, true>(c, XB + (size_t)TP * 1024, wt, FF, 1024, E, bx, c.G); }
        PHASE_END
        PHASE_BEGIN
            const bf16* wt = (const bf16*)(ws + WS_W + W_DN) + (size_t)l * 1024 * LD_FF; pg8::Gemm g{(bf16*)(ws + WS_R + R_H), wt, TP, 1024, FF, LD_FF}; pg8::StaticOrder S; S.init(TP, 1024, c.G, bx);
            pg8::EpiRes E{XB, ssq + (size_t)(2 * l + 2) * 4 * T};
            if (bx & 1) { sgemm2<32, false>(c, (const bf16*)(ws + WS_R + R_H) + (size_t)TP * LD_FF, wt, 1024, FF, E, bx, c.G, LD_FF); pg8::gemm_phase<pg8::EpiRes, pg8::StaticOrder, false, true>(ring, g, S, E, c.tid); }
            else { pg8::gemm_phase<pg8::EpiRes, pg8::StaticOrder, false, true>(ring, g, S, E, c.tid); sgemm2<32, false>(c, (const bf16*)(ws + WS_R + R_H) + (size_t)TP * LD_FF, wt, 1024, FF, E, bx, c.G, LD_FF); }
        PHASE_END
    }
    PHASE_BEGINR(1) final_norm(c); PHASE_END
#undef PHASE_BEGIN
#undef PHASE_BEGINR
#undef PHASE_END
}

#ifndef MK_N_LAUNCHES
#define MK_N_LAUNCHES 1
#endif
extern "C" void kernel_launch(void* const* d_in, const int* in_sizes, int n_in, void* d_out, int out_size, void* d_ws, size_t ws_size, hipStream_t stream) {
    static int grid = 0;
    if (grid == 0) {
        if (n_in != 37 || out_size != (int)OUT_END || ws_size < WS_END) { fprintf(stderr, "kernel_launch: shape mismatch (n_in %d out %d ws %zu)\n", n_in, out_size, ws_size); grid = -1; return; }
        int dev = 0, cus = 0;
        if (hipGetDevice(&dev) != hipSuccess || hipDeviceGetAttribute(&cus, hipDeviceAttributeMultiprocessorCount, dev) != hipSuccess) { grid = -1; return; }
        if (hipFuncSetAttribute((const void*)mk_fwd, hipFuncAttributeMaxDynamicSharedMemorySize, LDS_BYTES) != hipSuccess) { fprintf(stderr, "kernel_launch: hipFuncSetAttribute failed\n"); grid = -1; return; }
        int per_cu = 0;
        if (hipOccupancyMaxActiveBlocksPerMultiprocessor(&per_cu, (const void*)mk_fwd, NWAVES * 64, LDS_BYTES) != hipSuccess || per_cu < 1) fprintf(stderr, "kernel_launch: occupancy query says %d\n", per_cu);
        (void)hipGetLastError();
        grid = cus;
        if (grid != 256) fprintf(stderr, "kernel_launch: %d CUs; this kernel's static work split assumes 256\n", grid);
    }
    if (grid < 0) return;
    if (hipMemsetAsync((char*)d_ws + WS_CTL, 0, CTL_ZERO_BYTES, stream) != hipSuccess) return;
    Args a{};
    for (int i = 0; i < 37; ++i) a.in[i] = (const float*)d_in[i];
    a.out = (float*)d_out; a.ws = (unsigned char*)d_ws;
    if (MK_N_LAUNCHES == 1) { a.ph_lo = 0; a.ph_hi = N_PHASES; hipLaunchKernelGGL(mk_fwd, dim3(grid), dim3(NWAVES * 64), LDS_BYTES, stream, a); }
    else { for (int p = 0; p < N_PHASES; ++p) { a.ph_lo = p; a.ph_hi = p + 1; hipLaunchKernelGGL(mk_fwd, dim3(grid), dim3(NWAVES * 64), LDS_BYTES, stream, a); } }
}
```

```cpp
#include <hip/hip_runtime.h>
#include <cstdio>
#include <cstdint>
namespace pg8 {
#define PG8_LAS __attribute__((address_space(3)))
typedef unsigned short bf16_t;
typedef short bf16x8 __attribute__((ext_vector_type(8)));
typedef float f32x4 __attribute__((ext_vector_type(4)));
typedef unsigned u32x4 __attribute__((ext_vector_type(4)));
constexpr int BM = 256, BK = 64, HALF = 128, HTB = HALF * BK * 2  , STAGE_BYTES = 8 * HTB, NXCD = 8, WGM = 8;

__host__ __device__ __forceinline__ int lds_byte(int r, int c) { const int st = (r >> 4) * 2 + (c >> 5), rr = r & 15, cc = c & 31, ob = rr * 64 + cc * 2; return st * 1024 + (ob ^ (((ob >> 9) & 1) << 5)); }
__host__ __device__ __forceinline__ void stage_rc(int b, int& R, int& C) { const int st = b / 1024, sb = b % 1024, swz = sb ^ (((sb >> 9) & 1) << 5); R = (st >> 1) * 16 + swz / 64; C = (st & 1) * 32 + (swz % 64) / 2; }
__host__ __device__ __forceinline__ int perm32(int rho) { const int n = rho >> 4, i = rho & 15; return 8 * (i >> 2) + 4 * n + (i & 3); }

struct Unit { int pm, pn; };
struct Gemm { const bf16_t* A; const bf16_t* Bt; int M, N, K, ld; };

struct StaticOrder {
    int nM, nN, nwg, G, c;
    __host__ __device__ void init(int M, int N, int G_, int c_) { nM = M / BM; nN = N / BM; nwg = nM * nN; G = G_; c = c_; }
    __host__ __device__ bool next(int i, Unit& u) const {
        const long L = (long)i * G + c; if (L >= nwg) return false;
        int wgid = (int)L; { const int q = nwg / NXCD, r = nwg % NXCD, xcd = wgid % NXCD, off = wgid / NXCD; wgid = (xcd < r ? xcd * (q + 1) : r * (q + 1) + (xcd - r) * q) + off; }
        const int nig = WGM * nN, gid = wgid / nig, fm = gid * WGM, gsz = (nM - fm) < WGM ? (nM - fm) : WGM;
        u.pm = fm + ((wgid % nig) % gsz); u.pn = (wgid % nig) / gsz; return true;
    }
    __device__ __forceinline__ void a_ready(const Unit&) const {}
    __device__ __forceinline__ void done(const Unit&) const {}
};

__device__ __forceinline__ unsigned cvt_pk_bf16(float lo, float hi) { unsigned r; asm volatile("v_cvt_pk_bf16_f32 %0, %1, %2" : "=v"(r) : "v"(lo), "v"(hi)); return r; }
template <class Epi, class Sched, bool ALIGN_EPI = false, bool SP2 = false>
__device__ __forceinline__ void gemm_phase(PG8_LAS unsigned char* lds, const Gemm g, const Sched& S, const Epi& E, int tid_in) {
    int tid_ = tid_in; asm volatile("" : "+v"(tid_));
    const int tid = tid_, wid = __builtin_amdgcn_readfirstlane(tid >> 6), lane = tid & 63, wr = wid >> 2, wc = wid & 3, fr = lane & 15, fq = lane >> 4;
    const int K = g.K, nt = K / BK, LD = g.ld;
    unsigned voffA[2], voffB[2];
#pragma unroll
    for (int i = 0; i < 2; ++i) { int R, C; stage_rc(tid * 16 + i * 8192, R, C); const int Rb = Epi::PERM ? ((R & ~31) + perm32(R & 31)) : R;
        voffA[i] = (unsigned)(R * LD + C) * 2u; voffB[i] = (unsigned)(Rb * LD + C) * 2u; }
    const size_t kstep = (size_t)(BK * 2);
    const size_t hstep = (size_t)HALF * LD * 2;
    const size_t tstep = 2 * hstep;
    const unsigned ldsw = (unsigned)wid * 1024u;
    const int aoff = lds_byte(wr * 64 + fr, fq * 8), boff = lds_byte(wc * 32 + fr, fq * 8);
#define PG8_SA(b, h) (((b) * 2 + (h)) * HTB)
#define PG8_SB(b, h) ((4 + (b) * 2 + (h)) * HTB)
#define PG8_STAGE(bufoff, gbase, voff) do { _Pragma("unroll") for (int _i = 0; _i < 2; ++_i) \
        __builtin_amdgcn_global_load_lds((const unsigned*)((const char*)(gbase) + (voff)[_i]), (PG8_LAS unsigned*)(lds + (bufoff) + ldsw + _i * 8192), 16, 0, 0); } while (0)
#define PG8_LDA(dst, b, h) do { _Pragma("unroll") for (int m = 0; m < 4; ++m) _Pragma("unroll") for (int k = 0; k < 2; ++k) dst[m][k] = *(const PG8_LAS bf16x8*)(lds + PG8_SA(b, h) + aoff + m * 2048 + k * 1024); } while (0)
#define PG8_LDB(dst, b, h) do { _Pragma("unroll") for (int n = 0; n < 2; ++n) _Pragma("unroll") for (int k = 0; k < 2; ++k) dst[n][k] = *(const PG8_LAS bf16x8*)(lds + PG8_SB(b, h) + boff + n * 2048 + k * 1024); } while (0)
#define PG8_MMA(ai, bj, At, Bt) do { __builtin_amdgcn_s_setprio(1); _Pragma("unroll") for (int m = 0; m < 4; ++m) _Pragma("unroll") for (int n = 0; n < 2; ++n) _Pragma("unroll") for (int k = 0; k < 2; ++k) \
        acc[ai][bj][m][n] = __builtin_amdgcn_mfma_f32_16x16x32_bf16(Bt[n][k], At[m][k], acc[ai][bj][m][n], 0, 0, 0); __builtin_amdgcn_s_setprio(0); } while (0)
#define PG8_WAIT_V(n) asm volatile("s_waitcnt vmcnt(" #n ")" ::: "memory")
#define PG8_WAIT_L(n) asm volatile("s_waitcnt lgkmcnt(" #n ")" ::: "memory")
#define PG8_BAR __builtin_amdgcn_s_barrier()
#define PG8_SCHED __builtin_amdgcn_sched_barrier(0)
    Unit cur, nxt; int ui = 0;
    if (!S.next(0, cur)) return;
    f32x4 acc[2][2][4][2];
#pragma unroll
    for (int a = 0; a < 2; ++a)
#pragma unroll
        for (int b = 0; b < 2; ++b)
#pragma unroll
            for (int m = 0; m < 4; ++m)
#pragma unroll
                for (int n = 0; n < 2; ++n) acc[a][b][m][n] = (f32x4){0.f, 0.f, 0.f, 0.f};
    bf16x8 At[4][2], B0[2][2], B1[2][2];
    const char* cA = (const char*)g.A + (size_t)cur.pm * tstep; const char* cB = (const char*)g.Bt + (size_t)cur.pn * tstep;
    S.a_ready(cur);
    if constexpr (SP2) {
        PG8_STAGE(PG8_SB(0, 0), cB, voffB); PG8_STAGE(PG8_SB(0, 1), cB + hstep, voffB); PG8_STAGE(PG8_SA(0, 0), cA, voffA); PG8_STAGE(PG8_SA(0, 1), cA + hstep, voffA);
        if (wr == 1) PG8_BAR;
        PG8_WAIT_V(2); PG8_BAR;
        PG8_STAGE(PG8_SB(1, 0), cB + kstep, voffB); PG8_STAGE(PG8_SA(1, 0), cA + kstep, voffA); PG8_STAGE(PG8_SB(1, 1), cB + hstep + kstep, voffB);
        PG8_WAIT_V(6); PG8_BAR;
    } else {
        PG8_STAGE(PG8_SB(0, 0), cB, voffB); PG8_STAGE(PG8_SA(0, 0), cA, voffA); PG8_STAGE(PG8_SB(0, 1), cB + hstep, voffB); PG8_STAGE(PG8_SA(0, 1), cA + hstep, voffA);
        if (wr == 1) PG8_BAR;
        PG8_WAIT_V(4); PG8_BAR;
        PG8_STAGE(PG8_SB(1, 0), cB + kstep, voffB); PG8_STAGE(PG8_SA(1, 0), cA + kstep, voffA); PG8_STAGE(PG8_SB(1, 1), cB + hstep + kstep, voffB);
        PG8_WAIT_V(6); PG8_BAR;
    }
    for (;;) {
        const bool has_next = S.next(ui + 1, nxt);
        const char* nA = has_next ? (const char*)g.A + (size_t)nxt.pm * tstep : cA; const char* nB = has_next ? (const char*)g.Bt + (size_t)nxt.pn * tstep : cB;
        for (int t = 0; t < nt; t += 2) {
            const bool last = (t == nt - 2);
            const char* a1 = cA + (size_t)(t + 1) * kstep;
            const char* a2 = last ? nA : cA + (size_t)(t + 2) * kstep; const char* b2 = last ? nB : cB + (size_t)(t + 2) * kstep;
            const char* a3 = a2 + kstep; const char* b3 = b2 + kstep;
            if (last && has_next) S.a_ready(nxt);
            if constexpr (SP2) {
            PG8_LDB(B0, 0, 0); PG8_LDB(B1, 0, 1); PG8_SCHED; PG8_LDA(At, 0, 0); PG8_STAGE(PG8_SA(1, 1), a1 + hstep, voffA);
            PG8_WAIT_V(8); PG8_WAIT_L(0); PG8_BAR; PG8_MMA(0, 0, At, B0); PG8_MMA(0, 1, At, B1); PG8_BAR; PG8_SCHED;
            PG8_LDA(At, 0, 1); PG8_STAGE(PG8_SB(0, 0), b2, voffB); PG8_STAGE(PG8_SB(0, 1), b2 + hstep, voffB); PG8_STAGE(PG8_SA(0, 0), a2, voffA);
            PG8_WAIT_V(8); PG8_WAIT_L(0); PG8_BAR; PG8_MMA(1, 0, At, B0); PG8_MMA(1, 1, At, B1); PG8_BAR; PG8_SCHED;
            PG8_LDB(B0, 1, 0); PG8_LDB(B1, 1, 1); PG8_SCHED; PG8_LDA(At, 1, 0); PG8_STAGE(PG8_SA(0, 1), a2 + hstep, voffA);
            PG8_WAIT_V(8); PG8_WAIT_L(0); PG8_BAR; PG8_MMA(0, 0, At, B0); PG8_MMA(0, 1, At, B1); PG8_BAR; PG8_SCHED;
            PG8_LDA(At, 1, 1); PG8_STAGE(PG8_SB(1, 0), b3, voffB); PG8_STAGE(PG8_SB(1, 1), b3 + hstep, voffB); PG8_STAGE(PG8_SA(1, 0), a3, voffA);
            PG8_WAIT_V(8); PG8_WAIT_L(0); PG8_BAR; PG8_MMA(1, 0, At, B0); PG8_MMA(1, 1, At, B1); PG8_BAR; PG8_SCHED;
            } else {
            PG8_LDB(B0, 0, 0); PG8_SCHED; PG8_LDA(At, 0, 0); PG8_STAGE(PG8_SA(1, 1), a1 + hstep, voffA);
            PG8_WAIT_L(8); PG8_BAR; PG8_WAIT_L(0); PG8_MMA(0, 0, At, B0); PG8_BAR; PG8_SCHED;
            PG8_LDB(B1, 0, 1); PG8_STAGE(PG8_SB(0, 0), b2, voffB);
            PG8_BAR; PG8_WAIT_L(0); PG8_MMA(0, 1, At, B1); PG8_BAR;
            PG8_LDA(At, 0, 1); PG8_STAGE(PG8_SA(0, 0), a2, voffA);
            PG8_BAR; PG8_WAIT_L(0); PG8_MMA(1, 0, At, B0); PG8_BAR; PG8_SCHED;
            PG8_STAGE(PG8_SB(0, 1), b2 + hstep, voffB);
            PG8_WAIT_V(6); PG8_BAR; PG8_MMA(1, 1, At, B1); PG8_BAR;
            PG8_LDB(B0, 1, 0); PG8_SCHED; PG8_LDA(At, 1, 0); PG8_STAGE(PG8_SA(0, 1), a2 + hstep, voffA);
            PG8_WAIT_L(8); PG8_BAR; PG8_WAIT_L(0); PG8_MMA(0, 0, At, B0); PG8_BAR; PG8_SCHED;
            PG8_LDB(B1, 1, 1); PG8_STAGE(PG8_SB(1, 0), b3, voffB);
            PG8_BAR; PG8_WAIT_L(0); PG8_MMA(0, 1, At, B1); PG8_BAR;
            PG8_LDA(At, 1, 1); PG8_STAGE(PG8_SA(1, 0), a3, voffA);
            PG8_BAR; PG8_WAIT_L(0); PG8_MMA(1, 0, At, B0); PG8_BAR; PG8_SCHED;
            PG8_STAGE(PG8_SB(1, 1), b3 + hstep, voffB);
            PG8_WAIT_V(6); PG8_BAR; PG8_MMA(1, 1, At, B1); PG8_BAR;
            }
        }
        if constexpr (ALIGN_EPI) { if (wr == 0) PG8_BAR; }
        if constexpr (!Epi::AFTER_DRAIN) { E(acc, cur, wr, wc, fr, fq); S.done(cur); }
        if (!has_next) break;
#pragma unroll
        for (int a = 0; a < 2; ++a)
#pragma unroll
            for (int b = 0; b < 2; ++b)
#pragma unroll
                for (int m = 0; m < 4; ++m)
#pragma unroll
                    for (int n = 0; n < 2; ++n) acc[a][b][m][n] = (f32x4){0.f, 0.f, 0.f, 0.f};
        cur = nxt; cA = nA; cB = nB; ++ui;
        if constexpr (ALIGN_EPI) { if (wr == 1) PG8_BAR; }
    }
    PG8_WAIT_V(0);
    if constexpr (!ALIGN_EPI) { if (wr == 0) PG8_BAR; }
    PG8_BAR;
    if constexpr (Epi::AFTER_DRAIN) { E.fused(acc, cur, wr, wc, fr, fq, lds, wid, lane); S.done(cur); }
#undef PG8_SA
#undef PG8_SB
#undef PG8_STAGE
#undef PG8_LDA
#undef PG8_LDB
#undef PG8_MMA
#undef PG8_WAIT_V
#undef PG8_WAIT_L
#undef PG8_BAR
#undef PG8_SCHED
}
}
#ifndef PG8_SP2
#define PG8_SP2 true
#endif
namespace pg8 {
constexpr int TP_ROWS = 16384, T_ROWS = 16896;
constexpr float EPS_F = 1e-6f;
__device__ __forceinline__ float sigmoid_f(float x) { return __builtin_amdgcn_rcpf(1.0f + __expf(-x)); }
__device__ __forceinline__ float gelu_tanh_f(float x) { const float u = 0.7978845608028654f * (x + 0.044715f * x * x * x); return x * __builtin_amdgcn_rcpf(1.0f + __expf(-2.0f * u)); }
__device__ __forceinline__ float logsigmoid_f(float x) { return fminf(x, 0.f) - __logf(1.0f + __expf(-fabsf(x))); }
__device__ __forceinline__ u32x4 pack8(const f32x4& a, const f32x4& b) { u32x4 w; w.x = cvt_pk_bf16(a[0], a[1]); w.y = cvt_pk_bf16(a[2], a[3]); w.z = cvt_pk_bf16(b[0], b[1]); w.w = cvt_pk_bf16(b[2], b[3]); return w; }
__device__ __forceinline__ void unpack8(const u32x4& w, f32x4& a, f32x4& b) {
    a = (f32x4){__uint_as_float(w.x << 16), __uint_as_float(w.x & 0xffff0000u), __uint_as_float(w.y << 16), __uint_as_float(w.y & 0xffff0000u)};
    b = (f32x4){__uint_as_float(w.z << 16), __uint_as_float(w.z & 0xffff0000u), __uint_as_float(w.w << 16), __uint_as_float(w.w & 0xffff0000u)}; }
__device__ __forceinline__ float ssq4(const float* ssq, int row) { return rsqrtf(((ssq[row] + ssq[T_ROWS + row]) + (ssq[2 * T_ROWS + row] + ssq[3 * T_ROWS + row])) * (1.0f / 1024.0f) + EPS_F); }

template <class E> __device__ __forceinline__ void drive_epi(const E& e, const f32x4 (&acc)[2][2][4][2], const Unit& u, int wr, int wc, int fr, int fq, float (&sums)[8]) {
    const int row0 = u.pm * BM + wr * 64 + fr, col0 = u.pn * BM + wc * 32 + 8 * fq;
    float rs[8]; f32x4 cb0[2], cb1[2];
#pragma unroll
    for (int g = 0; g < 8; ++g) rs[g] = e.row_scale(row0 + (g >> 2) * HALF + (g & 3) * 16);
#pragma unroll
    for (int bj = 0; bj < 2; ++bj) e.col8(col0 + bj * HALF, cb0[bj], cb1[bj]);
#pragma unroll
    for (int hf = 0; hf < 2; ++hf) {
        u32x4 pre[4][2];
        if (E::HAS_PRE) {
#pragma unroll
            for (int m = 0; m < 4; ++m)
#pragma unroll
                for (int bj = 0; bj < 2; ++bj) pre[m][bj] = e.pre8(row0 + hf * HALF + m * 16, col0 + bj * HALF);
        }
#pragma unroll
        for (int m = 0; m < 4; ++m) { const int g = 4 * hf + m, row = row0 + hf * HALF + m * 16; float s = 0.f;
#pragma unroll
            for (int bj = 0; bj < 2; ++bj) e.row8(row, col0 + bj * HALF, acc[hf][bj][m][0], acc[hf][bj][m][1], rs[g], cb0[bj], cb1[bj], E::HAS_PRE ? pre[m][bj] : (u32x4){0u, 0u, 0u, 0u}, s);
            sums[g] = s; }
        if (E::HAS_PRE) asm volatile("" ::: "memory");
    }
}
struct EpiInE {
    static constexpr bool PERM = true, AFTER_DRAIN = false, HAS_PRE = false;
    bf16_t* P; const float* ssq;
    __device__ __forceinline__ float row_scale(int row) const { return ssq4(ssq, row); }
    __device__ __forceinline__ void col8(int, f32x4& b0, f32x4& b1) const { b0 = (f32x4){0.f, 0.f, 0.f, 0.f}; b1 = b0; }
    __device__ __forceinline__ u32x4 pre8(int, int) const { return (u32x4){0u, 0u, 0u, 0u}; }
    __device__ __forceinline__ void row8(int row, int col, f32x4 v0, f32x4 v1, float rs, const f32x4&, const f32x4&, const u32x4&, float&) const {
        v0 = v0 * rs; v1 = v1 * rs;
        if (col >= 1024 && col < 1536) {
#pragma unroll
            for (int e = 0; e < 4; ++e) { v0[e] = v0[e] * sigmoid_f(v0[e]); v1[e] = v1[e] * sigmoid_f(v1[e]); } }
        *(u32x4*)(P + (size_t)row * 2048 + col) = pack8(v0, v1);
    }
    __device__ __forceinline__ void operator()(const f32x4 (&acc)[2][2][4][2], const Unit& u, int wr, int wc, int fr, int fq) const { float sm[8]; drive_epi(*this, acc, u, wr, wc, fr, fq, sm); }
};
struct EpiInO {
    static constexpr bool PERM = true, AFTER_DRAIN = false, HAS_PRE = false;
    bf16_t* GATE; bf16_t* CIN; const float* ssq; float* conv_p; float* conv_s;
    __device__ __forceinline__ float row_scale(int row) const { return ssq4(ssq, row); }
    __device__ __forceinline__ void col8(int, f32x4& b0, f32x4& b1) const { b0 = (f32x4){0.f, 0.f, 0.f, 0.f}; b1 = b0; }
    __device__ __forceinline__ u32x4 pre8(int, int) const { return (u32x4){0u, 0u, 0u, 0u}; }
    __device__ __forceinline__ void row8(int row, int col, f32x4 v0, f32x4 v1, float rs, const f32x4&, const f32x4&, const u32x4&, float&) const {
        v0 = v0 * rs; v1 = v1 * rs;
        if (col < 1024) {
#pragma unroll
            for (int e = 0; e < 4; ++e) { v0[e] = gelu_tanh_f(v0[e]); v1[e] = gelu_tanh_f(v1[e]); }
            *(u32x4*)(GATE + (size_t)row * 1024 + col) = pack8(v0, v1);
        } else {
            const int cc = col - 1024;
            *(u32x4*)(CIN + (size_t)row * 1024 + cc) = pack8(v0, v1);
            float* cdst = nullptr;
            if (row < TP_ROWS) { const int t = row & 2047; if (t >= 2045) cdst = conv_p + ((size_t)(row >> 11) * 3 + (t - 2045)) * 1024; }
            else { const int r2 = row - TP_ROWS, t = r2 & 3; if (t >= 1) cdst = conv_s + ((size_t)(r2 >> 2) * 3 + (t - 1)) * 1024; }
            if (cdst) { *(f32x4*)(cdst + cc) = v0; *(f32x4*)(cdst + cc + 4) = v1; }
        }
    }
    __device__ __forceinline__ void operator()(const f32x4 (&acc)[2][2][4][2], const Unit& u, int wr, int wc, int fr, int fq) const { float sm[8]; drive_epi(*this, acc, u, wr, wc, fr, fq, sm); }
};
struct EpiRes {
    static constexpr bool PERM = true, AFTER_DRAIN = true, HAS_PRE = true;
    bf16_t* XB; float* ssq_out;
    __device__ __forceinline__ float row_scale(int) const { return 1.f; }
    __device__ __forceinline__ void col8(int, f32x4& b0, f32x4& b1) const { b0 = (f32x4){0.f, 0.f, 0.f, 0.f}; b1 = b0; }
    __device__ __forceinline__ u32x4 pre8(int row, int col) const { return *(const u32x4*)(XB + (size_t)row * 1024 + col); }
    __device__ __forceinline__ void row8(int row, int col, f32x4 v0, f32x4 v1, float, const f32x4&, const f32x4&, const u32x4& pre, float& s) const {
        f32x4 o0, o1; unpack8(pre, o0, o1); o0 = o0 + v0; o1 = o1 + v1;
        *(u32x4*)(XB + (size_t)row * 1024 + col) = pack8(o0, o1);
        s += (o0[0] * o0[0] + o0[1] * o0[1]) + (o0[2] * o0[2] + o0[3] * o0[3]) + (o1[0] * o1[0] + o1[1] * o1[1]) + (o1[2] * o1[2] + o1[3] * o1[3]);
    }
    __device__ __forceinline__ void fused(f32x4 (&acc)[2][2][4][2], const Unit& u, int wr, int wc, int fr, int fq, PG8_LAS unsigned char* lds, int wid, int lane) const {
        PG8_LAS float* part = (PG8_LAS float*)lds;
        float sm[8]; drive_epi(*this, acc, u, wr, wc, fr, fq, sm);
#pragma unroll
        for (int g = 0; g < 8; ++g) { float s = sm[g]; s += __shfl_xor(s, 16); s += __shfl_xor(s, 32);
            if (fq == 0) part[wc * 256 + (g >> 2) * HALF + wr * 64 + (g & 3) * 16 + fr] = s; }
        asm volatile("s_waitcnt lgkmcnt(0)" ::: "memory"); __builtin_amdgcn_s_barrier(); asm volatile("" ::: "memory");
        const int t = wid * 64 + lane;
        if (t < 256) ssq_out[(size_t)u.pn * T_ROWS + u.pm * BM + t] = (part[t] + part[256 + t]) + (part[512 + t] + part[768 + t]);
        asm volatile("s_waitcnt lgkmcnt(0)" ::: "memory"); __builtin_amdgcn_s_barrier(); asm volatile("" ::: "memory");
    }
    __device__ __forceinline__ void operator()(const f32x4 (&acc)[2][2][4][2], const Unit& u, int wr, int wc, int fr, int fq) const {}
};
struct EpiUp {
    static constexpr bool PERM = true, AFTER_DRAIN = false, HAS_PRE = false;
    bf16_t* H; const float* ssq;
    __device__ __forceinline__ float row_scale(int row) const { return ssq4(ssq, row); }
    __device__ __forceinline__ void col8(int, f32x4& b0, f32x4& b1) const { b0 = (f32x4){0.f, 0.f, 0.f, 0.f}; b1 = b0; }
    __device__ __forceinline__ u32x4 pre8(int, int) const { return (u32x4){0u, 0u, 0u, 0u}; }
    __device__ __forceinline__ void row8(int row, int col, f32x4 v0, f32x4 v1, float rs, const f32x4&, const f32x4&, const u32x4&, float&) const {
        v0 = v0 * rs; v1 = v1 * rs;
#pragma unroll
        for (int e = 0; e < 4; ++e) { const float a = fmaxf(v0[e], 0.f), b = fmaxf(v1[e], 0.f); v0[e] = a * a; v1[e] = b * b; }
        { const u32x4 pk_ = pack8(v0, v1); bf16_t* dp_ = H + (size_t)row * 4224 + col;
          asm volatile("global_store_dwordx4 %0, %1, off sc1\n\ts_nop 1" :: "v"(dp_), "v"(pk_) : "memory"); }
    }
    __device__ __forceinline__ void operator()(const f32x4 (&acc)[2][2][4][2], const Unit& u, int wr, int wc, int fr, int fq) const { float sm[8]; drive_epi(*this, acc, u, wr, wc, fr, fq, sm); }
};
struct EpiGlu {
    static constexpr bool PERM = true, AFTER_DRAIN = false, HAS_PRE = true;
    const bf16_t* Z1; bf16_t* MIX; const float* b_glu;
    __device__ __forceinline__ float row_scale(int) const { return 1.f; }
    __device__ __forceinline__ void col8(int col, f32x4& b0, f32x4& b1) const { b0 = *(const f32x4*)(b_glu + col); b1 = *(const f32x4*)(b_glu + col + 4); }
    __device__ __forceinline__ u32x4 pre8(int row, int col) const { return *(const u32x4*)(Z1 + (size_t)row * 512 + col); }
    __device__ __forceinline__ void row8(int row, int col, f32x4 v0, f32x4 v1, float, const f32x4& b0, const f32x4& b1, const u32x4& pre, float&) const {
        f32x4 z0, z1; unpack8(pre, z0, z1);
#pragma unroll
        for (int e = 0; e < 4; ++e) { v0[e] = z0[e] * sigmoid_f(v0[e] + b0[e]); v1[e] = z1[e] * sigmoid_f(v1[e] + b1[e]); }
        *(u32x4*)(MIX + (size_t)row * 1024 + 512 + col) = pack8(v0, v1);
    }
    __device__ __forceinline__ void operator()(const f32x4 (&acc)[2][2][4][2], const Unit& u, int wr, int wc, int fr, int fq) const { float sm[8]; drive_epi(*this, acc, u, wr, wc, fr, fq, sm); }
};
}
constexpr int NWAVES = 8;
constexpr int D = 1024, TP = 16384, TS = 512, T = TP + TS, FF = 4096;
constexpr int NIN_E = 2304, NIN_O = 2048;
constexpr float EPS = 1e-6f;
constexpr size_t MiB = 1u << 20;
constexpr size_t WS_CTL = 0, CTL_ZERO_BYTES = 2 * MiB;
constexpr size_t WS_SSQ = 277 * MiB;
constexpr size_t CTL_S5AB = 1 * MiB;
constexpr size_t CTL_S5BRE = 1 * MiB + 64 * 1024;
constexpr size_t CTL_S5BIM = CTL_S5BRE + 256 * 1024;
constexpr size_t WS_W = 2 * MiB;
constexpr size_t W_INE = 0, W_GLU = 9437184, W_OUTE = 10485760, W_INO = 14680064, W_G = 23068672, W_OUTO = 24117248, W_UP = 28311552, W_DN = 61865984, W_END = 96468992;
constexpr size_t WS_WA = 94 * MiB;
constexpr int LD_FF = 4224;
constexpr size_t WS_XB = 95 * MiB, WS_R = 128 * MiB;
constexpr size_t R_H = 0, R_P = 0, R_LA = 66 * MiB, R_Z1 = 82 * MiB + MiB / 2, R_MIX = 99 * MiB, R_ORAW = 132 * MiB;
constexpr size_t R_CIN = 0, R_LOGA = 0, R_XC = 33 * MiB, R_BB = 66 * MiB;
constexpr size_t WS_END = WS_SSQ + (size_t)9 * 4 * T * 4;
static_assert(WS_R + 148 * MiB + MiB / 2 <= WS_SSQ, "ws map");
static_assert(WS_W + W_END <= WS_XB && WS_XB + (size_t)T * D * 2 <= WS_R, "ws map");
constexpr size_t OUT_YP = 0, OUT_YS = 16777216, OUT_GLAP = 17301504, OUT_REP = 17825792, OUT_IMP = 17858560, OUT_LRUP = 17891328, OUT_CONVP = 17907712,
                 OUT_GLAS = 17956864, OUT_RES = 26345472, OUT_IMS = 26869760, OUT_LRUS = 27394048, OUT_CONVS = 27656192, OUT_END = 28442624;
constexpr int CW_TMO = 0, CW_CODE = 1, CW_BAR = 4096;
constexpr int RING_OFF = 0, RING_BYTES = 131072, LDSCTL_OFF = RING_BYTES, MISC_OFF = LDSCTL_OFF + 320, LDS_BYTES = 147456;

#define GAS __attribute__((address_space(1)))
#define LAS __attribute__((address_space(3)))
typedef unsigned short bf16;
typedef unsigned v4u __attribute__((ext_vector_type(4)));
typedef unsigned v2u __attribute__((ext_vector_type(2)));
typedef float f32x4 __attribute__((ext_vector_type(4)));
typedef short bf16x8 __attribute__((ext_vector_type(8)));
typedef GAS unsigned gu32;
#define RLX_AGENT __ATOMIC_RELAXED, __HIP_MEMORY_SCOPE_AGENT
#define LDS_WAIT() asm volatile("s_waitcnt lgkmcnt(0)" ::: "memory")
#define VM_WAIT() asm volatile("s_waitcnt vmcnt(0)" ::: "memory")
__device__ __forceinline__ unsigned f2bf(float f) { unsigned u = __builtin_bit_cast(unsigned, f); return (u + 0x7fffu + ((u >> 16) & 1u)) >> 16; }
__device__ __forceinline__ unsigned pk2(float lo, float hi) { return f2bf(lo) | (f2bf(hi) << 16); }
__device__ __forceinline__ float bflo(unsigned w) { return __uint_as_float(w << 16); }
__device__ __forceinline__ float bfhi(unsigned w) { return __uint_as_float(w & 0xffff0000u); }
__device__ __forceinline__ float bf2f(bf16 h) { return __uint_as_float((unsigned)h << 16); }
__device__ __forceinline__ float sigmoid_f(float x) { return __builtin_amdgcn_rcpf(1.0f + __expf(-x)); }
__device__ __forceinline__ float gelu_tanh_f(float x) { const float u = 0.7978845608028654f * (x + 0.044715f * x * x * x); return x * __builtin_amdgcn_rcpf(1.0f + __expf(-2.0f * u)); }
__device__ __forceinline__ float wave_sum(float v) {
#pragma unroll
    for (int o = 1; o < 64; o <<= 1) v += __shfl_xor(v, o);
    return v;
}
#define XB_TMO      128
#define XB_XCNT(j)  (256  + 64 * (j))
#define XB_XSUB(j)  (1280 + 64 * (j))
#define XB_XGEN(j)  (2304 + 64 * (j))
#define XB_TOP      3328
#define XB_TOPGEN   3392
#define XCD_BAR_WORDS 3456
#define XB_SPIN_CAP (1u << 18)

__device__ __forceinline__ unsigned xb_ld(unsigned* p)              { return __hip_atomic_load(p, __ATOMIC_RELAXED, __HIP_MEMORY_SCOPE_AGENT); }
__device__ __forceinline__ unsigned xb_add(unsigned* p, unsigned v) { return __hip_atomic_fetch_add(p, v, __ATOMIC_RELAXED, __HIP_MEMORY_SCOPE_AGENT); }
__device__ __forceinline__ unsigned xb_xcc_id() { return (unsigned)__builtin_amdgcn_s_getreg((3 << 11) | 20) & 0xFu; }
#define XB_SPIN(cond, bar) do { unsigned _sp = 0; while (cond) { __builtin_amdgcn_s_sleep(1); \
    if ((++_sp & 255u) == 0u) { if (xb_ld(&(bar)[XB_TMO])) break; if (_sp > XB_SPIN_CAP) { atomicAdd(&(bar)[XB_TMO], 1u); break; } } } } while (0)

struct XcdBarrier {
    unsigned* bar; unsigned x;
    volatile LAS unsigned* st;
};

__device__ __forceinline__ XcdBarrier xcd_barrier_post(unsigned* bar, volatile LAS unsigned* st, int tid) {
    XcdBarrier b; b.bar = bar; b.x = xb_xcc_id(); b.st = st;
    if (tid == 0) (void)xb_add(&bar[XB_XCNT(b.x)], 1u);
    return b;
}
__device__ __forceinline__ void xcd_barrier_complete(unsigned* bar, unsigned x, unsigned& nloc, unsigned& nx) {
    const unsigned G = gridDim.x * gridDim.y * gridDim.z;
    unsigned sum, cnt, mine, sp = 0u;
    for (;;) {
        sum = 0u; cnt = 0u; mine = 0u;
#pragma unroll
        for (unsigned j = 0; j < 16; ++j) { const unsigned c = xb_ld(&bar[XB_XCNT(j)]); sum += c; cnt += (c > 0u) ? 1u : 0u; mine = (j == x) ? c : mine; }
        if (sum == G) break;
        __builtin_amdgcn_s_sleep(1);
        if ((++sp & 255u) == 0u) { if (xb_ld(&bar[XB_TMO])) break; if (sp > XB_SPIN_CAP) { atomicAdd(&bar[XB_TMO], 1u); break; } }
    }
    nloc = mine > 0u ? mine : 1u; nx = cnt > 0u ? cnt : 1u;
}

__device__ __forceinline__ void xcd_barrier(const XcdBarrier& b, int tid) {
    asm volatile("s_waitcnt vmcnt(0)" ::: "memory");
    __syncthreads();
    if (tid == 0) {
        unsigned* bar = b.bar;
        __builtin_amdgcn_s_waitcnt(0);
        unsigned nloc = b.st[0], nx = b.st[1];
        if (nloc == 0u) { xcd_barrier_complete(bar, b.x, nloc, nx); b.st[0] = nloc; b.st[1] = nx; }
        const unsigned old = xb_add(&bar[XB_XSUB(b.x)], 1u);
        const unsigned gen = old / nloc;
        if (old + 1u == (gen + 1u) * nloc) {
            __builtin_amdgcn_fence(__ATOMIC_RELEASE, "agent");
            asm volatile("s_waitcnt vmcnt(0)" ::: "memory");
            const unsigned og = xb_add(&bar[XB_TOP], 1u);
            const unsigned tg = og / nx;
            if (og + 1u == (tg + 1u) * nx) xb_add(&bar[XB_TOPGEN], 1u);
            else XB_SPIN(xb_ld(&bar[XB_TOPGEN]) == tg, bar);
            __builtin_amdgcn_fence(__ATOMIC_ACQUIRE, "agent");
            xb_add(&bar[XB_XGEN(b.x)], 1u);
            asm volatile("s_waitcnt vmcnt(0)" ::: "memory");
        } else {
            XB_SPIN(xb_ld(&bar[XB_XGEN(b.x)]) == gen, bar);
            __builtin_amdgcn_fence(__ATOMIC_ACQUIRE, "agent");
            asm volatile("s_waitcnt vmcnt(0)" ::: "memory");
        }
    }
    __syncthreads();
}
struct Args { const float* in[37]; float* out; unsigned char* ws; int ph_lo, ph_hi, li, pad; };
template <class T> __device__ __forceinline__ T* as_global(T* p) { const unsigned long long u = (unsigned long long)p; return (T*)(GAS T*)u; }
struct InPtrs { const float* const* p; __device__ __forceinline__ const float* operator[](int i) const { return as_global(p[i]); } };
struct Ctx { InPtrs in; float* out; unsigned char* ws; LAS unsigned char* lds; int tid, lane, wave, vcu, G, gw, NGW, var; };

__device__ __forceinline__ void tr_item(const float* W, int ldw, int K, const float* gain, bf16* WT, LAS float* scr, int kb, int nb, int lane, int ldo) {
    const int k0 = 64 * kb, n0 = 32 * nb;
    f32x4 v[8];
#pragma unroll
    for (int i = 0; i < 8; ++i) v[i] = __builtin_nontemporal_load((const f32x4*)(W + (size_t)(k0 + 8 * i + (lane >> 3)) * ldw + n0 + 4 * (lane & 7)));
#pragma unroll
    for (int i = 0; i < 8; ++i) { const int kk = 8 * i + (lane >> 3); f32x4 x = v[i]; if (gain) x = x * gain[k0 + kk];
        LAS float* d = scr + kk * 33 + 4 * (lane & 7); d[0] = x[0]; d[1] = x[1]; d[2] = x[2]; d[3] = x[3]; }
    LDS_WAIT(); asm volatile("" ::: "memory");
    const int c = lane & 7;
#pragma unroll
    for (int j = 0; j < 4; ++j) { const int n = (lane >> 3) + 8 * j; const LAS float* s = scr + (8 * c) * 33 + n;
        v4u o; o.x = pk2(s[0 * 33], s[1 * 33]); o.y = pk2(s[2 * 33], s[3 * 33]); o.z = pk2(s[4 * 33], s[5 * 33]); o.w = pk2(s[6 * 33], s[7 * 33]);
        __builtin_nontemporal_store(o, (GAS v4u*)(WT + (size_t)(n0 + n) * ldo + k0 + 8 * c)); }
    LDS_WAIT(); asm volatile("" ::: "memory");
}
__device__ __forceinline__ void tr_job(const Ctx& c, int& base, const float* W, int ldw, int ncols, int K, const float* gain, bf16* WT, LAS float* scr, int ldo = 0) {
    if (ldo == 0) ldo = K;
    const int nblk = ncols / 32, nitems = (K / 64) * nblk;
    int first = (c.gw - base) % c.NGW; if (first < 0) first += c.NGW;
    for (int it = first; it < nitems; it += c.NGW) tr_item(W, ldw, K, gain, WT, scr, it / nblk, it % nblk, c.lane, ldo);
    base = (base + nitems) % c.NGW;
}
__device__ __forceinline__ void sincos_d(double x, double& s, double& c) {
    const double j = __builtin_rint(x * 0.63661977236758134308);
    double r = __builtin_fma(-j, 1.57079632673412561417e+00, x); r = __builtin_fma(-j, 6.07710050650619224932e-11, r);
    const double z = r * r;
    const double sp = r + r * z * (-1.66666666666666307295e-1 + z * (8.33333333332211858878e-3 + z * (-1.98412698295895385996e-4 + z * (2.75573136213857245213e-6 + z * (-2.50507477628578072866e-8 + z * 1.58962301576546568060e-10)))));
    const double cp = 1.0 - 0.5 * z + z * z * (4.16666666666665929218e-2 + z * (-1.38888888888730564116e-3 + z * (2.48015872888517045348e-5 + z * (-2.75573141792967388112e-7 + z * (2.08757008419747316778e-9 + z * -1.13585365213876817300e-11)))));
    const int q = ((int)j) & 3;
    s = (q == 0) ? sp : (q == 1) ? cp : (q == 2) ? -sp : -cp;
    c = (q == 0) ? cp : (q == 1) ? -sp : (q == 2) ? -cp : sp;
}
__device__ __forceinline__ void p0_weights_rest(const Ctx& c) {
    LAS float* scr = (LAS float*)(c.lds + RING_OFF + c.wave * 16384);
    const InPtrs in = c.in; unsigned char* ws = c.ws;
    bf16* Wb = (bf16*)(ws + WS_W);
    int base = 0;
    for (int e = 0; e < 2; ++e) {
        if (e == 1) { const float* w = in[8] + (size_t)e * 1024 * 2064; const float* g = in[7] + e * 1024; bf16* dst = (bf16*)((unsigned char*)Wb + W_INE) + (size_t)e * NIN_E * 1024;
            tr_job(c, base, w, 2064, 1536, 1024, g, dst, scr);
            tr_job(c, base, w + 1552, 2064, 512, 1024, g, dst + (size_t)1536 * 1024, scr); }
        tr_job(c, base, in[20] + (size_t)e * 512 * 512, 512, 512, 512, nullptr, (bf16*)((unsigned char*)Wb + W_GLU) + (size_t)e * 512 * 512, scr);
        tr_job(c, base, in[22] + (size_t)e * 1024 * 1024, 1024, 1024, 1024, nullptr, (bf16*)((unsigned char*)Wb + W_OUTE) + (size_t)e * 1024 * 1024, scr);
    }
    for (int o = 0; o < 2; ++o) {
        tr_job(c, base, in[24] + (size_t)o * 1024 * 2048, 2048, 2048, 1024, in[23] + o * 1024, (bf16*)((unsigned char*)Wb + W_INO) + (size_t)o * 2048 * 1024, scr);
        tr_job(c, base, in[32] + (size_t)o * 1024 * 1024, 1024, 1024, 1024, nullptr, (bf16*)((unsigned char*)Wb + W_OUTO) + (size_t)o * 1024 * 1024, scr);
        for (int n = 0; n < 8; ++n) {
            bf16* dst = (bf16*)((unsigned char*)Wb + W_G) + ((size_t)o * 8 + n) * 256 * 128;
            tr_job(c, base, in[27] + ((size_t)o * 8 + n) * 128 * 128, 128, 128, 128, nullptr, dst, scr);
            tr_job(c, base, in[29] + ((size_t)o * 8 + n) * 128 * 128, 128, 128, 128, nullptr, dst + 128 * 128, scr);
        }
    }
    for (int l = 0; l < 4; ++l) {
        tr_job(c, base, in[34] + (size_t)l * 1024 * 4096, 4096, 4096, 1024, in[33] + l * 1024, (bf16*)((unsigned char*)Wb + W_UP) + (size_t)l * 4096 * 1024, scr);
        tr_job(c, base, in[35] + (size_t)l * 4096 * 1024, 1024, 1024, 4096, nullptr, (bf16*)((unsigned char*)Wb + W_DN) + (size_t)l * 1024 * LD_FF, scr, LD_FF);
    }
    __syncthreads();
}
__device__ __forceinline__ void p0_prologue(const Ctx& c) {
    LAS float* scr = (LAS float*)(c.lds + RING_OFF + c.wave * 16384);
    const InPtrs in = c.in; unsigned char* ws = c.ws;
    bf16* Wb = (bf16*)(ws + WS_W);
    int base = 0;
    { const float* w = in[8]; const float* g = in[7]; bf16* dst = (bf16*)((unsigned char*)Wb + W_INE);
      tr_job(c, base, w, 2064, 1536, 1024, g, dst, scr);
      tr_job(c, base, w + 1552, 2064, 512, 1024, g, dst + (size_t)1536 * 1024, scr); }
    const int gtid = c.vcu * (NWAVES * 64) + c.tid, NT = c.G * NWAVES * 64;
    for (int i = gtid; i < 2 * 16 * 128; i += NT) {
        const int e = i >> 11, j = (i >> 7) & 15, k0 = (i & 127) * 8; const float* w = in[8] + (size_t)e * 1024 * 2064 + 1536 + j; const float* g = in[7] + e * 1024;
        float o[8];
#pragma unroll
        for (int kk = 0; kk < 8; ++kk) o[kk] = w[(size_t)(k0 + kk) * 2064] * g[k0 + kk];
        v4u pk; pk.x = pk2(o[0], o[1]); pk.y = pk2(o[2], o[3]); pk.z = pk2(o[4], o[5]); pk.w = pk2(o[6], o[7]);
        *(v4u*)((bf16*)(ws + WS_WA) + ((size_t)e * 16 + j) * 1024 + k0) = pk;
    }
    for (int i = gtid; i < 2 * 256 * 2; i += NT) {
        const int e = i >> 9, n = (i >> 1) & 255, j0 = (i & 1) * 8; const float* a2 = in[9] + (size_t)e * 16 * 256 + n;
        float o[8];
#pragma unroll
        for (int jj = 0; jj < 8; ++jj) o[jj] = a2[(size_t)(j0 + jj) * 256];
        v4u pk; pk.x = pk2(o[0], o[1]); pk.y = pk2(o[2], o[3]); pk.z = pk2(o[4], o[5]); pk.w = pk2(o[6], o[7]);
        *(v4u*)((bf16*)(ws + WS_WA) + 2 * 16 * 1024 + ((size_t)e * 256 + n) * 16 + j0) = pk;
    }
    for (int i = gtid; i < 2 * 32 * 64; i += NT) {
        const double dt = exp((double)in[14][i >> 6]);
        const double are = (double)in[12][i], aim = (double)in[13][i];
        const double zr = dt * are, zi = dt * aim; double sn, cs; sincos_d(zi, sn, cs);
        const double mag = exp(zr), abre = mag * cs, abim = mag * sn;
        double sh, ch; sincos_d(0.5 * zi, sh, ch);
        const double m1re = expm1(zr) * cs - 2.0 * sh * sh, m1im = abim;
        const double den = are * are + aim * aim;
        const double cre = (m1re * are + m1im * aim) / den, cim = (m1im * are - m1re * aim) / den;
        float* AB = (float*)(ws + CTL_S5AB); AB[2 * i] = (float)abre; AB[2 * i + 1] = (float)abim;
        float* BRE = (float*)(ws + CTL_S5BRE) + (size_t)i * 16; float* BIM = (float*)(ws + CTL_S5BIM) + (size_t)i * 16;
        const float* bre = in[15] + (size_t)i * 16; const float* bim = in[16] + (size_t)i * 16;
#pragma unroll
        for (int q = 0; q < 16; ++q) { const double br = bre[q], bi = bim[q]; BRE[q] = (float)(cre * br - cim * bi); BIM[q] = (float)(cre * bi + cim * br); }
    }
    bf16* XB = (bf16*)(ws + WS_XB); float* ssq0 = (float*)(ws + WS_SSQ);
    for (int m = c.gw; m < T; m += c.NGW) {
        const float* xr = (m < TP) ? in[0] + (size_t)m * D : in[1] + (size_t)(m - TP) * D;
        const GAS f32x4* x4 = (const GAS f32x4*)xr + c.lane; f32x4 v[4]; float s = 0.f;
#pragma unroll
        for (int j = 0; j < 4; ++j) { v[j] = __builtin_nontemporal_load(x4 + 64 * j); s += (v[j].x * v[j].x + v[j].y * v[j].y) + (v[j].z * v[j].z + v[j].w * v[j].w); }
        s = wave_sum(s);
        GAS v2u* o8 = (GAS v2u*)(XB + (size_t)m * D) + c.lane;
#pragma unroll
        for (int j = 0; j < 4; ++j) { v2u w; w.x = pk2(v[j].x, v[j].y); w.y = pk2(v[j].z, v[j].w); o8[64 * j] = w; }
        if (c.lane < 4) ssq0[(size_t)c.lane * T + m] = (c.lane == 0) ? s : 0.f;
    }
}
__device__ __forceinline__ void gla_naive_block(const Ctx& c, int e, int item0, bool sample) {
    unsigned char* ws = c.ws;
    const bf16* P = (const bf16*)(ws + WS_R + R_P); const float* LA = (const float*)(ws + WS_R + R_LA); bf16* ORAW = (bf16*)(ws + WS_R + R_ORAW);
    const int sub = c.tid >> 7, st = c.tid & 127, item = item0 + sub, b = item >> 2, h = item & 3;
    const int row0 = sample ? TP + b * 4 : b * 2048, n = sample ? 4 : 2048;
    float S[64];
    if (sample) { const float* s0 = c.in[2] + (((size_t)e * 128 + b) * 4 + h) * 8192;
#pragma unroll
        for (int d = 0; d < 64; ++d) S[d] = s0[d * 128 + st]; }
    else {
#pragma unroll
        for (int d = 0; d < 64; ++d) S[d] = 0.f; }
    LAS float* lq = (LAS float*)(c.lds + RING_OFF) + sub * 5120; LAS float* lk = lq + 1024; LAS float* la = lq + 2048; LAS float* lv = lq + 3072;
    for (int t0 = 0; t0 < n; t0 += 16) {
        const int nt = (n - t0) < 16 ? (n - t0) : 16;
        __syncthreads();
#pragma unroll
        for (int i = 0; i < 8; ++i) { const int idx = st + 128 * i, tt = idx >> 6, d = idx & 63;
            if (tt < nt) { const size_t row = (size_t)(row0 + t0 + tt);
                lq[idx] = bf2f(P[row * 2048 + h * 64 + d]); lk[idx] = bf2f(P[row * 2048 + 256 + h * 64 + d]); la[idx] = __expf(LA[row * 256 + h * 64 + d]); } }
#pragma unroll
        for (int tt = 0; tt < 16; ++tt) if (tt < nt) lv[tt * 128 + st] = bf2f(P[(size_t)(row0 + t0 + tt) * 2048 + 512 + h * 128 + st]);
        __syncthreads();
#pragma unroll 1
        for (int tt = 0; tt < nt; ++tt) {
            const float v = lv[tt * 128 + st]; float o = 0.f;
#pragma unroll
            for (int d4 = 0; d4 < 16; ++d4) { const f32x4 a4 = *(const LAS f32x4*)(la + tt * 64 + 4 * d4), k4 = *(const LAS f32x4*)(lk + tt * 64 + 4 * d4), q4 = *(const LAS f32x4*)(lq + tt * 64 + 4 * d4);
#pragma unroll
                for (int i = 0; i < 4; ++i) { S[4 * d4 + i] = a4[i] * S[4 * d4 + i] + k4[i] * v; o += q4[i] * S[4 * d4 + i]; } }
            ORAW[(size_t)(row0 + t0 + tt) * 512 + h * 128 + st] = (bf16)f2bf(o * 0.125f);
        }
    }
    float* dst = c.out + (sample ? OUT_GLAS + (((size_t)e * 128 + b) * 4 + h) * 8192 : OUT_GLAP + (((size_t)e * 8 + b) * 4 + h) * 8192);
#pragma unroll
    for (int d = 0; d < 64; ++d) dst[d * 128 + st] = S[d];
}
__device__ __forceinline__ void s5_naive_wave(const Ctx& c, int e, int item, bool sample, LAS float* wl) {
    unsigned char* ws = c.ws; const int lane = c.lane;
    const bf16* P = (const bf16*)(ws + WS_R + R_P); bf16* Z1 = (bf16*)(ws + WS_R + R_Z1);
    const int b = item >> 5, g = item & 31, row0 = sample ? TP + b * 4 : b * 2048, n = sample ? 4 : 2048;
    const int idx = (e * 32 + g) * 64 + lane;
    const float* AB = (const float*)(ws + CTL_S5AB); const float ar = AB[2 * idx], ai = AB[2 * idx + 1];
    float bre[16], bim[16];
    { const f32x4* r4 = (const f32x4*)((const float*)(ws + CTL_S5BRE) + (size_t)idx * 16); const f32x4* i4 = (const f32x4*)((const float*)(ws + CTL_S5BIM) + (size_t)idx * 16);
#pragma unroll
      for (int q = 0; q < 4; ++q) { const f32x4 a = r4[q], bb = i4[q];
#pragma unroll
          for (int j = 0; j < 4; ++j) { bre[4 * q + j] = a[j]; bim[4 * q + j] = bb[j]; } } }
    float hre = 0.f, him = 0.f;
    if (sample) { hre = c.in[3][(((size_t)e * 128 + b) * 32 + g) * 64 + lane]; him = c.in[4][(((size_t)e * 128 + b) * 32 + g) * 64 + lane]; }
    LAS float* lcre = wl; LAS float* lcim = wl + 1024; LAS float* lu = wl + 2048; LAS float* hs = wl + 2176;
    { const float* cr = c.in[17] + (size_t)(e * 32 + g) * 1024; const float* ci = c.in[18] + (size_t)(e * 32 + g) * 1024;
#pragma unroll
      for (int i = 0; i < 16; ++i) { lcre[i * 64 + lane] = cr[i * 64 + lane]; lcim[i * 64 + lane] = ci[i * 64 + lane]; } }
    const int ott = lane >> 3, oc0 = 2 * (lane & 7);
    const float dsk0 = c.in[19][(e * 32 + g) * 16 + oc0], dsk1 = c.in[19][(e * 32 + g) * 16 + oc0 + 1];
    for (int t0 = 0; t0 < n; t0 += 8) {
        const int nt = (n - t0) < 8 ? (n - t0) : 8;
#pragma unroll
        for (int i = 0; i < 2; ++i) { const int ix = lane + 64 * i, tt = ix >> 4, cc = ix & 15;
            lu[ix] = (tt < nt) ? bf2f(P[(size_t)(row0 + t0 + tt) * 2048 + 1536 + g * 16 + cc]) : 0.f; }
        LDS_WAIT(); asm volatile("" ::: "memory");
#pragma unroll
        for (int tt = 0; tt < 8; ++tt) {
            if (tt < nt) {
                float bur = 0.f, bui = 0.f;
#pragma unroll
                for (int q = 0; q < 4; ++q) { const f32x4 u4 = *(const LAS f32x4*)(lu + tt * 16 + 4 * q);
#pragma unroll
                    for (int j = 0; j < 4; ++j) { bur += u4[j] * bre[4 * q + j]; bui += u4[j] * bim[4 * q + j]; } }
                const float nre = ar * hre - ai * him + bur, nim = ar * him + ai * hre + bui; hre = nre; him = nim;
                hs[tt * 128 + lane] = hre; hs[tt * 128 + 64 + lane] = him;
            }
        }
        LDS_WAIT(); asm volatile("" ::: "memory");
        if (ott < nt) {
            float y0 = 0.f, y1 = 0.f;
#pragma unroll
            for (int p4 = 0; p4 < 16; ++p4) {
                const f32x4 hr = *(const LAS f32x4*)(hs + ott * 128 + 4 * p4), hi = *(const LAS f32x4*)(hs + ott * 128 + 64 + 4 * p4);
                const f32x4 c0r = *(const LAS f32x4*)(lcre + oc0 * 64 + 4 * p4), c0i = *(const LAS f32x4*)(lcim + oc0 * 64 + 4 * p4);
                const f32x4 c1r = *(const LAS f32x4*)(lcre + (oc0 + 1) * 64 + 4 * p4), c1i = *(const LAS f32x4*)(lcim + (oc0 + 1) * 64 + 4 * p4);
#pragma unroll
                for (int j = 0; j < 4; ++j) { y0 += hr[j] * c0r[j] - hi[j] * c0i[j]; y1 += hr[j] * c1r[j] - hi[j] * c1i[j]; }
            }
            y0 += dsk0 * lu[ott * 16 + oc0]; y1 += dsk1 * lu[ott * 16 + oc0 + 1];
            *(unsigned*)(Z1 + (size_t)(row0 + t0 + ott) * 512 + g * 16 + oc0) = pk2(gelu_tanh_f(y0), gelu_tanh_f(y1));
        }
        LDS_WAIT(); asm volatile("" ::: "memory");
    }
    float* dre = c.out + (sample ? OUT_RES + (((size_t)e * 128 + b) * 32 + g) * 64 : OUT_REP + (((size_t)e * 8 + b) * 32 + g) * 64);
    float* dim = c.out + (sample ? OUT_IMS + (((size_t)e * 128 + b) * 32 + g) * 64 : OUT_IMP + (((size_t)e * 8 + b) * 32 + g) * 64);
    dre[lane] = hre; dim[lane] = him;
}
__device__ __forceinline__ void gla_post(const Ctx& c, int e) {
    unsigned char* ws = c.ws; const int lane = c.lane;
    const bf16* P = (const bf16*)(ws + WS_R + R_P); const bf16* ORAW = (const bf16*)(ws + WS_R + R_ORAW); bf16* MIX = (bf16*)(ws + WS_R + R_MIX);
    const float* gn = c.in[11] + e * 512;
    for (int wi = TP * 4 + c.gw; wi < T * 4; wi += c.NGW) {
        const int row = wi >> 2, h = wi & 3;
        const unsigned ow = *(const unsigned*)(ORAW + (size_t)row * 512 + h * 128 + 2 * lane);
        const float o0 = bflo(ow), o1 = bfhi(ow);
        const float ss = wave_sum(o0 * o0 + o1 * o1), rs = rsqrtf(ss * (1.0f / 128.0f) + EPS);
        const unsigned gw = *(const unsigned*)(P + (size_t)row * 2048 + 1024 + h * 128 + 2 * lane);
        *(unsigned*)(MIX + (size_t)row * 1024 + h * 128 + 2 * lane) = pk2(o0 * rs * gn[h * 128 + 2 * lane] * bflo(gw), o1 * rs * gn[h * 128 + 2 * lane + 1] * bfhi(gw));
    }
}
__device__ __forceinline__ void final_norm(const Ctx& c) {
    const float* nf = c.in[36]; const bf16* XB = (const bf16*)(c.ws + WS_XB);
    for (int m = c.gw; m < T; m += c.NGW) {
        const v4u* x8 = (const v4u*)(XB + (size_t)m * D) + c.lane; float v[16]; float s = 0.f;
#pragma unroll
        for (int j = 0; j < 2; ++j) { const v4u w = x8[64 * j];
#pragma unroll
            for (int q = 0; q < 4; ++q) { v[8 * j + 2 * q] = bflo(w[q]); v[8 * j + 2 * q + 1] = bfhi(w[q]); } }
#pragma unroll
        for (int i = 0; i < 16; ++i) s += v[i] * v[i];
        const float rs = rsqrtf(wave_sum(s) * (1.0f / 1024.0f) + EPS);
#pragma unroll
        for (int j = 0; j < 2; ++j) { const int col = 512 * j + 8 * c.lane; const f32x4 g0 = *(const f32x4*)(nf + col), g1 = *(const f32x4*)(nf + col + 4);
            f32x4 o0, o1;
#pragma unroll
            for (int q = 0; q < 4; ++q) { o0[q] = v[8 * j + q] * rs * g0[q]; o1[q] = v[8 * j + 4 + q] * rs * g1[q]; }
            *(f32x4*)(c.out + (size_t)m * D + col) = o0; *(f32x4*)(c.out + (size_t)m * D + col + 4) = o1; }
    }
}
typedef float f32x16 __attribute__((ext_vector_type(16)));
typedef short s16x4 __attribute__((ext_vector_type(4)));
typedef float f32x2_t __attribute__((ext_vector_type(2)));
typedef __bf16 bf16x2_t __attribute__((ext_vector_type(2)));
#define MFMA32(a, b, c) __builtin_amdgcn_mfma_f32_32x32x16_bf16((a), (b), (c), 0, 0, 0)
__device__ __forceinline__ unsigned cvtpk(float lo, float hi) { f32x2_t v = {lo, hi}; bf16x2_t b = __builtin_convertvector(v, bf16x2_t); return __builtin_bit_cast(unsigned, b); }
template <int S_> __device__ __forceinline__ bf16x8 pack_step(const f32x16& x) {
    v4u p; p.x = cvtpk(x[8 * S_], x[8 * S_ + 1]); p.y = cvtpk(x[8 * S_ + 2], x[8 * S_ + 3]); p.z = cvtpk(x[8 * S_ + 4], x[8 * S_ + 5]); p.w = cvtpk(x[8 * S_ + 6], x[8 * S_ + 7]);
    return __builtin_bit_cast(bf16x8, p);
}
__device__ __forceinline__ s16x4 trr(const LAS unsigned char* p) { return __builtin_bit_cast(s16x4, __builtin_amdgcn_ds_read_tr16_b64_v4i16((LAS s16x4*)p)); }
__device__ __forceinline__ bf16x8 cat8(s16x4 lo, s16x4 hi) { return __builtin_shufflevector(lo, hi, 0, 1, 2, 3, 4, 5, 6, 7); }
__device__ __forceinline__ bf16x8 cat8u(v2u lo, v2u hi) { v4u w; w.x = lo.x; w.y = lo.y; w.z = hi.x; w.w = hi.y; return __builtin_bit_cast(bf16x8, w); }
constexpr int GL_PQ = 144, GL_PV = 320, GL_PSG = 272;
constexpr int GL_QS = 0, GL_KS = 32 * GL_PQ, GL_V = 2 * 32 * GL_PQ, GL_SG = GL_V + 32 * GL_PV, GL_EL = GL_SG + 32 * GL_PSG, GL_BUF = GL_EL + 256;
constexpr int GL_TOT = 3 * GL_BUF, GL_PART = GL_TOT + 2 * 2048, GL_END = GL_PART + 2 * 512;
static_assert(GL_BUF % 16 == 0 && GL_END <= RING_BYTES, "GLA LDS map");

__device__ __forceinline__ void gla_fast_block(const Ctx& c, int e, int item) {
    unsigned char* ws = c.ws;
    const bf16* P = (const bf16*)(ws + WS_R + R_P); const float* LA = (const float*)(ws + WS_R + R_LA); bf16* MIX = (bf16*)(ws + WS_R + R_MIX);
    const int b = item >> 2, hh = item & 3, row0 = b * 2048;
    const int lane = c.lane, r32 = lane & 31, h = lane >> 5, wv = c.wave;
    LAS unsigned char* L = c.lds + RING_OFF;
    const int i16 = lane & 15, tq = i16 >> 2, tp = i16 & 3, blk = (lane >> 4) & 1;
    const bool consumer = wv < 4;
    if (consumer) {
        const int et = wv & 3;
        f32x16 S0, S1, O;
#pragma unroll
        for (int r = 0; r < 16; ++r) { S0[r] = 0.f; S1[r] = 0.f; O[r] = 0.f; }
        float gh[16];
#pragma unroll
        for (int r = 0; r < 16; ++r) gh[r] = c.in[11][e * 512 + hh * 128 + 32 * et + (r & 3) + 8 * (r >> 2) + 4 * h];
        v2u sgr[4] = {{0u, 0u}, {0u, 0u}, {0u, 0u}, {0u, 0u}};
        __syncthreads(); __syncthreads();
        for (int n = 0; n <= 64; ++n) {
            if (n > 0) {
                const LAS float* part = (const LAS float*)(L + GL_PART + ((n - 1) & 1) * 512);
                const float tot = (part[r32] + part[32 + r32]) + (part[64 + r32] + part[96 + r32]);
                const float rs = rsqrtf(tot * (1.0f / 128.0f) + EPS);
                bf16* dst = MIX + (size_t)(row0 + 32 * (n - 1) + r32) * 1024 + hh * 128 + 32 * et + 4 * h;
#pragma unroll
                for (int g4 = 0; g4 < 4; ++g4) { const v2u sg = sgr[g4];
                    v2u ov; ov.x = cvtpk(O[4 * g4] * rs * gh[4 * g4] * bflo(sg.x), O[4 * g4 + 1] * rs * gh[4 * g4 + 1] * bfhi(sg.x));
                    ov.y = cvtpk(O[4 * g4 + 2] * rs * gh[4 * g4 + 2] * bflo(sg.y), O[4 * g4 + 3] * rs * gh[4 * g4 + 3] * bfhi(sg.y));
                    *(v2u*)(dst + 8 * g4) = ov; }
            }
            if (n < 64) {
                const int bo = (n % 3) * GL_BUF;
                const LAS unsigned char* Qs = L + bo + GL_QS; const LAS unsigned char* Ks = L + bo + GL_KS; const LAS unsigned char* Vi = L + bo + GL_V;
                f32x16 X;
#pragma unroll
                for (int r = 0; r < 16; ++r) X[r] = 0.f;
#pragma unroll
                for (int s = 0; s < 4; ++s) { const bf16x8 ka = *(const LAS bf16x8*)(Ks + r32 * GL_PQ + 32 * s + 16 * h), qb = *(const LAS bf16x8*)(Qs + r32 * GL_PQ + 32 * s + 16 * h); X = MFMA32(ka, qb, X); }
#pragma unroll
                for (int r = 0; r < 16; ++r) { const int j = (r & 3) + 8 * (r >> 2) + 4 * h; X[r] = (j <= r32) ? X[r] : 0.f; }
                const bf16x8 px0 = pack_step<0>(X), px1 = pack_step<1>(X);
#pragma unroll
                for (int r = 0; r < 16; ++r) O[r] = 0.f;
                { const LAS unsigned char* vb = Vi + (4 * h + tq) * GL_PV + (32 * et + 16 * blk + 4 * tp) * 2;
                  const bf16x8 a0 = cat8(trr(vb), trr(vb + 8 * GL_PV)), a1 = cat8(trr(vb + 16 * GL_PV), trr(vb + 24 * GL_PV));
                  O = MFMA32(a0, px0, O); O = MFMA32(a1, px1, O); }
                { const LAS unsigned char* qp = Qs + r32 * GL_PQ + 8 * h;
                  const bf16x8 sa0 = pack_step<0>(S0), sa1 = pack_step<1>(S0), sa2 = pack_step<0>(S1), sa3 = pack_step<1>(S1);
                  const bf16x8 b0 = cat8u(*(const LAS v2u*)(qp), *(const LAS v2u*)(qp + 16)), b1 = cat8u(*(const LAS v2u*)(qp + 32), *(const LAS v2u*)(qp + 48));
                  const bf16x8 b2 = cat8u(*(const LAS v2u*)(qp + 64), *(const LAS v2u*)(qp + 80)), b3 = cat8u(*(const LAS v2u*)(qp + 96), *(const LAS v2u*)(qp + 112));
                  O = MFMA32(sa0, b0, O); O = MFMA32(sa1, b1, O); O = MFMA32(sa2, b2, O); O = MFMA32(sa3, b3, O); }
                { const LAS unsigned char* kb = Ks + (8 * h + tq) * GL_PQ + (16 * blk + 4 * tp) * 2; const LAS unsigned char* vb = Vi + (8 * h + tq) * GL_PV + (32 * et + 16 * blk + 4 * tp) * 2;
                  const bf16x8 v0 = cat8(trr(vb), trr(vb + 4 * GL_PV)), v1 = cat8(trr(vb + 16 * GL_PV), trr(vb + 20 * GL_PV));
                  const bf16x8 k00 = cat8(trr(kb), trr(kb + 4 * GL_PQ)), k01 = cat8(trr(kb + 16 * GL_PQ), trr(kb + 20 * GL_PQ));
                  const bf16x8 k10 = cat8(trr(kb + 64), trr(kb + 64 + 4 * GL_PQ)), k11 = cat8(trr(kb + 64 + 16 * GL_PQ), trr(kb + 64 + 20 * GL_PQ));
                  S0 = MFMA32(k00, v0, S0); S0 = MFMA32(k01, v1, S0); S1 = MFMA32(k10, v0, S1); S1 = MFMA32(k11, v1, S1);
                  const LAS float* el = (const LAS float*)(L + bo + GL_EL);
#pragma unroll
                  for (int g4 = 0; g4 < 4; ++g4) { const f32x4 f0 = *(const LAS f32x4*)(el + 8 * g4 + 4 * h), f1 = *(const LAS f32x4*)(el + 32 + 8 * g4 + 4 * h);
#pragma unroll
                      for (int q = 0; q < 4; ++q) { S0[4 * g4 + q] *= f0[q]; S1[4 * g4 + q] *= f1[q]; } } }
                float ss = 0.f;
#pragma unroll
                for (int r = 0; r < 16; ++r) ss += O[r] * O[r];
                ss += __shfl_xor(ss, 32);
                if (h == 0) *(LAS float*)(L + GL_PART + (n & 1) * 512 + (et * 32 + r32) * 4) = ss;
                { const LAS unsigned char* sgp = L + bo + GL_SG + r32 * GL_PSG + (32 * et + 4 * h) * 2;
#pragma unroll
                  for (int g4 = 0; g4 < 4; ++g4) sgr[g4] = *(const LAS v2u*)(sgp + 16 * g4); }
                asm volatile("s_waitcnt lgkmcnt(0)" ::: "memory");
                __syncthreads();
            }
        }
        float* dst = c.out + OUT_GLAP + (((size_t)e * 8 + b) * 4 + hh) * 8192 + 32 * et + r32;
#pragma unroll
        for (int r = 0; r < 16; ++r) { const int d = (r & 3) + 8 * (r >> 2) + 4 * h; dst[(size_t)d * 128] = S0[r]; dst[(size_t)(32 + d) * 128] = S1[r]; }
    } else {
        const int pt = c.tid - 256, dp = pt & 31, jq = (pt >> 5) & 7;
        f32x2_t la2[4][4]; unsigned q2[4][4], k2[4][4]; v4u vraw[4][2], graw[4][2];
#define GLA_LOAD(chunk, RS) do { const size_t rb_ = (size_t)(row0 + 32 * (chunk)); \
        _Pragma("unroll") for (int j_ = 0; j_ < 4; ++j_) { const size_t rw_ = rb_ + 4 * jq + j_; \
            la2[RS][j_] = *(const f32x2_t*)(LA + rw_ * 256 + hh * 64 + 2 * dp); q2[RS][j_] = *(const unsigned*)(P + rw_ * 2048 + hh * 64 + 2 * dp); k2[RS][j_] = *(const unsigned*)(P + rw_ * 2048 + 256 + hh * 64 + 2 * dp); } \
        _Pragma("unroll") for (int x_ = 0; x_ < 2; ++x_) { const int pc_ = pt + 256 * x_, j_ = pc_ >> 4, e8_ = pc_ & 15; \
            vraw[RS][x_] = *(const v4u*)(P + (rb_ + j_) * 2048 + 512 + hh * 128 + 8 * e8_); graw[RS][x_] = *(const v4u*)(P + (rb_ + j_) * 2048 + 1024 + hh * 128 + 8 * e8_); } } while (0)
#define GLA_PROD1(ck, RS) do { const int bufo_ = ((ck) % 3) * GL_BUF; \
        _Pragma("unroll") for (int x_ = 0; x_ < 2; ++x_) { const int pc_ = pt + 256 * x_, j_ = pc_ >> 4, e8_ = pc_ & 15; \
            *(LAS v4u*)(L + bufo_ + GL_V + j_ * GL_PV + 16 * e8_) = vraw[RS][x_]; *(LAS v4u*)(L + bufo_ + GL_SG + j_ * GL_PSG + 16 * e8_) = graw[RS][x_]; } \
        *(LAS f32x2_t*)(L + GL_TOT + ((ck) & 1) * 2048 + (jq * 64 + 2 * dp) * 4) = (f32x2_t){(la2[RS][0].x + la2[RS][1].x) + (la2[RS][2].x + la2[RS][3].x), (la2[RS][0].y + la2[RS][1].y) + (la2[RS][2].y + la2[RS][3].y)}; } while (0)
#define GLA_PROD2(ck, RS) do { const int bufo_ = ((ck) % 3) * GL_BUF; float p0_ = 0.f, p1_ = 0.f, t0_ = 0.f, t1_ = 0.f; \
        _Pragma("unroll") for (int g_ = 0; g_ < 8; ++g_) { const f32x2_t tv_ = *(const LAS f32x2_t*)(L + GL_TOT + ((ck) & 1) * 2048 + (g_ * 64 + 2 * dp) * 4); if (g_ < jq) { p0_ += tv_.x; p1_ += tv_.y; } t0_ += tv_.x; t1_ += tv_.y; } \
        float c0_ = p0_, c1_ = p1_; \
        _Pragma("unroll") for (int j_ = 0; j_ < 4; ++j_) { c0_ += la2[RS][j_].x; c1_ += la2[RS][j_].y; \
            const float q0_ = bflo(q2[RS][j_]) * __expf(c0_) * 0.125f, q1_ = bfhi(q2[RS][j_]) * __expf(c1_) * 0.125f, k0_ = bflo(k2[RS][j_]) * __expf(-c0_), k1_ = bfhi(k2[RS][j_]) * __expf(-c1_); \
            *(LAS unsigned*)(L + bufo_ + GL_QS + (4 * jq + j_) * GL_PQ + 4 * dp) = cvtpk(q0_, q1_); *(LAS unsigned*)(L + bufo_ + GL_KS + (4 * jq + j_) * GL_PQ + 4 * dp) = cvtpk(k0_, k1_); } \
        if (jq == 0) *(LAS f32x2_t*)(L + bufo_ + GL_EL + 8 * dp) = (f32x2_t){__expf(t0_), __expf(t1_)}; } while (0)
#define GLA_PITER(n, S1, S2) do { \
            if ((n) + 2 < 64) GLA_PROD1((n) + 2, S2); \
            if ((n) + 1 < 64) GLA_PROD2((n) + 1, S1); \
            GLA_LOAD(((n) + 5 < 64 ? (n) + 5 : 63), S1);     \
            asm volatile("s_waitcnt lgkmcnt(0)" ::: "memory"); \
            __syncthreads(); } while (0)
        GLA_LOAD(0, 0); GLA_LOAD(1, 1); GLA_LOAD(2, 2); GLA_LOAD(3, 3);
        GLA_PROD1(0, 0); asm volatile("s_waitcnt lgkmcnt(0)" ::: "memory"); __syncthreads();
        GLA_PROD1(1, 1); GLA_PROD2(0, 0); GLA_LOAD(4, 0); asm volatile("s_waitcnt lgkmcnt(0)" ::: "memory"); __syncthreads();
        for (int nn = 0; nn < 64; nn += 4) { GLA_PITER(nn, 1, 2); GLA_PITER(nn + 1, 2, 3); GLA_PITER(nn + 2, 3, 0); GLA_PITER(nn + 3, 0, 1); }
#undef GLA_PITER
#undef GLA_LOAD
#undef GLA_PROD1
#undef GLA_PROD2
    }
}
constexpr int S5_PBU = 144, S5_PH = 72;
__device__ __forceinline__ float fma_s(float a, float b, float c) { float r; asm("v_fma_f32 %0, %1, %2, %3" : "=v"(r) : "v"(a), "v"(b), "v"(c)); return r; }
constexpr int S5P_ITEM_LDS = 2 * (128 * S5_PBU + 128 * S5_PH);
__device__ __forceinline__ void s5_pipe_block(const Ctx& c, int e, int item0) {
    unsigned char* ws = c.ws; const int lane = c.lane, r32 = lane & 31, h = lane >> 5, wv = c.wave;
    const bf16* P = (const bf16*)(ws + WS_R + R_P); bf16* Z1 = (bf16*)(ws + WS_R + R_Z1);
    const int slot = wv / 3, role = (wv < 6) ? wv - 3 * slot : 3, item = item0 + (slot & 1);
    const int b = item >> 5, g = item & 31, row0 = b * 2048, eg = e * 32 + g;
    LAS unsigned char* BU0 = c.lds + RING_OFF + (slot & 1) * S5P_ITEM_LDS; LAS unsigned char* HB0 = BU0 + 2 * 128 * S5_PBU;
    bf16x8 Bf[4], Cf[8]; float dsk[8]; float ar = 0.f, ai = 0.f, nai = 0.f, hre = 0.f, him = 0.f;
#pragma unroll
    for (int nt = 0; nt < 4; ++nt) Bf[nt] = (bf16x8){0, 0, 0, 0, 0, 0, 0, 0};
#pragma unroll
    for (int s8 = 0; s8 < 8; ++s8) { Cf[s8] = (bf16x8){0, 0, 0, 0, 0, 0, 0, 0}; dsk[s8] = 0.f; }
    if (role == 0) {
#pragma unroll
        for (int nt = 0; nt < 4; ++nt) { const int n = 32 * nt + r32; const float* src = (const float*)(ws + (n < 64 ? CTL_S5BRE : CTL_S5BIM)) + ((size_t)eg * 64 + (n & 63)) * 16 + 8 * h;
            const f32x4 x0 = *(const f32x4*)src, x1 = *(const f32x4*)(src + 4); v4u w; w.x = cvtpk(x0[0], x0[1]); w.y = cvtpk(x0[2], x0[3]); w.z = cvtpk(x1[0], x1[1]); w.w = cvtpk(x1[2], x1[3]); Bf[nt] = __builtin_bit_cast(bf16x8, w); }
    } else if (role == 1) {
        const float* AB = (const float*)(ws + CTL_S5AB); ar = AB[2 * (eg * 64 + lane)]; ai = AB[2 * (eg * 64 + lane) + 1]; nai = -ai;
    } else if (role == 2) {
#pragma unroll
        for (int s8 = 0; s8 < 8; ++s8) { const int n0 = 16 * s8 + 8 * h; v4u w = {0u, 0u, 0u, 0u};
            if (r32 < 16) { const float* src = (n0 < 64 ? c.in[17] : c.in[18]) + ((size_t)eg * 16 + r32) * 64 + (n0 & 63); const float sg = (n0 < 64) ? 1.f : -1.f;
                const f32x4 x0 = *(const f32x4*)src * sg, x1 = *(const f32x4*)(src + 4) * sg; w.x = cvtpk(x0[0], x0[1]); w.y = cvtpk(x0[2], x0[3]); w.z = cvtpk(x1[0], x1[1]); w.w = cvtpk(x1[2], x1[3]); }
            Cf[s8] = __builtin_bit_cast(bf16x8, w); }
#pragma unroll
        for (int r = 0; r < 8; ++r) dsk[r] = c.in[19][eg * 16 + (r & 3) + 8 * (r >> 2) + 4 * h];
    }
    const bf16* up = P + (size_t)row0 * 2048 + 1536 + g * 16 + (size_t)r32 * 2048;
    if (role == 0) {
        v4u ur[4];
#pragma unroll
        for (int k = 0; k < 4; ++k) ur[k] = *(const v4u*)(up + 8 * h + (size_t)k * 32 * 2048);
        for (int nn = 0; nn < 68; nn += 4) {
#pragma unroll
            for (int k = 0; k < 4; ++k) { const int n = nn + k;
                if (n < 64) {
                    LAS unsigned char* BU = BU0 + (n & 1) * 128 * S5_PBU;
                    const bf16x8 uf = __builtin_bit_cast(bf16x8, ur[k]);
#pragma unroll
                    for (int nt = 0; nt < 4; ++nt) { f32x16 z;
#pragma unroll
                        for (int r = 0; r < 16; ++r) z[r] = 0.f;
                        const f32x16 d = MFMA32(uf, Bf[nt], z);
#pragma unroll
                        for (int q = 0; q < 4; ++q) *(LAS f32x4*)(BU + (32 * nt + r32) * S5_PBU + (8 * q + 4 * h) * 4) = (f32x4){d[4 * q], d[4 * q + 1], d[4 * q + 2], d[4 * q + 3]}; }
                }
                { const int nl = (n + 4 < 64) ? n + 4 : 63; ur[k] = *(const v4u*)(up + 8 * h + (size_t)nl * 32 * 2048); }
                __syncthreads();
            }
        }
    } else if (role == 1) {
        for (int step = 0; step < 68; ++step) {
            if (step >= 1 && step < 65) {
                const int n = step - 1; const LAS unsigned char* BU = BU0 + (n & 1) * 128 * S5_PBU; LAS unsigned char* HB = HB0 + (n & 1) * 128 * S5_PH;
                f32x4 br4[8], bi4[8];
#pragma unroll
                for (int k = 0; k < 8; ++k) { br4[k] = *(const LAS f32x4*)(BU + lane * S5_PBU + 16 * k); bi4[k] = *(const LAS f32x4*)(BU + (64 + lane) * S5_PBU + 16 * k); }
                asm volatile("s_waitcnt lgkmcnt(0)" ::: "memory");
#pragma unroll
                for (int t = 0; t < 32; t += 2) {
                    const float a0 = fma_s(ar, hre, br4[t >> 2][t & 3]), a1 = fma_s(ar, him, bi4[t >> 2][t & 3]); const float re0 = fma_s(nai, him, a0), im0 = fma_s(ai, hre, a1);
                    const float b0 = fma_s(ar, re0, br4[t >> 2][(t & 3) + 1]), b1 = fma_s(ar, im0, bi4[t >> 2][(t & 3) + 1]); const float re1 = fma_s(nai, im0, b0), im1 = fma_s(ai, re0, b1);
                    hre = re1; him = im1;
                    *(LAS unsigned*)(HB + lane * S5_PH + 2 * t) = cvtpk(re0, re1); *(LAS unsigned*)(HB + (64 + lane) * S5_PH + 2 * t) = cvtpk(im0, im1); }
            }
            __syncthreads();
        }
    } else if (role == 2) {
        v2u ua[4], ub[4];
#pragma unroll
        for (int k = 0; k < 4; ++k) { const bf16* q = up + 4 * h + (size_t)k * 32 * 2048; ua[k] = *(const v2u*)q; ub[k] = *(const v2u*)(q + 8); }
        __syncthreads(); __syncthreads();
        for (int nn = 0; nn < 64; nn += 4) {
#pragma unroll
            for (int k = 0; k < 4; ++k) { const int n = nn + k;
                const LAS unsigned char* HB = HB0 + (n & 1) * 128 * S5_PH;
                f32x16 y;
#pragma unroll
                for (int r = 0; r < 16; ++r) y[r] = 0.f;
#pragma unroll
                for (int s8 = 0; s8 < 8; ++s8) { const LAS unsigned char* hp = HB + (16 * s8 + 8 * h + ((lane & 15) >> 2)) * S5_PH + (16 * ((lane >> 4) & 1) + 4 * (lane & 3)) * 2;
                    const bf16x8 hb = cat8(trr(hp), trr(hp + 4 * S5_PH)); y = MFMA32(Cf[s8], hb, y); }
                const v2u xa = ua[k], xb = ub[k];
                const float u0 = bflo(xa.x), u1 = bfhi(xa.x), u2 = bflo(xa.y), u3 = bfhi(xa.y), u4 = bflo(xb.x), u5 = bfhi(xb.x), u6 = bflo(xb.y), u7 = bfhi(xb.y);
                v2u o0, o1;
                o0.x = cvtpk(gelu_tanh_f(y[0] + dsk[0] * u0), gelu_tanh_f(y[1] + dsk[1] * u1)); o0.y = cvtpk(gelu_tanh_f(y[2] + dsk[2] * u2), gelu_tanh_f(y[3] + dsk[3] * u3));
                o1.x = cvtpk(gelu_tanh_f(y[4] + dsk[4] * u4), gelu_tanh_f(y[5] + dsk[5] * u5)); o1.y = cvtpk(gelu_tanh_f(y[6] + dsk[6] * u6), gelu_tanh_f(y[7] + dsk[7] * u7));
                bf16* zp = Z1 + (size_t)(row0 + 32 * n + r32) * 512 + g * 16 + 4 * h;
                *(v2u*)zp = o0; *(v2u*)(zp + 8) = o1;
                { const int nl = (n + 4 < 64) ? n + 4 : 63; const bf16* q = up + 4 * h + (size_t)nl * 32 * 2048; ua[k] = *(const v2u*)q; ub[k] = *(const v2u*)(q + 8); }
                __syncthreads();
            }
        }
        __syncthreads(); __syncthreads();
    } else {
        for (int step = 0; step < 68; ++step) __syncthreads();
    }
    if (role == 1) { c.out[OUT_REP + ((size_t)(e * 8 + b) * 32 + g) * 64 + lane] = hre; c.out[OUT_IMP + ((size_t)(e * 8 + b) * 32 + g) * 64 + lane] = him; }
}
__device__ __forceinline__ void even_mixer_v2(const Ctx& c, int e) {
    const int bid = (c.vcu & 31) * 8 + (c.vcu >> 5);
    if (bid < 32) { gla_fast_block(c, e, bid); }
    else if (bid < 160) {
        s5_pipe_block(c, e, (bid - 32) * 2);
    }
    else { for (int bi = bid - 160; bi < 128; bi += 96) { gla_naive_block(c, e, bi * 4, true); __syncthreads(); }
           for (int it = (bid - 160) * 8 + c.wave; it < 4096; it += 96 * 8) s5_naive_wave(c, e, it, true, (LAS float*)(c.lds + RING_OFF) + c.wave * 3200); }
}
typedef float f32x16s __attribute__((ext_vector_type(16)));
__device__ __forceinline__ float sq8(const v4u& w) { float s = 0.f;
#pragma unroll
    for (int q = 0; q < 4; ++q) { const float a = bflo(w[q]), b = bfhi(w[q]); s += a * a + b * b; }
    return s; }
template <int TN, bool NORM_A, class Epi> __device__ __forceinline__ void sgemm2(const Ctx& c, const bf16* A, const bf16* Bt, int N, int K, const Epi& E, int first_tile, int tile_stride, int ld = 0) {
    if (ld == 0) ld = K;
    constexpr int ROWS = 64 + TN, NP = ROWS * 16 / 512, PITCH = 272, BUFB = ROWS * PITCH, NSUB = TN / 32, KPARTS = 4 / NSUB, KSTEPS = 8 / KPARTS;
    const int lane = c.lane, r32 = lane & 31, h = lane >> 5, wv = c.wave, tid = c.tid;
    LAS unsigned char* L = c.lds + RING_OFF;
    const int wm = wv & 1, wn = (NSUB == 2) ? ((wv >> 1) & 1) : 0, kp = (NSUB == 2) ? (wv >> 2) : (wv >> 1);
    const int ntiles = 8 * (N / TN), nch = K / 128;
    for (int tile = first_tile; tile < ntiles; tile += tile_stride) {
        const int rb = tile & 7, cb = tile >> 3;
        const unsigned char* src[NP]; int dst[NP];
#pragma unroll
        for (int i = 0; i < NP; ++i) { const int p = tid + 512 * i, row = p >> 4, c16 = p & 15;
            src[i] = (const unsigned char*)((row < 64) ? A + (size_t)(64 * rb + row) * ld : Bt + (size_t)(TN * cb + row - 64) * ld) + 16 * c16; dst[i] = row * PITCH + 16 * c16; }
        v4u ra[NP], rb_[NP], rc_[NP], rd_[NP];
#pragma unroll
        for (int i = 0; i < NP; ++i) { ra[i] = *(const v4u*)(src[i]); rb_[i] = *(const v4u*)(src[i] + 256); rc_[i] = *(const v4u*)(src[i] + 512); rd_[i] = *(const v4u*)(src[i] + 768); }
#pragma unroll
        for (int i = 0; i < NP; ++i) *(LAS v4u*)(L + dst[i]) = ra[i];
        float ssa0 = 0.f, ssa1 = 0.f;
        if (NORM_A) { ssa0 = sq8(ra[0]); ssa1 = sq8(ra[1]); }
        f32x16s acc;
#pragma unroll
        for (int r = 0; r < 16; ++r) acc[r] = 0.f;
        __syncthreads();
#define SG_STEP(ch, RCUR, RNEXT) do { \
            if ((ch) + 4 < nch) { _Pragma("unroll") for (int i = 0; i < NP; ++i) RCUR[i] = *(const v4u*)(src[i] + (size_t)((ch) + 4) * 256); } \
            { const LAS unsigned char* bufp = L + ((ch) & 1) * BUFB; \
              _Pragma("unroll") for (int s = 0; s < KSTEPS; ++s) { const int ks = kp * KSTEPS + s; \
                  const bf16x8 fa = *(const LAS bf16x8*)(bufp + (32 * wm + r32) * PITCH + 32 * ks + 16 * h), fb = *(const LAS bf16x8*)(bufp + (64 + 32 * wn + r32) * PITCH + 32 * ks + 16 * h); \
                  acc = __builtin_amdgcn_mfma_f32_32x32x16_bf16(fa, fb, acc, 0, 0, 0); } } \
            if ((ch) + 1 < nch) { _Pragma("unroll") for (int i = 0; i < NP; ++i) *(LAS v4u*)(L + (((ch) + 1) & 1) * BUFB + dst[i]) = RNEXT[i]; if (NORM_A) { ssa0 += sq8(RNEXT[0]); ssa1 += sq8(RNEXT[1]); } } \
            __syncthreads(); } while (0)
        for (int ch = 0; ch < nch; ch += 4) { SG_STEP(ch, ra, rb_); SG_STEP(ch + 1, rb_, rc_); SG_STEP(ch + 2, rc_, rd_); SG_STEP(ch + 3, rd_, ra); }
#undef SG_STEP
        LAS float* red = (LAS float*)L;
#pragma unroll
        for (int r = 0; r < 16; ++r) red[wv * 1024 + ((r & 3) + 8 * (r >> 2) + 4 * h) * 32 + r32] = acc[r];
        if (NORM_A) {
#pragma unroll
            for (int o = 1; o < 16; o <<= 1) { ssa0 += __shfl_xor(ssa0, o); ssa1 += __shfl_xor(ssa1, o); }
            if ((tid & 15) == 0) { red[8192 + (tid >> 4)] = ssa0; red[8192 + 32 + (tid >> 4)] = ssa1; } }
        __syncthreads();
        if (tid < 64 * (TN / 8)) {
            const int row = tid / (TN / 8), cg = tid % (TN / 8), sm = row >> 5, sn = (8 * cg) >> 5, rr = row & 31, cc = (8 * cg) & 31;
            f32x4 v0 = {0.f, 0.f, 0.f, 0.f}, v1 = {0.f, 0.f, 0.f, 0.f};
#pragma unroll
            for (int q = 0; q < KPARTS; ++q) { const int w = (NSUB == 2) ? (sm + 2 * sn + 4 * q) : (sm + 2 * q);
                v0 = v0 + *(const LAS f32x4*)(red + w * 1024 + rr * 32 + cc); v1 = v1 + *(const LAS f32x4*)(red + w * 1024 + rr * 32 + cc + 4); }
            const int grow = pg8::TP_ROWS + 64 * rb + row; float s = 0.f;
            const float rs = NORM_A ? rsqrtf(red[8192 + row] * (1.0f / 1024.0f) + pg8::EPS_F) : E.row_scale(grow);
            f32x4 cb0, cb1; E.col8(TN * cb + 8 * cg, cb0, cb1);
            const pg8::u32x4 pre = Epi::HAS_PRE ? E.pre8(grow, TN * cb + 8 * cg) : (pg8::u32x4){0u, 0u, 0u, 0u};
            E.row8(grow, TN * cb + 8 * cg, v0, v1, rs, cb0, cb1, pre, s);
        }
        __syncthreads();
    }
}
constexpr int LR_PX = 272, LR_PAB = 264, LR_WAVE = 32 * LR_PX;
constexpr int LR_COMP = 8 * LR_WAVE;
constexpr int LR_WF = LR_COMP + 4096, LR_CW = LR_WF + 16384;
static_assert(32 * LR_PAB <= LR_WAVE && LR_CW + 2560 <= RING_BYTES, "LRU LDS map");
__device__ __forceinline__ void lru_fused(const Ctx& c, int o) {
    unsigned char* ws = c.ws; const int lane = c.lane, r32 = lane & 31, h = lane >> 5, wv = c.wave;
    const bf16* CIN = (const bf16*)(ws + WS_R + R_CIN); const bf16* GT = (const bf16*)(ws + WS_R + R_XC); bf16* HG = (bf16*)(ws + WS_R + R_MIX);
    const int id = c.vcu, b = id >> 5, n = (id >> 2) & 7, cs = id & 3;
    const int chg = 128 * n + 32 * cs + r32;
    LAS unsigned char* XS = c.lds + RING_OFF + wv * LR_WAVE;
    LAS unsigned char* COMP = c.lds + RING_OFF + LR_COMP;
    const bf16* Wg = (const bf16*)(ws + WS_W + W_G) + ((size_t)o * 8 + n) * 256 * 128;
    LAS unsigned char* WF = c.lds + RING_OFF + LR_WF; LAS unsigned char* CWL = c.lds + RING_OFF + LR_CW;
#pragma unroll
    for (int i = 0; i < 2; ++i) { const int en = c.tid + 512 * i, rw = en >> 9, sk = (en >> 6) & 7, ln = en & 63;
        *(LAS v4u*)(WF + en * 16) = *(const v4u*)(Wg + (size_t)(rw * 128 + 32 * cs + (ln & 31)) * 128 + 16 * sk + 8 * (ln >> 5)); }
#pragma unroll
    for (int i = 0; i < 2; ++i) { const int en = c.tid + 512 * i, j = en >> 7, ch = en & 127;
        if (en < 640) *(LAS float*)(CWL + en * 4) = (j < 4) ? c.in[25][(size_t)o * 4 * 1024 + j * 1024 + 128 * n + ch] : c.in[26][o * 1024 + 128 * n + ch]; }
    const int c8 = lane & 15, tq = lane >> 4, cch = 128 * n + 8 * c8;
    v4u xr[11];
#define LRU_LOAD_XR(TT) do { const size_t rb_ = (size_t)b * 2048 + 256 * (TT) + 32 * wv; \
        _Pragma("unroll") for (int i_ = 0; i_ < 11; ++i_) { const int tl_ = 8 * tq + i_ - 3; xr[i_] = (v4u){0u, 0u, 0u, 0u}; \
            if (256 * (TT) + 32 * wv + tl_ >= 0) xr[i_] = *(const v4u*)(CIN + (size_t)((long)rb_ + tl_) * 1024 + cch); } } while (0)
    LRU_LOAD_XR(0);
    __syncthreads();
    const float brc = c.in[28][o * 1024 + chg], bic = c.in[30][o * 1024 + chg];
    const float sp8 = 8.0f * log1pf(__expf(-c.in[31][o * 1024 + chg]));
    float hc = 0.f;
    const int ntile = 8 + ((wv < 2) ? 1 : 0);
    for (int tt = 0; tt < 9; ++tt) {
        const bool sample = tt == 8;
        const bool active = tt < ntile;
        const int st = 2 * b + wv;
        const size_t rowb = sample ? (size_t)TP + 32 * st : (size_t)b * 2048 + 256 * tt + 32 * wv;
        float Aw = 1.f, Bw = 0.f, Ao = 1.f, Bo = 0.f;
        unsigned short gt[16];
        if (active) {
            { const size_t orow_ = rowb + 16 * h;
#pragma unroll
              for (int i = 0; i < 16; ++i) gt[i] = GT[(orow_ + i) * 1024 + chg]; }
            { float w0[8], w1[8], w2[8], w3[8], bs[8];
#pragma unroll
              for (int q = 0; q < 2; ++q) { const LAS f32x4* wp = (const LAS f32x4*)(CWL + (8 * c8 + 4 * q) * 4); const f32x4 a0 = wp[0], a1 = wp[32], a2 = wp[64], a3 = wp[96], bb = wp[128];
#pragma unroll
                  for (int i = 0; i < 4; ++i) { w0[4 * q + i] = a0[i]; w1[4 * q + i] = a1[i]; w2[4 * q + i] = a2[i]; w3[4 * q + i] = a3[i]; bs[4 * q + i] = bb[i]; } }
              if (!sample) {
#pragma unroll
                  for (int i = 0; i < 8; ++i) { float y[8];
#pragma unroll
                      for (int q = 0; q < 4; ++q) {
                          y[2 * q] = bs[2 * q] + w0[2 * q] * bflo(xr[i][q]) + w1[2 * q] * bflo(xr[i + 1][q]) + w2[2 * q] * bflo(xr[i + 2][q]) + w3[2 * q] * bflo(xr[i + 3][q]);
                          y[2 * q + 1] = bs[2 * q + 1] + w0[2 * q + 1] * bfhi(xr[i][q]) + w1[2 * q + 1] * bfhi(xr[i + 1][q]) + w2[2 * q + 1] * bfhi(xr[i + 2][q]) + w3[2 * q + 1] * bfhi(xr[i + 3][q]); }
                      v4u ov; ov.x = cvtpk(y[0], y[1]); ov.y = cvtpk(y[2], y[3]); ov.z = cvtpk(y[4], y[5]); ov.w = cvtpk(y[6], y[7]);
                      *(LAS v4u*)(XS + (8 * tq + i) * LR_PX + 16 * c8) = ov; }
                  if (tt + 1 < 8) LRU_LOAD_XR(tt + 1);
              } else {
#pragma unroll 1
                  for (int i = 0; i < 8; ++i) {
                      const int bt = 8 * st + 2 * tq + (i >> 2), stp = i & 3; const float* sc = c.in[6] + ((size_t)o * 128 + bt) * 3 * 1024 + cch;
                      float y[8];
#pragma unroll
                      for (int q = 0; q < 8; ++q) y[q] = bs[q];
#pragma unroll
                      for (int j = 0; j < 4; ++j) { const int sj = stp - 3 + j; float x[8];
                          if (sj >= 0) { const v4u x4 = *(const v4u*)(CIN + (rowb + 8 * tq + i - 3 + j) * 1024 + cch);
#pragma unroll
                              for (int q = 0; q < 4; ++q) { x[2 * q] = bflo(x4[q]); x[2 * q + 1] = bfhi(x4[q]); } }
                          else { const f32x4 s0 = *(const f32x4*)(sc + (size_t)(sj + 3) * 1024), s1 = *(const f32x4*)(sc + (size_t)(sj + 3) * 1024 + 4);
#pragma unroll
                              for (int q = 0; q < 4; ++q) { x[q] = s0[q]; x[4 + q] = s1[q]; } }
#pragma unroll
                          for (int q = 0; q < 8; ++q) y[q] += ((j == 0) ? w0[q] : (j == 1) ? w1[q] : (j == 2) ? w2[q] : w3[q]) * x[q]; }
                      v4u ov; ov.x = cvtpk(y[0], y[1]); ov.y = cvtpk(y[2], y[3]); ov.z = cvtpk(y[4], y[5]); ov.w = cvtpk(y[6], y[7]);
                      *(LAS v4u*)(XS + (8 * tq + i) * LR_PX + 16 * c8) = ov; }
              }
            }
            f32x16 accr, acci;
#pragma unroll
            for (int r = 0; r < 16; ++r) { accr[r] = 0.f; acci[r] = 0.f; }
#pragma unroll
            for (int s = 0; s < 8; ++s) { const bf16x8 xa = *(const LAS bf16x8*)(XS + r32 * LR_PX + 32 * s + 16 * h); accr = MFMA32(xa, *(const LAS bf16x8*)(WF + (s * 64 + lane) * 16), accr); acci = MFMA32(xa, *(const LAS bf16x8*)(WF + ((8 + s) * 64 + lane) * 16), acci); }
            float xv[16];
#pragma unroll
            for (int r = 0; r < 16; ++r) xv[r] = bf2f(*(const LAS bf16*)(XS + ((r & 3) + 8 * (r >> 2) + 4 * h) * LR_PX + (32 * cs + r32) * 2));
            asm volatile("s_waitcnt lgkmcnt(0)" ::: "memory");
#pragma unroll
            for (int r = 0; r < 16; ++r) {
                const float rg = sigmoid_f(accr[r] + brc), ig = sigmoid_f(acci[r] + bic);
                const float la = -rg * sp8, a = __expf(la);
                const float bq = __builtin_amdgcn_sqrtf(fmaxf(1.0f - a * a, 0.f)) * ig * xv[r];
                *(LAS f32x2_t*)(XS + ((r & 3) + 8 * (r >> 2) + 4 * h) * LR_PAB + 8 * r32) = (f32x2_t){a, bq};
            }
            asm volatile("s_waitcnt lgkmcnt(0)" ::: "memory");
            if (!sample) {
                float A = 1.f, B = 0.f;
#pragma unroll
                for (int i = 0; i < 16; ++i) { const f32x2_t ab = *(const LAS f32x2_t*)(XS + (16 * h + i) * LR_PAB + 8 * r32); A *= ab.x; B = ab.x * B + ab.y; }
                Ao = __shfl_xor(A, 32); Bo = __shfl_xor(B, 32);
                Aw = A * Ao; Bw = h ? (A * Bo + B) : (Ao * B + Bo);
                if (h == 0) *(LAS f32x2_t*)(COMP + ((tt & 1) * 256 + wv * 32 + r32) * 8) = (f32x2_t){Aw, Bw};
            }
        }
        __syncthreads();
        if (active) {
            float hin;
            if (!sample) {
                float hrun = hc; hin = hc;
#pragma unroll
                for (int w = 0; w < 8; ++w) { const f32x2_t cp = *(const LAS f32x2_t*)(COMP + ((tt & 1) * 256 + w * 32 + r32) * 8); if (w == wv) hin = hrun; hrun = cp.x * hrun + cp.y; }
                hc = hrun;
                if (h) hin = Ao * hin + Bo;
            } else hin = 0.f;
            const size_t orow = rowb + 16 * h;
            float hh = hin;
#pragma unroll
            for (int i = 0; i < 16; ++i) {
                if (sample && (i & 3) == 0) hh = c.in[5][((size_t)o * 128 + 8 * st + 4 * h + (i >> 2)) * 1024 + chg];
                const f32x2_t ab = *(const LAS f32x2_t*)(XS + (16 * h + i) * LR_PAB + 8 * r32);
                hh = ab.x * hh + ab.y;
                HG[(orow + i) * 1024 + chg] = (bf16)cvtpk(bf2f(gt[i]) * hh, 0.f);
                if (sample && (i & 3) == 3) c.out[OUT_LRUS + ((size_t)o * 128 + 8 * st + 4 * h + (i >> 2)) * 1024 + chg] = hh;
            }
            asm volatile("s_waitcnt lgkmcnt(0)" ::: "memory");
        }
    }
#undef LRU_LOAD_XR
    if (wv == 0 && h == 0) c.out[OUT_LRUP + ((size_t)o * 8 + b) * 1024 + chg] = hc;
}
typedef float f32x4g __attribute__((ext_vector_type(4)));
__device__ __forceinline__ void gate_job(const Ctx& c, int e, const float* ssq, int first_tile, int tile_stride) {
    unsigned char* ws = c.ws; const int lane = c.lane, wv = c.wave, l15 = lane & 15, quad = lane >> 4, r32 = lane & 31, h = lane >> 5;
    const bf16* XB = (const bf16*)(ws + WS_XB); float* LA = (float*)(ws + WS_R + R_LA);
    const bf16* WaT = (const bf16*)(ws + WS_WA) + (size_t)e * 16 * 1024;
    const bf16* A2T = (const bf16*)(ws + WS_WA) + 2 * 16 * 1024 + (size_t)e * 256 * 16;
    const float* b_a2 = c.in[10] + e * 256;
    LAS float* part = (LAS float*)(c.lds + RING_OFF);
    LAS bf16* alr = (LAS bf16*)(c.lds + RING_OFF + 32768);
    LAS float* pss = (LAS float*)(c.lds + RING_OFF + 32768 + 2048);
    for (int tile = first_tile; tile < T / 64; tile += tile_stride) {
        const int rowb = 64 * tile;
        bf16x8 bw[4];
#pragma unroll
        for (int s = 0; s < 4; ++s) bw[s] = *(const bf16x8*)(WaT + (size_t)l15 * 1024 + 128 * wv + 32 * s + 8 * quad);
        f32x4g acc[4];
#pragma unroll
        for (int mt = 0; mt < 4; ++mt) { acc[mt] = (f32x4g){0.f, 0.f, 0.f, 0.f};
            bf16x8 xa[4];
#pragma unroll
            for (int s = 0; s < 4; ++s) xa[s] = *(const bf16x8*)(XB + (size_t)(rowb + 16 * mt + l15) * 1024 + 128 * wv + 32 * s + 8 * quad);
#pragma unroll
            for (int s = 0; s < 4; ++s) acc[mt] = __builtin_amdgcn_mfma_f32_16x16x32_bf16(bw[s], xa[s], acc[mt], 0, 0, 0);
            float sq = 0.f;
#pragma unroll
            for (int s = 0; s < 4; ++s) { const v4u w4 = __builtin_bit_cast(v4u, xa[s]);
#pragma unroll
                for (int q = 0; q < 4; ++q) { const float a = bflo(w4[q]), b = bfhi(w4[q]); sq += a * a + b * b; } }
            sq += __shfl_xor(sq, 16); sq += __shfl_xor(sq, 32);
            if (quad == 0) pss[wv * 64 + 16 * mt + l15] = sq; }
#pragma unroll
        for (int mt = 0; mt < 4; ++mt)
#pragma unroll
            for (int q = 0; q < 4; ++q) part[wv * 1024 + (16 * mt + l15) * 16 + 4 * quad + q] = acc[mt][q];
        __syncthreads();
#pragma unroll
        for (int i = 0; i < 2; ++i) { const int idx = c.tid + 512 * i, row = idx >> 4; float s = 0.f;
#pragma unroll
            for (int w = 0; w < 8; ++w) s += part[w * 1024 + idx];
            float sq = 0.f;
#pragma unroll
            for (int w = 0; w < 8; ++w) sq += pss[w * 64 + row];
            const float rs = rsqrtf(sq * (1.0f / 1024.0f) + EPS);
            alr[idx] = (bf16)f2bf(s * rs); }
        __syncthreads();
        { const int rh = wv & 1;
          v4u aw = *(const LAS v4u*)(alr + (32 * rh + r32) * 16 + 8 * h); const bf16x8 af = __builtin_bit_cast(bf16x8, aw);
#pragma unroll
          for (int ct = 0; ct < 2; ++ct) { const int n = 32 * (2 * (wv >> 1) + ct) + r32;
              const bf16x8 bf = *(const bf16x8*)(A2T + (size_t)n * 16 + 8 * h);
              f32x16 z;
#pragma unroll
              for (int r = 0; r < 16; ++r) z[r] = 0.f;
              const f32x16 d = MFMA32(af, bf, z);
              const float bn = b_a2[n];
#pragma unroll
              for (int r = 0; r < 16; ++r) { const int row = rowb + 32 * rh + (r & 3) + 8 * (r >> 2) + 4 * h;
                  LA[(size_t)row * 256 + n] = pg8::logsigmoid_f(d[r] + bn) * 0.0625f; } } }
        __syncthreads();
    }
}
#ifndef REP_PROL
#define REP_PROL 1
#endif
#ifndef REP_IN
#define REP_IN 1
#endif
#ifndef REP_EMIX
#define REP_EMIX 1
#endif
#ifndef REP_GLU
#define REP_GLU 1
#endif
#ifndef REP_CONV
#define REP_CONV 1
#endif
#ifndef REP_GATES
#define REP_GATES 1
#endif
#ifndef REP_UP
#define REP_UP 1
#endif
#ifndef REP_LRU
#define REP_LRU 1
#endif
constexpr int N_PHASES = 24;
__global__ void __launch_bounds__(NWAVES * 64, 2) mk_fwd(Args args) {
    extern __shared__ __attribute__((aligned(16))) unsigned char lds_raw[];
    const int wave_s_ = __builtin_amdgcn_readfirstlane((int)threadIdx.x >> 6);
#define TID_NOW(var) int var; { int l_; asm volatile("v_mbcnt_lo_u32_b32 %0, -1, 0\n\tv_mbcnt_hi_u32_b32 %0, -1, %0" : "=v"(l_)); var = (wave_s_ << 6) | l_; }
    const int lo = args.ph_lo, hi = args.ph_hi;
    {
        LAS unsigned char* l0 = (LAS unsigned char*)lds_raw;
        TID_NOW(t0_)
        for (int u = t0_; u < (LDS_BYTES - LDSCTL_OFF) / 4; u += NWAVES * 64) ((LAS unsigned*)(l0 + LDSCTL_OFF))[u] = 0u;
        __syncthreads();
    }
    XcdBarrier bar; bar.bar = (unsigned*)(args.ws + WS_CTL) + CW_BAR + args.li * XCD_BAR_WORDS; bar.x = 0; bar.st = nullptr;
    TID_NOW(t0b_)
    if (hi - lo > 1) bar = xcd_barrier_post((unsigned*)(args.ws + WS_CTL) + CW_BAR + args.li * XCD_BAR_WORDS, (volatile LAS unsigned*)((LAS unsigned char*)lds_raw + MISC_OFF) + 8, t0b_);
    int pc = 0;
#define PHASE_BEGINR(R) { int pc_ = pc; asm volatile("" : "+s"(pc_)); if (pc_ >= lo && pc_ < hi) { for (int rep_ = 0; rep_ < (R); ++rep_) { if (rep_) __syncthreads(); unsigned char* wsr_ = args.ws; asm volatile("" : "+s"(wsr_)); unsigned char* ws = as_global(wsr_); float* outr_ = args.out; asm volatile("" : "+s"(outr_)); float* out_ = as_global(outr_); \
    TID_NOW(t_) int bx = blockIdx.x; asm volatile("" : "+s"(bx)); int G_ = gridDim.x; asm volatile("" : "+s"(G_)); \
    Ctx c; c.var = args.pad; c.in.p = args.in; c.out = out_; c.ws = ws; c.lds = (LAS unsigned char*)lds_raw; c.tid = t_; c.lane = c.tid & 63; c.wave = __builtin_amdgcn_readfirstlane(c.tid >> 6); \
    c.G = G_; c.vcu = (c.G % 8 == 0) ? (bx % 8) * (c.G / 8) + bx / 8 : bx; c.gw = c.vcu * NWAVES + c.wave; c.NGW = c.G * NWAVES; \
    PG8_LAS unsigned char* ring = (PG8_LAS unsigned char*)(c.lds + RING_OFF); (void)ring; \
    bf16* XB = (bf16*)(ws + WS_XB); float* X = c.out; float* ssq = (float*)(ws + WS_SSQ); bf16* MIX = (bf16*)(ws + WS_R + R_MIX); (void)XB; (void)X; (void)ssq; (void)MIX;
#define PHASE_BEGIN PHASE_BEGINR(1)
#define PHASE_END   } if (pc_ + 1 < hi) { TID_NOW(tb_) xcd_barrier(bar, tb_); } } } ++pc;

    PHASE_BEGINR(REP_PROL) p0_prologue(c); PHASE_END

    for (int l = 0; l < 4; ++l) {
        const int hf = l >> 1;
        if ((l & 1) == 0) {
            PHASE_BEGINR(REP_IN)
                const bf16* wt = (const bf16*)(ws + WS_W + W_INE) + (size_t)hf * NIN_E * 1024; pg8::Gemm g{XB, wt, TP, 2048, 1024, 1024}; pg8::StaticOrder S; S.init(TP, 2048, c.G, bx);
                pg8::EpiInE E{(bf16*)(ws + WS_R + R_P), ssq + (size_t)(2 * l) * 4 * T};
                if (bx & 1) { if (l == 0) p0_weights_rest(c); gate_job(c, hf, ssq + (size_t)(2 * l) * 4 * T, bx, c.G); sgemm2<64, true>(c, XB + (size_t)TP * 1024, wt, 2048, 1024, E, bx, c.G); pg8::gemm_phase<pg8::EpiInE, pg8::StaticOrder, true, true>(ring, g, S, E, c.tid); }
                else { pg8::gemm_phase<pg8::EpiInE, pg8::StaticOrder, true, true>(ring, g, S, E, c.tid); sgemm2<64, true>(c, XB + (size_t)TP * 1024, wt, 2048, 1024, E, bx, c.G); gate_job(c, hf, ssq + (size_t)(2 * l) * 4 * T, bx, c.G); if (l == 0) p0_weights_rest(c); }
            PHASE_END
            PHASE_BEGINR(REP_EMIX) even_mixer_v2(c, hf); PHASE_END
            PHASE_BEGINR(REP_GLU)
                gla_post(c, hf);
                bf16* Z1 = (bf16*)(ws + WS_R + R_Z1); const bf16* wt = (const bf16*)(ws + WS_W + W_GLU) + (size_t)hf * 512 * 512; pg8::Gemm g{Z1, wt, TP, 512, 512, 512}; pg8::StaticOrder S; S.init(TP, 512, c.G, bx);
                pg8::EpiGlu E{Z1, MIX, c.in[21] + hf * 512};
                if (bx & 1) { sgemm2<32, false>(c, Z1 + (size_t)TP * 512, wt, 512, 512, E, bx >= 128 ? bx - 128 : (1 << 30), c.G - 128); pg8::gemm_phase<pg8::EpiGlu, pg8::StaticOrder, true, true>(ring, g, S, E, c.tid); }
                else { pg8::gemm_phase<pg8::EpiGlu, pg8::StaticOrder, true, true>(ring, g, S, E, c.tid); sgemm2<32, false>(c, Z1 + (size_t)TP * 512, wt, 512, 512, E, bx >= 128 ? bx - 128 : (1 << 30), c.G - 128); }
            PHASE_END
        } else {
            PHASE_BEGINR(REP_IN)
                const bf16* wt = (const bf16*)(ws + WS_W + W_INO) + (size_t)hf * NIN_O * 1024; pg8::Gemm g{XB, wt, TP, NIN_O, 1024, 1024}; pg8::StaticOrder S; S.init(TP, NIN_O, c.G, bx);
                pg8::EpiInO E{(bf16*)(ws + WS_R + R_XC), (bf16*)(ws + WS_R + R_CIN), ssq + (size_t)(2 * l) * 4 * T, c.out + OUT_CONVP + (size_t)hf * 8 * 3 * 1024, c.out + OUT_CONVS + (size_t)hf * 128 * 3 * 1024};
                if (bx & 1) { sgemm2<64, true>(c, XB + (size_t)TP * 1024, wt, NIN_O, 1024, E, bx, c.G); pg8::gemm_phase<pg8::EpiInO, pg8::StaticOrder, true, true>(ring, g, S, E, c.tid); }
                else { pg8::gemm_phase<pg8::EpiInO, pg8::StaticOrder, true, true>(ring, g, S, E, c.tid); sgemm2<64, true>(c, XB + (size_t)TP * 1024, wt, NIN_O, 1024, E, bx, c.G); }
            PHASE_END
            PHASE_BEGINR(REP_LRU) lru_fused(c, hf); PHASE_END
        }
        PHASE_BEGIN
            const bf16* wo = (l & 1) ? (const bf16*)(ws + WS_W + W_OUTO) + (size_t)hf * 1024 * 1024 : (const bf16*)(ws + WS_W + W_OUTE) + (size_t)hf * 1024 * 1024;
            pg8::Gemm g{MIX, wo, TP, 1024, 1024, 1024}; pg8::StaticOrder S; S.init(TP, 1024, c.G, bx);
            pg8::EpiRes E{XB, ssq + (size_t)(2 * l + 1) * 4 * T};
            if (bx & 1) { sgemm2<32, false>(c, MIX + (size_t)TP * 1024, wo, 1024, 1024, E, bx, c.G); pg8::gemm_phase<pg8::EpiRes, pg8::StaticOrder, false, true>(ring, g, S, E, c.tid); }
            else { pg8::gemm_phase<pg8::EpiRes, pg8::StaticOrder, false, true>(ring, g, S, E, c.tid); sgemm2<32, false>(c, MIX + (size_t)TP * 1024, wo, 1024, 1024, E, bx, c.G); }
        PHASE_END
        PHASE_BEGINR(REP_UP)
            const bf16* wt = (const bf16*)(ws + WS_W + W_UP) + (size_t)l * 4096 * 1024; pg8::Gemm g{XB, wt, TP, FF, 1024, 1024}; pg8::StaticOrder S; S.init(TP, FF, c.G, bx);
            pg8::EpiUp E{(bf16*)(ws + WS_R + R_H), ssq + (size_t)(2 * l + 1) * 4 * T};
            if (bx & 1) { sgemm2<64, true>(c, XB + (size_t)TP * 1024, wt, FF, 1024, E, bx, c.G); pg8::gemm_phase<pg8::EpiUp, pg8::StaticOrder, true, true>(ring, g, S, E, c.tid); }
            else { pg8::gemm_phase<pg8::EpiUp, pg8::StaticOrder, true, true>(ring, g, S, E, c.tid); sgemm2<64, true>(c, XB + (size_t)TP * 1024, wt, FF, 1024, E, bx, c.G); }
        PHASE_END
        PHASE_BEGIN
            const bf16* wt = (const bf16*)(ws + WS_W + W_DN) + (size_t)l * 1024 * LD_FF; pg8::Gemm g{(bf16*)(ws + WS_R + R_H), wt, TP, 1024, FF, LD_FF}; pg8::StaticOrder S; S.init(TP, 1024, c.G, bx);
            pg8::EpiRes E{XB, ssq + (size_t)(2 * l + 2) * 4 * T};
            if (bx & 1) { sgemm2<32, false>(c, (const bf16*)(ws + WS_R + R_H) + (size_t)TP * LD_FF, wt, 1024, FF, E, bx, c.G, LD_FF); pg8::gemm_phase<pg8::EpiRes, pg8::StaticOrder, false, true>(ring, g, S, E, c.tid); }
            else { pg8::gemm_phase<pg8::EpiRes, pg8::StaticOrder, false, true>(ring, g, S, E, c.tid); sgemm2<32, false>(c, (const bf16*)(ws + WS_R + R_H) + (size_t)TP * LD_FF, wt, 1024, FF, E, bx, c.G, LD_FF); }
        PHASE_END
    }
    PHASE_BEGINR(1) final_norm(c); PHASE_END
#undef PHASE_BEGIN
#undef PHASE_BEGINR
#undef PHASE_END
}

#ifndef MK_N_LAUNCHES
#define MK_N_LAUNCHES 1
#endif
extern "C" void kernel_launch(void* const* d_in, const int* in_sizes, int n_in, void* d_out, int out_size, void* d_ws, size_t ws_size, hipStream_t stream) {
    static int grid = 0;
    if (grid == 0) {
        if (n_in != 37 || out_size != (int)OUT_END || ws_size < WS_END) { fprintf(stderr, "kernel_launch: shape mismatch (n_in %d out %d ws %zu)\n", n_in, out_size, ws_size); grid = -1; return; }
        int dev = 0, cus = 0;
        if (hipGetDevice(&dev) != hipSuccess || hipDeviceGetAttribute(&cus, hipDeviceAttributeMultiprocessorCount, dev) != hipSuccess) { grid = -1; return; }
        if (hipFuncSetAttribute((const void*)mk_fwd, hipFuncAttributeMaxDynamicSharedMemorySize, LDS_BYTES) != hipSuccess) { fprintf(stderr, "kernel_launch: hipFuncSetAttribute failed\n"); grid = -1; return; }
        int per_cu = 0;
        if (hipOccupancyMaxActiveBlocksPerMultiprocessor(&per_cu, (const void*)mk_fwd, NWAVES * 64, LDS_BYTES) != hipSuccess || per_cu < 1) fprintf(stderr, "kernel_launch: occupancy query says %d\n", per_cu);
        (void)hipGetLastError();
        grid = cus;
        if (grid != 256) fprintf(stderr, "kernel_launch: %d CUs; this kernel's static work split assumes 256\n", grid);
    }
    if (grid < 0) return;
    if (hipMemsetAsync((char*)d_ws + WS_CTL, 0, CTL_ZERO_BYTES, stream) != hipSuccess) return;
    Args a{};
    for (int i = 0; i < 37; ++i) a.in[i] = (const float*)d_in[i];
    a.out = (float*)d_out; a.ws = (unsigned char*)d_ws;
    if (MK_N_LAUNCHES == 1) { a.ph_lo = 0; a.ph_hi = N_PHASES; hipLaunchKernelGGL(mk_fwd, dim3(grid), dim3(NWAVES * 64), LDS_BYTES, stream, a); }
    else { for (int p = 0; p < N_PHASES; ++p) { a.ph_lo = p; a.ph_hi = p + 1; hipLaunchKernelGGL(mk_fwd, dim3(grid), dim3(NWAVES * 64), LDS_BYTES, stream, a); } }
}
```
